# Optimizing an MI355X kernel written in HIP

```python
import math
import jax
import jax.numpy as jnp
from jax import lax
import numpy as np

D_MODEL = 4096
BATCH = 2
SEQ = 4096
DEPTH = 1
DEC_BATCH = 1
DEC_SEQ = 16384
PAST_LEN = 128

GRID_W = 64
HEAD_DIM = 128
ATTN_WIDTH = D_MODEL // 2
N_HEADS = ATTN_WIDTH // HEAD_DIM
WIN_H_MAX = 8
WIN_W = 16
SSM_WIDTH = D_MODEL - ATTN_WIDTH
SSM_GROUP = 16
N_GROUPS = SSM_WIDTH // SSM_GROUP
STATE_P = 64
MIX_WIDTH = ATTN_WIDTH + SSM_WIDTH
IN_WIDTH = 3 * ATTN_WIDTH + SSM_WIDTH
D_FF = 4 * D_MODEL
PLE_DIM = 256
RMS_EPS = 1e-6
DT_MIN = 1e-3
DT_MAX = 1e-1
LAM_RE_MAX = -1e-4
NEG_INF = -1e30

kernel_name = 'hybrid_natten2d_s5_encoder'


def rms_norm(x, g):
    xf = x.astype(jnp.float32)
    y = xf * lax.rsqrt(jnp.mean(xf * xf, axis=-1, keepdims=True) + RMS_EPS)
    return (y * g.astype(jnp.float32)).astype(x.dtype)


def neighbourhood_attention(q, k, v, rpb):
    b, l = q.shape[0], q.shape[1]
    rows = l // GRID_W
    kh = min(WIN_H_MAX, rows)
    qg = q.reshape(b, rows, GRID_W, N_HEADS, HEAD_DIM)
    kg = k.reshape(b, rows, GRID_W, N_HEADS, HEAD_DIM)
    vg = v.reshape(b, rows, GRID_W, N_HEADS, HEAD_DIM)
    r = np.arange(rows)
    row_start = np.clip(r - kh // 2, 0, rows - kh)
    row_idx = row_start[:, None] + np.arange(kh)[None, :]
    c = np.arange(GRID_W)
    col_start = np.clip(c - WIN_W // 2, 0, GRID_W - WIN_W)
    in_win = (c[None, :] >= col_start[:, None]) & (c[None, :] < col_start[:, None] + WIN_W)
    dr = row_idx - r[:, None] + (WIN_H_MAX - 1)
    dc = np.clip(c[None, :] - c[:, None] + (WIN_W - 1), 0, 2 * WIN_W - 2)
    k_rows = kg[:, row_idx]
    v_rows = vg[:, row_idx]
    scores = jnp.einsum('brqhd,brjwhd->bhrqjw', qg, k_rows).astype(jnp.float32) * (HEAD_DIM ** -0.5)
    bias = rpb.astype(jnp.float32)[:, dr[:, None, :, None], dc[None, :, None, :]]
    scores = jnp.where(in_win[None, None, None, :, None, :], scores + bias[None], NEG_INF)
    shp = scores.shape
    probs = jax.nn.softmax(scores.reshape(shp[:4] + (kh * GRID_W,)), axis=-1).reshape(shp).astype(v.dtype)
    out = jnp.einsum('bhrqjw,brjwhd->brqhd', probs, v_rows)
    return out.reshape(b, l, ATTN_WIDTH)


def _cmul(ar, ai, br, bi):
    return ar * br - ai * bi, ar * bi + ai * br


def _ssm_combine(e1, e2):
    a1r, a1i, b1r, b1i = e1
    a2r, a2i, b2r, b2i = e2
    ar, ai = _cmul(a2r, a2i, a1r, a1i)
    br, bi = _cmul(a2r, a2i, b1r, b1i)
    return ar, ai, br + b2r, bi + b2i


def s5_direction(u, lam_re, lam_im, log_dt, b_re, b_im, c_re, c_im, reverse):
    lam_re = jnp.minimum(lam_re.astype(jnp.float32), LAM_RE_MAX)
    lam_im = lam_im.astype(jnp.float32)
    dt = jnp.exp(log_dt.astype(jnp.float32))[:, None]
    mag = jnp.exp(lam_re * dt)
    lbar_re = mag * jnp.cos(lam_im * dt)
    lbar_im = mag * jnp.sin(lam_im * dt)
    den = lam_re * lam_re + lam_im * lam_im
    nr = lbar_re - 1.0
    coef_re = (nr * lam_re + lbar_im * lam_im) / den
    coef_im = (lbar_im * lam_re - nr * lam_im) / den
    b_re = b_re.astype(jnp.float32)
    b_im = b_im.astype(jnp.float32)
    bb_re = coef_re[..., None] * b_re - coef_im[..., None] * b_im
    bb_im = coef_re[..., None] * b_im + coef_im[..., None] * b_re
    bu_re = jnp.einsum('blgh,gph->blgp', u, bb_re)
    bu_im = jnp.einsum('blgh,gph->blgp', u, bb_im)
    l = u.shape[1]
    a_re = jnp.broadcast_to(lbar_re, (1, l) + lbar_re.shape)
    a_im = jnp.broadcast_to(lbar_im, (1, l) + lbar_im.shape)
    _, _, s_re, s_im = lax.associative_scan(_ssm_combine, (a_re, a_im, bu_re, bu_im), reverse=reverse, axis=1)
    return (jnp.einsum('blgp,ghp->blgh', s_re, c_re.astype(jnp.float32))
            - jnp.einsum('blgp,ghp->blgh', s_im, c_im.astype(jnp.float32)))


def s5_mixer(u, lam_re_fwd, lam_im_fwd, log_dt_fwd, b_re_fwd, b_im_fwd, c_re_fwd, c_im_fwd,
             lam_re_bwd, lam_im_bwd, log_dt_bwd, b_re_bwd, b_im_bwd, c_re_bwd, c_im_bwd,
             d_skip, w_glu, b_glu):
    b, l, _ = u.shape
    uf = u.astype(jnp.float32).reshape(b, l, N_GROUPS, SSM_GROUP)
    y = (s5_direction(uf, lam_re_fwd, lam_im_fwd, log_dt_fwd, b_re_fwd, b_im_fwd, c_re_fwd, c_im_fwd, False)
         + s5_direction(uf, lam_re_bwd, lam_im_bwd, log_dt_bwd, b_re_bwd, b_im_bwd, c_re_bwd, c_im_bwd, True))
    y = y.reshape(b, l, SSM_WIDTH) + d_skip.astype(jnp.float32) * uf.reshape(b, l, SSM_WIDTH)
    z = jax.nn.gelu(y).astype(u.dtype)
    return z * jax.nn.sigmoid(z @ w_glu + b_glu)


def _layer(h, pe, g_pre_mix, w_in, rpb,
           lam_re_fwd, lam_im_fwd, log_dt_fwd, b_re_fwd, b_im_fwd, c_re_fwd, c_im_fwd,
           lam_re_bwd, lam_im_bwd, log_dt_bwd, b_re_bwd, b_im_bwd, c_re_bwd, c_im_bwd,
           d_skip, w_glu, b_glu, g_attn_out, g_ssm_out, w_out, g_post_mix,
           g_pre_mlp, w_up, w_down, g_post_mlp, g_ple, w_ple_gate, w_ple):
    a = rms_norm(h, g_pre_mix)
    proj = a @ w_in
    q = proj[..., :ATTN_WIDTH]
    k = proj[..., ATTN_WIDTH:2 * ATTN_WIDTH]
    v = proj[..., 2 * ATTN_WIDTH:3 * ATTN_WIDTH]
    u = proj[..., 3 * ATTN_WIDTH:]
    att = neighbourhood_attention(q, k, v, rpb)
    ssm = s5_mixer(u, lam_re_fwd, lam_im_fwd, log_dt_fwd, b_re_fwd, b_im_fwd, c_re_fwd, c_im_fwd,
                   lam_re_bwd, lam_im_bwd, log_dt_bwd, b_re_bwd, b_im_bwd, c_re_bwd, c_im_bwd,
                   d_skip, w_glu, b_glu)
    mix = jnp.concatenate([rms_norm(att, g_attn_out), rms_norm(ssm, g_ssm_out)], axis=-1) @ w_out
    h = h + rms_norm(mix, g_post_mix)
    m = rms_norm(h, g_pre_mlp)
    m = jnp.square(jax.nn.relu(m @ w_up)) @ w_down
    h = h + rms_norm(m, g_post_mlp)
    gate = jax.nn.sigmoid(rms_norm(h, g_ple) @ w_ple_gate)
    return h + (pe.astype(h.dtype) @ w_ple) * gate


def _trunk(x, p, weights):
    h = x
    for i in range(DEPTH):
        h = _layer(h, p[i], *[w[i] for w in weights])
    return h


def _normal(key, shape, scale):
    return scale * jax.random.normal(key, shape, dtype=jnp.float32)


def setup_inputs(seed: int = 0) -> dict:
    key = jax.random.key(seed)
    ks = jax.random.split(key, 40)
    L = DEPTH
    f32 = jnp.float32

    def gain(k, n):
        return 1.0 + _normal(k, (L, n), 0.05)

    def lam_re(k):
        return -0.5 + _normal(k, (L, N_GROUPS, STATE_P), 0.01)

    def lam_im(k):
        return math.pi * jnp.arange(STATE_P, dtype=f32) + _normal(k, (L, N_GROUPS, STATE_P), 0.01)

    def log_dt(k):
        return jax.random.uniform(k, (L, N_GROUPS), f32, math.log(DT_MIN), math.log(DT_MAX))

    b_scale = (2 * SSM_GROUP) ** -0.5
    c_scale = (2 * STATE_P) ** -0.5
    return {
        'x_prompt': _normal(ks[0], (BATCH, SEQ, D_MODEL), 1.0),
        'x_sample': _normal(ks[1], (DEC_BATCH, DEC_SEQ, D_MODEL), 1.0),
        'p_prompt': _normal(ks[2], (DEPTH, BATCH, SEQ, PLE_DIM), 1.0),
        'p_sample': _normal(ks[3], (DEPTH, DEC_BATCH, DEC_SEQ, PLE_DIM), 1.0),
        'g_pre_mix': gain(ks[4], D_MODEL),
        'w_in': _normal(ks[5], (L, D_MODEL, IN_WIDTH), D_MODEL ** -0.5),
        'rpb': _normal(ks[6], (L, N_HEADS, 2 * WIN_H_MAX - 1, 2 * WIN_W - 1), 0.02),
        'lam_re_fwd': lam_re(ks[7]),
        'lam_im_fwd': lam_im(ks[8]),
        'log_dt_fwd': log_dt(ks[9]),
        'b_re_fwd': _normal(ks[10], (L, N_GROUPS, STATE_P, SSM_GROUP), b_scale),
        'b_im_fwd': _normal(ks[11], (L, N_GROUPS, STATE_P, SSM_GROUP), b_scale),
        'c_re_fwd': _normal(ks[12], (L, N_GROUPS, SSM_GROUP, STATE_P), c_scale),
        'c_im_fwd': _normal(ks[13], (L, N_GROUPS, SSM_GROUP, STATE_P), c_scale),
        'lam_re_bwd': lam_re(ks[14]),
        'lam_im_bwd': lam_im(ks[15]),
        'log_dt_bwd': log_dt(ks[16]),
        'b_re_bwd': _normal(ks[17], (L, N_GROUPS, STATE_P, SSM_GROUP), b_scale),
        'b_im_bwd': _normal(ks[18], (L, N_GROUPS, STATE_P, SSM_GROUP), b_scale),
        'c_re_bwd': _normal(ks[19], (L, N_GROUPS, SSM_GROUP, STATE_P), c_scale),
        'c_im_bwd': _normal(ks[20], (L, N_GROUPS, SSM_GROUP, STATE_P), c_scale),
        'd_skip': _normal(ks[21], (L, SSM_WIDTH), 1.0),
        'w_glu': _normal(ks[22], (L, SSM_WIDTH, SSM_WIDTH), SSM_WIDTH ** -0.5),
        'b_glu': _normal(ks[23], (L, SSM_WIDTH), 0.01),
        'g_attn_out': gain(ks[24], ATTN_WIDTH),
        'g_ssm_out': gain(ks[25], SSM_WIDTH),
        'w_out': _normal(ks[26], (L, MIX_WIDTH, D_MODEL), MIX_WIDTH ** -0.5),
        'g_post_mix': gain(ks[27], D_MODEL),
        'g_pre_mlp': gain(ks[28], D_MODEL),
        'w_up': _normal(ks[29], (L, D_MODEL, D_FF), D_MODEL ** -0.5),
        'w_down': _normal(ks[30], (L, D_FF, D_MODEL), D_FF ** -0.5),
        'g_post_mlp': gain(ks[31], D_MODEL),
        'g_ple': gain(ks[32], D_MODEL),
        'w_ple_gate': _normal(ks[33], (L, D_MODEL, D_MODEL), D_MODEL ** -0.5),
        'w_ple': _normal(ks[34], (L, PLE_DIM, D_MODEL), PLE_DIM ** -0.5),
    }


def reference(x_prompt, x_sample, p_prompt, p_sample, g_pre_mix, w_in, rpb,
              lam_re_fwd, lam_im_fwd, log_dt_fwd, b_re_fwd, b_im_fwd, c_re_fwd, c_im_fwd,
              lam_re_bwd, lam_im_bwd, log_dt_bwd, b_re_bwd, b_im_bwd, c_re_bwd, c_im_bwd,
              d_skip, w_glu, b_glu, g_attn_out, g_ssm_out, w_out, g_post_mix,
              g_pre_mlp, w_up, w_down, g_post_mlp, g_ple, w_ple_gate, w_ple):
    weights = (g_pre_mix, w_in, rpb,
               lam_re_fwd, lam_im_fwd, log_dt_fwd, b_re_fwd, b_im_fwd, c_re_fwd, c_im_fwd,
               lam_re_bwd, lam_im_bwd, log_dt_bwd, b_re_bwd, b_im_bwd, c_re_bwd, c_im_bwd,
               d_skip, w_glu, b_glu, g_attn_out, g_ssm_out, w_out, g_post_mix,
               g_pre_mlp, w_up, w_down, g_post_mlp, g_ple, w_ple_gate, w_ple)
    y_prompt = _trunk(x_prompt, p_prompt, weights)
    y_sample = _trunk(x_sample, p_sample, weights)
    return (y_prompt, y_sample)
```

```cpp
#include <hip/hip_runtime.h>
#include <cstdio>
#include <cstdint>

#define GAS __attribute__((address_space(1)))
#define LAS __attribute__((address_space(3)))
typedef unsigned short bf16;
typedef short bf16x8 __attribute__((ext_vector_type(8)));
typedef float f32x4 __attribute__((ext_vector_type(4)));
typedef float f32x2 __attribute__((ext_vector_type(2)));
typedef unsigned u32x4 __attribute__((ext_vector_type(4)));
typedef unsigned u32x2 __attribute__((ext_vector_type(2)));

constexpr int T = 24576, TPR = 8192, D = 4096, AW = 2048, NH = 16, HD = 128, NG = 128, SP = 64, DFF = 16384, PLE = 256, NIN = 8192;
constexpr float RMS_EPS = 1e-6f;
constexpr float LOG2E = 1.4426950408889634f;
constexpr float QSCALE = 0.08838834764831845f * 1.4426950408889634f;

constexpr size_t MiB = 1u << 20;
constexpr size_t WS_CTL = 0, CTL_ZERO_BYTES = 1 * MiB;
constexpr size_t WS_RSTD0 = 1 * MiB, WS_RSTD1 = WS_RSTD0 + 128 * 1024, WS_RSTD2 = WS_RSTD1 + 128 * 1024, WS_RATIO = WS_RSTD2 + 128 * 1024, WS_RSSSM = WS_RATIO + 128 * 1024;
constexpr size_t WS_PSATT = 2 * MiB, WS_PSSSM = 4 * MiB, WS_PSMIX = 8 * MiB, WS_PSM = 14 * MiB;
constexpr size_t WS_PEB = 24 * MiB;
constexpr size_t WS_KTAB = 36 * MiB, WS_MC = 40 * MiB, WS_MB = 72 * MiB;
constexpr size_t WS_WIN = 104 * MiB, WS_WGLU = 168 * MiB, WS_WOUT = 176 * MiB;
constexpr size_t WS_XB = 208 * MiB;
constexpr size_t WS_Q = 400 * MiB, WS_K = 496 * MiB, WS_V = 592 * MiB, WS_UG = 688 * MiB, WS_Z = 784 * MiB, WS_S = 880 * MiB, WS_HB = 976 * MiB;
constexpr size_t WS_WUP = 400 * MiB, WS_WDOWN = 528 * MiB, WS_WGATE = 656 * MiB, WS_WPLE = 688 * MiB;
constexpr size_t WS_HBUF = 692 * MiB;
constexpr size_t WS_MCH = 36 * MiB;
constexpr size_t WS_PP = 692 * MiB;
constexpr size_t WS_END = 1024 * MiB;
constexpr int MCHUNK = 8192, NCHUNK = T / MCHUNK;

constexpr int CW_BAR = 4096;

constexpr int RING_BYTES = 131072;
constexpr int MISC_OFF = RING_BYTES + 320;
constexpr int LDS_BYTES = 147456;
constexpr int NWAVES = 8;

__device__ __forceinline__ unsigned cvt_pk_bf16(float lo, float hi) { unsigned r; asm volatile("v_cvt_pk_bf16_f32 %0, %1, %2" : "=v"(r) : "v"(lo), "v"(hi)); return r; }
__device__ __forceinline__ float bf_lo(unsigned v) { return __builtin_bit_cast(float, v << 16); }
__device__ __forceinline__ float bf_hi(unsigned v) { return __builtin_bit_cast(float, v & 0xffff0000u); }
__device__ __forceinline__ float wave_sum(float v) {
#pragma unroll
    for (int o = 1; o < 64; o <<= 1) v += __shfl_xor(v, o);
    return v;
}
__device__ __forceinline__ float wave_max(float v) {
#pragma unroll
    for (int o = 1; o < 64; o <<= 1) v = fmaxf(v, __shfl_xor(v, o));
    return v;
}
__device__ __forceinline__ int lane_id() { return (int)__builtin_amdgcn_mbcnt_hi(~0u, __builtin_amdgcn_mbcnt_lo(~0u, 0u)); }
__device__ __forceinline__ int lane_op() { int l = lane_id(); asm volatile("" : "+v"(l)); return l; }
__device__ __forceinline__ float sigmoidf_(float x) { return 1.0f / (1.0f + __expf(-x)); }
__device__ __forceinline__ float gelu_tanh(float x) { const float a = 1.5957691216057308f * (x + 0.044715f * x * x * x); return x / (1.0f + __expf(-a)); }

namespace pg8 {
#define PG8_LAS __attribute__((address_space(3)))
typedef unsigned short bf16_t;
constexpr int BM = 256, BK = 64, HALF = 128, HTB = HALF * BK * 2, STAGE_BYTES = 8 * HTB, NXCD = 8, WGM = 8;
__host__ __device__ __forceinline__ int lds_byte(int r, int c) { const int st = (r >> 4) * 2 + (c >> 5), rr = r & 15, cc = c & 31, ob = rr * 64 + cc * 2; return st * 1024 + (ob ^ (((ob >> 9) & 1) << 5)); }
__host__ __device__ __forceinline__ void stage_rc(int b, int& R, int& C) { const int st = b / 1024, sb = b % 1024, swz = sb ^ (((sb >> 9) & 1) << 5); R = (st >> 1) * 16 + swz / 64; C = (st & 1) * 32 + (swz % 64) / 2; }
__host__ __device__ __forceinline__ int perm32(int rho) { const int n = rho >> 4, i = rho & 15; return 8 * (i >> 2) + 4 * n + (i & 3); }
struct Unit { int pm, pn; };
struct Gemm { const bf16_t* A; const bf16_t* Bt; int M, N, K, wave; };
struct StaticOrder {
    int nM, nN, nwg, G, c;
    __host__ __device__ void init(int M, int N, int G_, int c_) { nM = M / BM; nN = N / BM; nwg = nM * nN; G = G_; c = c_; }
    __host__ __device__ bool next(int i, Unit& u) const {
        const long L = (long)i * G + c; if (L >= nwg) return false;
        int wgid = (int)L; { const int q = nwg / NXCD, r = nwg % NXCD, xcd = wgid % NXCD, off = wgid / NXCD; wgid = (xcd < r ? xcd * (q + 1) : r * (q + 1) + (xcd - r) * q) + off; }
        const int nig = WGM * nN, gid = wgid / nig, fm = gid * WGM, gsz = (nM - fm) < WGM ? (nM - fm) : WGM;
        u.pm = fm + ((wgid % nig) % gsz); u.pn = (wgid % nig) / gsz; return true;
    }
    __device__ __forceinline__ void a_ready(const Unit&) const {}
    __device__ __forceinline__ void done(const Unit&) const {}
};

template <class Epi, class Sched, bool ALIGN_EPI = false, bool SP2 = false>
__device__ __forceinline__ void gemm_phase(PG8_LAS unsigned char* lds, const Gemm g, const Sched& S, const Epi& E) {
    const int lane = lane_op(), wid = g.wave, tid = wid * 64 + lane, wr = wid >> 2, wc = wid & 3, fr = lane & 15, fq = lane >> 4;
    const int K = g.K, nt = K / BK;
    unsigned voffA[2], voffB[2];
#pragma unroll
    for (int i = 0; i < 2; ++i) { int R, C; stage_rc(tid * 16 + i * 8192, R, C); const int Rb = Epi::PERM ? ((R & ~31) + perm32(R & 31)) : R;
        voffA[i] = (unsigned)(R * K + C) * 2u; voffB[i] = (unsigned)(Rb * K + C) * 2u; }
    const size_t kstep = (size_t)(BK * 2);
    const size_t hstep = (size_t)HALF * K * 2;
    const size_t tstep = 2 * hstep;
    const unsigned ldsw = (unsigned)wid * 1024u;
    const int aoff = lds_byte(wr * 64 + fr, fq * 8), boff = lds_byte(wc * 32 + fr, fq * 8);
#define PG8_SA(b, h) (((b) * 2 + (h)) * HTB)
#define PG8_SB(b, h) ((4 + (b) * 2 + (h)) * HTB)
#define PG8_STAGE(bufoff, gbase, voff) do { _Pragma("unroll") for (int _i = 0; _i < 2; ++_i) \
        __builtin_amdgcn_global_load_lds((const unsigned*)((const char*)(gbase) + (voff)[_i]), (PG8_LAS unsigned*)(lds + (bufoff) + ldsw + _i * 8192), 16, 0, 0); } while (0)
#define PG8_LDA(dst, b, h) do { _Pragma("unroll") for (int m = 0; m < 4; ++m) _Pragma("unroll") for (int k = 0; k < 2; ++k) dst[m][k] = *(const PG8_LAS bf16x8*)(lds + PG8_SA(b, h) + aoff + m * 2048 + k * 1024); } while (0)
#define PG8_LDB(dst, b, h) do { _Pragma("unroll") for (int n = 0; n < 2; ++n) _Pragma("unroll") for (int k = 0; k < 2; ++k) dst[n][k] = *(const PG8_LAS bf16x8*)(lds + PG8_SB(b, h) + boff + n * 2048 + k * 1024); } while (0)
#define PG8_MMA(ai, bj, At, Bt) do { __builtin_amdgcn_s_setprio(1); _Pragma("unroll") for (int m = 0; m < 4; ++m) _Pragma("unroll") for (int n = 0; n < 2; ++n) _Pragma("unroll") for (int k = 0; k < 2; ++k) \
        acc[ai][bj][m][n] = __builtin_amdgcn_mfma_f32_16x16x32_bf16(Bt[n][k], At[m][k], acc[ai][bj][m][n], 0, 0, 0); __builtin_amdgcn_s_setprio(0); } while (0)
#define PG8_WAIT_V(n) asm volatile("s_waitcnt vmcnt(" #n ")" ::: "memory")
#define PG8_WAIT_L(n) asm volatile("s_waitcnt lgkmcnt(" #n ")" ::: "memory")
#define PG8_BAR __builtin_amdgcn_s_barrier()
#define PG8_SCHED __builtin_amdgcn_sched_barrier(0)
    Unit cur, nxt; int ui = 0;
    if (!S.next(0, cur)) return;
    f32x4 acc[2][2][4][2];
#pragma unroll
    for (int a = 0; a < 2; ++a)
#pragma unroll
        for (int b = 0; b < 2; ++b)
#pragma unroll
            for (int m = 0; m < 4; ++m)
#pragma unroll
                for (int n = 0; n < 2; ++n) acc[a][b][m][n] = (f32x4){0.f, 0.f, 0.f, 0.f};
    bf16x8 At[4][2], B0[2][2], B1[2][2];
    const char* cA = (const char*)g.A + (size_t)cur.pm * tstep; const char* cB = (const char*)g.Bt + (size_t)cur.pn * tstep;
    S.a_ready(cur);
    if constexpr (SP2) {
        PG8_STAGE(PG8_SB(0, 0), cB, voffB); PG8_STAGE(PG8_SB(0, 1), cB + hstep, voffB); PG8_STAGE(PG8_SA(0, 0), cA, voffA); PG8_STAGE(PG8_SA(0, 1), cA + hstep, voffA);
        if (wr == 1) PG8_BAR;
        PG8_WAIT_V(2); PG8_BAR;
        PG8_STAGE(PG8_SB(1, 0), cB + kstep, voffB); PG8_STAGE(PG8_SA(1, 0), cA + kstep, voffA); PG8_STAGE(PG8_SB(1, 1), cB + hstep + kstep, voffB);
        PG8_WAIT_V(6); PG8_BAR;
    } else {
        PG8_STAGE(PG8_SB(0, 0), cB, voffB); PG8_STAGE(PG8_SA(0, 0), cA, voffA); PG8_STAGE(PG8_SB(0, 1), cB + hstep, voffB); PG8_STAGE(PG8_SA(0, 1), cA + hstep, voffA);
        if (wr == 1) PG8_BAR;
        PG8_WAIT_V(4); PG8_BAR;
        PG8_STAGE(PG8_SB(1, 0), cB + kstep, voffB); PG8_STAGE(PG8_SA(1, 0), cA + kstep, voffA); PG8_STAGE(PG8_SB(1, 1), cB + hstep + kstep, voffB);
        PG8_WAIT_V(6); PG8_BAR;
    }
    for (;;) {
        const bool has_next = S.next(ui + 1, nxt);
        const char* nA = has_next ? (const char*)g.A + (size_t)nxt.pm * tstep : cA; const char* nB = has_next ? (const char*)g.Bt + (size_t)nxt.pn * tstep : cB;
#pragma nounroll
        for (int t = 0; t < nt; t += 2) {
            const bool last = (t == nt - 2);
            const char* a1 = cA + (size_t)(t + 1) * kstep;
            const char* a2 = last ? nA : cA + (size_t)(t + 2) * kstep; const char* b2 = last ? nB : cB + (size_t)(t + 2) * kstep;
            const char* a3 = a2 + kstep; const char* b3 = b2 + kstep;
            if (last && has_next) S.a_ready(nxt);
            if constexpr (Epi::MIDK) { if (t == (nt >> 1)) E.midk(acc, cur, wr, wc, fr, fq); }
            if constexpr (SP2) {
            PG8_LDB(B0, 0, 0); PG8_LDB(B1, 0, 1); PG8_SCHED; PG8_LDA(At, 0, 0); PG8_STAGE(PG8_SA(1, 1), a1 + hstep, voffA);
            PG8_WAIT_V(8); PG8_WAIT_L(0); PG8_BAR; PG8_MMA(0, 0, At, B0); PG8_MMA(0, 1, At, B1); PG8_BAR; PG8_SCHED;
            PG8_LDA(At, 0, 1); PG8_STAGE(PG8_SB(0, 0), b2, voffB); PG8_STAGE(PG8_SB(0, 1), b2 + hstep, voffB); PG8_STAGE(PG8_SA(0, 0), a2, voffA);
            PG8_WAIT_V(8); PG8_WAIT_L(0); PG8_BAR; PG8_MMA(1, 0, At, B0); PG8_MMA(1, 1, At, B1); PG8_BAR; PG8_SCHED;
            PG8_LDB(B0, 1, 0); PG8_LDB(B1, 1, 1); PG8_SCHED; PG8_LDA(At, 1, 0); PG8_STAGE(PG8_SA(0, 1), a2 + hstep, voffA);
            PG8_WAIT_V(8); PG8_WAIT_L(0); PG8_BAR; PG8_MMA(0, 0, At, B0); PG8_MMA(0, 1, At, B1); PG8_BAR; PG8_SCHED;
            PG8_LDA(At, 1, 1); PG8_STAGE(PG8_SB(1, 0), b3, voffB); PG8_STAGE(PG8_SB(1, 1), b3 + hstep, voffB); PG8_STAGE(PG8_SA(1, 0), a3, voffA);
            PG8_WAIT_V(8); PG8_WAIT_L(0); PG8_BAR; PG8_MMA(1, 0, At, B0); PG8_MMA(1, 1, At, B1); PG8_BAR; PG8_SCHED;
            } else {
            PG8_LDB(B0, 0, 0); PG8_SCHED; PG8_LDA(At, 0, 0); PG8_STAGE(PG8_SA(1, 1), a1 + hstep, voffA);
            PG8_WAIT_L(8); PG8_BAR; PG8_WAIT_L(0); PG8_MMA(0, 0, At, B0); PG8_BAR; PG8_SCHED;
            PG8_LDB(B1, 0, 1); PG8_STAGE(PG8_SB(0, 0), b2, voffB);
            PG8_BAR; PG8_WAIT_L(0); PG8_MMA(0, 1, At, B1); PG8_BAR;
            PG8_LDA(At, 0, 1); PG8_STAGE(PG8_SA(0, 0), a2, voffA);
            PG8_BAR; PG8_WAIT_L(0); PG8_MMA(1, 0, At, B0); PG8_BAR; PG8_SCHED;
            PG8_STAGE(PG8_SB(0, 1), b2 + hstep, voffB);
            PG8_WAIT_V(6); PG8_BAR; PG8_MMA(1, 1, At, B1); PG8_BAR;
            PG8_LDB(B0, 1, 0); PG8_SCHED; PG8_LDA(At, 1, 0); PG8_STAGE(PG8_SA(0, 1), a2 + hstep, voffA);
            PG8_WAIT_L(8); PG8_BAR; PG8_WAIT_L(0); PG8_MMA(0, 0, At, B0); PG8_BAR; PG8_SCHED;
            PG8_LDB(B1, 1, 1); PG8_STAGE(PG8_SB(1, 0), b3, voffB);
            PG8_BAR; PG8_WAIT_L(0); PG8_MMA(0, 1, At, B1); PG8_BAR;
            PG8_LDA(At, 1, 1); PG8_STAGE(PG8_SA(1, 0), a3, voffA);
            PG8_BAR; PG8_WAIT_L(0); PG8_MMA(1, 0, At, B0); PG8_BAR; PG8_SCHED;
            PG8_STAGE(PG8_SB(1, 1), b3 + hstep, voffB);
            PG8_WAIT_V(6); PG8_BAR; PG8_MMA(1, 1, At, B1); PG8_BAR;
            }
        }
        if constexpr (ALIGN_EPI) { if (wr == 0) PG8_BAR; }
        E(acc, cur, wr, wc, fr, fq); S.done(cur);
        if (!has_next) break;
#pragma unroll
        for (int a = 0; a < 2; ++a)
#pragma unroll
            for (int b = 0; b < 2; ++b)
#pragma unroll
                for (int m = 0; m < 4; ++m)
#pragma unroll
                    for (int n = 0; n < 2; ++n) acc[a][b][m][n] = (f32x4){0.f, 0.f, 0.f, 0.f};
        cur = nxt; cA = nA; cB = nB; ++ui;
        if constexpr (ALIGN_EPI) { if (wr == 1) PG8_BAR; }
    }
    PG8_WAIT_V(0);
    if constexpr (!ALIGN_EPI) { if (wr == 0) PG8_BAR; }
    PG8_BAR;
#undef PG8_SA
#undef PG8_SB
#undef PG8_STAGE
#undef PG8_LDA
#undef PG8_LDB
#undef PG8_MMA
#undef PG8_WAIT_V
#undef PG8_WAIT_L
#undef PG8_BAR
#undef PG8_SCHED
}

typedef f32x4 Acc[2][2][4][2];

struct EpiProj {
    static constexpr bool PERM = true, MIDK = false;
    bf16_t *Q, *Ug; const float* rstd;
    __device__ __forceinline__ void operator()(const Acc& acc, const Unit& u, int wr, int wc, int fr, int fq) const {
        const int row0 = u.pm * BM + wr * 64 + fr; const int t = u.pn >> 3;
        const int colt = (u.pn & 7) * BM + wc * 32 + 8 * fq;
        bf16_t* base = Q + (size_t)t * ((size_t)T * AW);
#pragma unroll
        for (int ai = 0; ai < 2; ++ai)
#pragma unroll
            for (int m = 0; m < 4; ++m) { const int row = row0 + ai * HALF + m * 16; const float rs = rstd[row];
#pragma unroll
                for (int bj = 0; bj < 2; ++bj) { const f32x4 v0 = acc[ai][bj][m][0] * rs, v1 = acc[ai][bj][m][1] * rs;
                    u32x4 w; w.x = cvt_pk_bf16(v0[0], v0[1]); w.y = cvt_pk_bf16(v0[2], v0[3]); w.z = cvt_pk_bf16(v1[0], v1[1]); w.w = cvt_pk_bf16(v1[2], v1[3]);
                    const int col = colt + bj * HALF;
                    if (t < 3) *(u32x4*)(base + (size_t)row * AW + col) = w;
                    else *(u32x4*)(Ug + ((size_t)(col >> 4) * T + row) * 16 + (col & 15)) = w; } }
    }
};
struct EpiGlu {
    static constexpr bool PERM = true, MIDK = false;
    const bf16_t* Z; bf16_t* cat; const float* bglu; float* ps;
    __device__ __forceinline__ void operator()(const Acc& acc, const Unit& u, int wr, int wc, int fr, int fq) const {
        const int row0 = u.pm * BM + wr * 64 + fr; const int col0 = u.pn * BM + wc * 32 + 8 * fq;
        f32x4 bv[2][2];
#pragma unroll
        for (int bj = 0; bj < 2; ++bj)
#pragma unroll
            for (int n = 0; n < 2; ++n) bv[bj][n] = *(const f32x4*)(bglu + col0 + bj * HALF + 4 * n);
#pragma unroll
        for (int ai = 0; ai < 2; ++ai)
#pragma unroll
            for (int m = 0; m < 4; ++m) { const int row = row0 + ai * HALF + m * 16; float ssq = 0.f;
#pragma unroll
                for (int bj = 0; bj < 2; ++bj) { const int col = col0 + bj * HALF;
                    const u32x4 zr = *(const u32x4*)(Z + (size_t)row * AW + col);
                    const f32x4 a0 = acc[ai][bj][m][0] + bv[bj][0], a1 = acc[ai][bj][m][1] + bv[bj][1];
                    f32x4 s0, s1;
                    s0[0] = bf_lo(zr.x) * sigmoidf_(a0[0]); s0[1] = bf_hi(zr.x) * sigmoidf_(a0[1]); s0[2] = bf_lo(zr.y) * sigmoidf_(a0[2]); s0[3] = bf_hi(zr.y) * sigmoidf_(a0[3]);
                    s1[0] = bf_lo(zr.z) * sigmoidf_(a1[0]); s1[1] = bf_hi(zr.z) * sigmoidf_(a1[1]); s1[2] = bf_lo(zr.w) * sigmoidf_(a1[2]); s1[3] = bf_hi(zr.w) * sigmoidf_(a1[3]);
                    ssq += (s0[0] * s0[0] + s0[1] * s0[1]) + (s0[2] * s0[2] + s0[3] * s0[3]) + (s1[0] * s1[0] + s1[1] * s1[1]) + (s1[2] * s1[2] + s1[3] * s1[3]);
                    u32x4 w; w.x = cvt_pk_bf16(s0[0], s0[1]); w.y = cvt_pk_bf16(s0[2], s0[3]); w.z = cvt_pk_bf16(s1[0], s1[1]); w.w = cvt_pk_bf16(s1[2], s1[3]);
                    *(u32x4*)(cat + (size_t)row * D + AW + col) = w; }
                ssq += __shfl_xor(ssq, 16); ssq += __shfl_xor(ssq, 32);
                if (fq == 0) ps[(size_t)row * 32 + u.pn * 4 + wc] = ssq;
                asm volatile("" ::: "memory"); }
    }
};
struct EpiOut {
    static constexpr bool PERM = false, MIDK = true;
    float* out; const float* ratio; const float* rsssm; float* ps;
    __device__ __forceinline__ void midk(Acc& acc, const Unit& u, int wr, int wc, int fr, int fq) const {
        const int row0 = u.pm * BM + wr * 64 + fr;
#pragma unroll
        for (int ai = 0; ai < 2; ++ai)
#pragma unroll
            for (int m = 0; m < 4; ++m) { const float r = ratio[row0 + ai * HALF + m * 16];
#pragma unroll
                for (int bj = 0; bj < 2; ++bj)
#pragma unroll
                    for (int n = 0; n < 2; ++n) acc[ai][bj][m][n] = acc[ai][bj][m][n] * r; }
    }
    __device__ __forceinline__ void operator()(const Acc& acc, const Unit& u, int wr, int wc, int fr, int fq) const {
        const int row0 = u.pm * BM + wr * 64 + fr; const int col0 = u.pn * BM + wc * 32 + 4 * fq;
#pragma unroll
        for (int ai = 0; ai < 2; ++ai)
#pragma unroll
            for (int m = 0; m < 4; ++m) { const int row = row0 + ai * HALF + m * 16; const float rs = rsssm[row]; float ssq = 0.f;
#pragma unroll
                for (int bj = 0; bj < 2; ++bj)
#pragma unroll
                    for (int n = 0; n < 2; ++n) { const f32x4 v = acc[ai][bj][m][n] * rs; ssq += (v[0] * v[0] + v[1] * v[1]) + (v[2] * v[2] + v[3] * v[3]);
                        *(f32x4*)(out + (size_t)row * D + col0 + bj * HALF + n * 16) = v; }
                ssq += __shfl_xor(ssq, 16); ssq += __shfl_xor(ssq, 32);
                if (fq == 0) ps[(size_t)row * 64 + u.pn * 4 + wc] = ssq; }
    }
};
struct EpiUp {
    static constexpr bool PERM = true, MIDK = false;
    bf16_t* H; const float* rstd; int row_off;
    __device__ __forceinline__ void operator()(const Acc& acc, const Unit& u, int wr, int wc, int fr, int fq) const {
        const int row0 = u.pm * BM + wr * 64 + fr; const int col0 = u.pn * BM + wc * 32 + 8 * fq;
#pragma unroll
        for (int ai = 0; ai < 2; ++ai)
#pragma unroll
            for (int m = 0; m < 4; ++m) { const int row = row0 + ai * HALF + m * 16; const float rs = rstd[row_off + row];
#pragma unroll
                for (int bj = 0; bj < 2; ++bj) { f32x4 v0 = acc[ai][bj][m][0] * rs, v1 = acc[ai][bj][m][1] * rs;
#pragma unroll
                    for (int j = 0; j < 4; ++j) { const float a = fmaxf(v0[j], 0.f), b = fmaxf(v1[j], 0.f); v0[j] = a * a; v1[j] = b * b; }
                    u32x4 w; w.x = cvt_pk_bf16(v0[0], v0[1]); w.y = cvt_pk_bf16(v0[2], v0[3]); w.z = cvt_pk_bf16(v1[0], v1[1]); w.w = cvt_pk_bf16(v1[2], v1[3]);
                    *(u32x4*)(H + (size_t)row * DFF + col0 + bj * HALF) = w; } }
    }
};
struct EpiDown {
    static constexpr bool PERM = false, MIDK = false;
    float* Mo; float* ps; int row_off;
    __device__ __forceinline__ void operator()(const Acc& acc, const Unit& u, int wr, int wc, int fr, int fq) const {
        const int row0 = u.pm * BM + wr * 64 + fr; const int col0 = u.pn * BM + wc * 32 + 4 * fq;
#pragma unroll
        for (int ai = 0; ai < 2; ++ai)
#pragma unroll
            for (int m = 0; m < 4; ++m) { const int row = row0 + ai * HALF + m * 16; float ssq = 0.f;
#pragma unroll
                for (int bj = 0; bj < 2; ++bj)
#pragma unroll
                    for (int n = 0; n < 2; ++n) { const f32x4 v = acc[ai][bj][m][n]; ssq += (v[0] * v[0] + v[1] * v[1]) + (v[2] * v[2] + v[3] * v[3]);
                        *(f32x4*)(Mo + (size_t)row * D + col0 + bj * HALF + n * 16) = v; }
                ssq += __shfl_xor(ssq, 16); ssq += __shfl_xor(ssq, 32);
                if (fq == 0) ps[(size_t)(row_off + row) * 64 + u.pn * 4 + wc] = ssq; }
    }
};
struct EpiPle {
    static constexpr bool PERM = true, MIDK = false;
    bf16_t* P;
    __device__ __forceinline__ void operator()(const Acc& acc, const Unit& u, int wr, int wc, int fr, int fq) const {
        const int row0 = u.pm * BM + wr * 64 + fr; const int col0 = u.pn * BM + wc * 32 + 8 * fq;
#pragma unroll
        for (int ai = 0; ai < 2; ++ai)
#pragma unroll
            for (int m = 0; m < 4; ++m) { const int row = row0 + ai * HALF + m * 16;
#pragma unroll
                for (int bj = 0; bj < 2; ++bj) { const f32x4 v0 = acc[ai][bj][m][0], v1 = acc[ai][bj][m][1];
                    u32x4 w; w.x = cvt_pk_bf16(v0[0], v0[1]); w.y = cvt_pk_bf16(v0[2], v0[3]); w.z = cvt_pk_bf16(v1[0], v1[1]); w.w = cvt_pk_bf16(v1[2], v1[3]);
                    *(u32x4*)(P + (size_t)row * D + col0 + bj * HALF) = w; } }
    }
};
struct EpiGate {
    static constexpr bool PERM = false, MIDK = false;
    float* out; const bf16_t* P; const float* rstd;
    __device__ __forceinline__ void operator()(const Acc& acc, const Unit& u, int wr, int wc, int fr, int fq) const {
        const int row0 = u.pm * BM + wr * 64 + fr; const int col0 = u.pn * BM + wc * 32 + 4 * fq;
#pragma unroll
        for (int ai = 0; ai < 2; ++ai)
#pragma unroll
            for (int m = 0; m < 4; ++m) { const int row = row0 + ai * HALF + m * 16; const float rs = rstd[row];
#pragma unroll
                for (int bj = 0; bj < 2; ++bj)
#pragma unroll
                    for (int n = 0; n < 2; ++n) { const size_t off = (size_t)row * D + col0 + bj * HALF + n * 16;
                        const f32x4 h2 = *(const f32x4*)(out + off); const u32x2 pr = *(const u32x2*)(P + off); const f32x4 a = acc[ai][bj][m][n] * rs;
                        f32x4 o; o[0] = h2[0] + bf_lo(pr.x) * sigmoidf_(a[0]); o[1] = h2[1] + bf_hi(pr.x) * sigmoidf_(a[1]); o[2] = h2[2] + bf_lo(pr.y) * sigmoidf_(a[2]); o[3] = h2[3] + bf_hi(pr.y) * sigmoidf_(a[3]);
                        *(f32x4*)(out + off) = o; }
                asm volatile("" ::: "memory"); }
    }
};
}

#define XB_TMO      128
#define XB_XCNT(j)  (256  + 64 * (j))
#define XB_XSUB(j)  (1280 + 64 * (j))
#define XB_XGEN(j)  (2304 + 64 * (j))
#define XB_TOP      3328
#define XB_TOPGEN   3392
#define XCD_BAR_WORDS 3456
#define XB_SPIN_CAP (1u << 18)
__device__ __forceinline__ unsigned xb_ld(unsigned* p)              { return __hip_atomic_load(p, __ATOMIC_RELAXED, __HIP_MEMORY_SCOPE_AGENT); }
__device__ __forceinline__ unsigned xb_add(unsigned* p, unsigned v) { return __hip_atomic_fetch_add(p, v, __ATOMIC_RELAXED, __HIP_MEMORY_SCOPE_AGENT); }
__device__ __forceinline__ unsigned xb_xcc_id() { return (unsigned)__builtin_amdgcn_s_getreg((3 << 11) | 20) & 0xFu; }
#define XB_SPIN(cond, bar) do { unsigned _sp = 0; while (cond) { __builtin_amdgcn_s_sleep(1); \
    if ((++_sp & 255u) == 0u) { if (xb_ld(&(bar)[XB_TMO])) break; if (_sp > XB_SPIN_CAP) { atomicAdd(&(bar)[XB_TMO], 1u); break; } } } } while (0)
struct XcdBarrier { unsigned* bar; unsigned x; volatile LAS unsigned* st; int wave; };
__device__ __forceinline__ XcdBarrier xcd_barrier_post(unsigned* bar, volatile LAS unsigned* st, int wave) {
    XcdBarrier b; b.bar = bar; b.x = xb_xcc_id(); b.st = st; b.wave = wave;
    if (wave == 0 && lane_id() == 0) (void)xb_add(&bar[XB_XCNT(b.x)], 1u);
    return b;
}
__device__ __forceinline__ void xcd_barrier_complete(unsigned* bar, unsigned x, unsigned& nloc, unsigned& nx) {
    const unsigned G = gridDim.x * gridDim.y * gridDim.z;
    unsigned sum, cnt, mine, sp = 0u;
    for (;;) {
        sum = 0u; cnt = 0u; mine = 0u;
#pragma unroll
        for (unsigned j = 0; j < 16; ++j) { const unsigned c = xb_ld(&bar[XB_XCNT(j)]); sum += c; cnt += (c > 0u) ? 1u : 0u; mine = (j == x) ? c : mine; }
        if (sum == G) break;
        __builtin_amdgcn_s_sleep(1);
        if ((++sp & 255u) == 0u) { if (xb_ld(&bar[XB_TMO])) break; if (sp > XB_SPIN_CAP) { atomicAdd(&bar[XB_TMO], 1u); break; } }
    }
    nloc = mine > 0u ? mine : 1u; nx = cnt > 0u ? cnt : 1u;
}
__device__ __forceinline__ void xcd_barrier(const XcdBarrier& b) {
    asm volatile("s_waitcnt vmcnt(0)" ::: "memory");
    __syncthreads();
    if (b.wave == 0 && lane_id() == 0) {
        unsigned* bar = b.bar;
        __builtin_amdgcn_s_waitcnt(0);
        unsigned nloc = b.st[0], nx = b.st[1];
        if (nloc == 0u) { xcd_barrier_complete(bar, b.x, nloc, nx); b.st[0] = nloc; b.st[1] = nx; }
        const unsigned old = xb_add(&bar[XB_XSUB(b.x)], 1u);
        const unsigned gen = old / nloc;
        if (old + 1u == (gen + 1u) * nloc) {
            __builtin_amdgcn_fence(__ATOMIC_RELEASE, "agent");
            asm volatile("s_waitcnt vmcnt(0)" ::: "memory");
            const unsigned og = xb_add(&bar[XB_TOP], 1u);
            const unsigned tg = og / nx;
            if (og + 1u == (tg + 1u) * nx) xb_add(&bar[XB_TOPGEN], 1u);
            else XB_SPIN(xb_ld(&bar[XB_TOPGEN]) == tg, bar);
            __builtin_amdgcn_fence(__ATOMIC_ACQUIRE, "agent");
            xb_add(&bar[XB_XGEN(b.x)], 1u);
            asm volatile("s_waitcnt vmcnt(0)" ::: "memory");
        } else {
            XB_SPIN(xb_ld(&bar[XB_XGEN(b.x)]) == gen, bar);
            __builtin_amdgcn_fence(__ATOMIC_ACQUIRE, "agent");
            asm volatile("s_waitcnt vmcnt(0)" ::: "memory");
        }
    }
    __syncthreads();
}

struct Args { const float* in[35]; float* out; unsigned char* ws; int ph_lo, ph_hi; };
template <int I> __device__ __forceinline__ const float* argp() {
    const unsigned long long kp = (unsigned long long)__builtin_amdgcn_kernarg_segment_ptr(); unsigned long long v;
    asm volatile("s_load_dwordx2 %0, %1, %2\n\ts_waitcnt lgkmcnt(0)" : "=s"(v) : "s"(kp), "n"(I * 8) : "memory");
    return (const float*)v;
}
#define ARGP(i) argp<(i)>()
struct Frame {
    LAS unsigned char* lds;
    int tid, lane, wave, G, gw, NGW;
    float* out; unsigned char* ws;
};
#define LDS_WAIT() asm volatile("s_waitcnt lgkmcnt(0)" ::: "memory")

__device__ __forceinline__ const float* xrow(const float* xp, const float* xs, int m) { return m < TPR ? xp + (size_t)m * D : xs + (size_t)(m - TPR) * D; }
__device__ __forceinline__ const float* perow(const float* pp_, const float* ps_, int m) { return m < TPR ? pp_ + (size_t)m * PLE : ps_ + (size_t)(m - TPR) * PLE; }

__device__ __forceinline__ void transpose_item(const float* W, int K, int N, bf16* WT, const float* gk, int ncs, float cscale, LAS float* scr, int item, int lane) {
    const int nblk = N / 32, kb = item / nblk, nb = item % nblk, k0 = 64 * kb, n0 = 32 * nb;
    const float cs = (n0 < ncs) ? cscale : 1.0f;
#pragma unroll 8
    for (int i = 0; i < 32; ++i) { const int kk = 2 * i + (lane >> 5); const float gs = gk ? gk[k0 + kk] * cs : cs;
        scr[kk * 33 + (lane & 31)] = W[(size_t)(k0 + kk) * N + n0 + (lane & 31)] * gs; }
    LDS_WAIT(); asm volatile("" ::: "memory");
    const int c = lane & 7;
#pragma unroll
    for (int j = 0; j < 4; ++j) { const int n = (lane >> 3) + 8 * j; const LAS float* s = scr + (8 * c) * 33 + n;
        u32x4 o; o.x = cvt_pk_bf16(s[0 * 33], s[1 * 33]); o.y = cvt_pk_bf16(s[2 * 33], s[3 * 33]); o.z = cvt_pk_bf16(s[4 * 33], s[5 * 33]); o.w = cvt_pk_bf16(s[6 * 33], s[7 * 33]);
        *(u32x4*)(WT + (size_t)(n0 + n) * K + k0 + 8 * c) = o; }
    LDS_WAIT(); asm volatile("" ::: "memory");
}

__device__ __forceinline__ void xb_row(const Frame& F, const float* xp, const float* xs, int m) {
    const f32x4* xr = (const f32x4*)xrow(xp, xs, m) + F.lane;
    bf16* orow = (bf16*)(F.ws + WS_XB) + (size_t)m * D;
    float ssq = 0.f;
#pragma unroll
    for (int j = 0; j < 16; ++j) { const f32x4 v = xr[64 * j]; ssq += (v[0] * v[0] + v[1] * v[1]) + (v[2] * v[2] + v[3] * v[3]);
        u32x2 w; w.x = cvt_pk_bf16(v[0], v[1]); w.y = cvt_pk_bf16(v[2], v[3]); *((u32x2*)orow + F.lane + 64 * j) = w; }
    ssq = wave_sum(ssq);
    if (F.lane == 0) ((float*)(F.ws + WS_RSTD0))[m] = 1.0f / sqrtf(ssq * (1.0f / D) + RMS_EPS);
}
__device__ __forceinline__ void row_pass(const Frame& F, const float* base, const float* add, const float* ps, const float* g, float* out, bf16* outb, float* rstd_out) {
    const float rsa = 1.0f / sqrtf(wave_sum(ps[F.lane]) * (1.0f / D) + RMS_EPS);
    float ssq = 0.f;
#pragma unroll
    for (int j = 0; j < 16; ++j) { const int c4 = F.lane + 64 * j;
        const f32x4 b = ((const f32x4*)base)[c4], a = ((const f32x4*)add)[c4], gg = ((const f32x4*)g)[c4];
        const f32x4 h = b + a * rsa * gg;
        ssq += (h[0] * h[0] + h[1] * h[1]) + (h[2] * h[2] + h[3] * h[3]);
        ((f32x4*)out)[c4] = h;
        u32x2 w; w.x = cvt_pk_bf16(h[0], h[1]); w.y = cvt_pk_bf16(h[2], h[3]); ((u32x2*)outb)[c4] = w;
        if ((j & 3) == 3) asm volatile("" ::: "memory"); }
    ssq = wave_sum(ssq);
    if (F.lane == 0) *rstd_out = 1.0f / sqrtf(ssq * (1.0f / D) + RMS_EPS);
}

__device__ __forceinline__ float dot8(const u32x4 a, const u32x4 b) {
    return (bf_lo(a.x) * bf_lo(b.x) + bf_hi(a.x) * bf_hi(b.x)) + (bf_lo(a.y) * bf_lo(b.y) + bf_hi(a.y) * bf_hi(b.y)) +
           (bf_lo(a.z) * bf_lo(b.z) + bf_hi(a.z) * bf_hi(b.z)) + (bf_lo(a.w) * bf_lo(b.w) + bf_hi(a.w) * bf_hi(b.w));
}
__device__ __forceinline__ void attn_slow_task(const Frame& F, const float* rpb, int tok, int h) {
    const int lane = F.lane;
    const bf16* Qb = (const bf16*)(F.ws + WS_Q); const bf16* Kb = (const bf16*)(F.ws + WS_K); const bf16* Vb = (const bf16*)(F.ws + WS_V);
    const int R = tok >> 6, c = tok & 63;
    int Rb, rows; if (R < 64) { Rb = 0; rows = 64; } else if (R < 128) { Rb = 64; rows = 64; } else { Rb = 128; rows = 256; }
    const int r = R - Rb;
    int rs = r - 4; rs = rs < 0 ? 0 : rs; rs = rs > rows - 8 ? rows - 8 : rs;
    int cs = c - 8; cs = cs < 0 ? 0 : cs; cs = cs > 48 ? 48 : cs;
    const u32x4* qp = (const u32x4*)(Qb + (size_t)tok * AW + h * HD);
    float sc[2];
#pragma unroll
    for (int j2 = 0; j2 < 2; ++j2) { const int kk = lane + 64 * j2, kr = kk >> 4, kc = cs + (kk & 15);
        const int ktok = (Rb + rs + kr) * 64 + kc;
        const u32x4* kp = (const u32x4*)(Kb + (size_t)ktok * AW + h * HD);
        float s = 0.f;
#pragma unroll
        for (int d8 = 0; d8 < 16; ++d8) s += dot8(qp[d8], kp[d8]);
        const int dr = (rs + kr) - r + 7; int dc = kc - c + 15; dc = dc < 0 ? 0 : dc; dc = dc > 30 ? 30 : dc;
        s += rpb[(h * 15 + dr) * 31 + dc] * LOG2E;
        sc[j2] = s; }
    const float mx = wave_max(fmaxf(sc[0], sc[1]));
    const float p0 = exp2f(sc[0] - mx), p1 = exp2f(sc[1] - mx);
    const float l = wave_sum(p0 + p1);
    float o0 = 0.f, o1 = 0.f;
    for (int kk = 0; kk < 128; ++kk) { const float pk = __shfl(kk < 64 ? p0 : p1, kk & 63);
        const int kr = kk >> 4, kc = cs + (kk & 15); const int ktok = (Rb + rs + kr) * 64 + kc;
        const unsigned vv = *(const unsigned*)(Vb + (size_t)ktok * AW + h * HD + 2 * lane);
        o0 += pk * bf_lo(vv); o1 += pk * bf_hi(vv); }
    const float inv = 1.0f / l; o0 *= inv; o1 *= inv;
    *(unsigned*)((bf16*)(F.ws + WS_XB) + (size_t)tok * D + h * HD + 2 * lane) = cvt_pk_bf16(o0, o1);
    const float ssq = wave_sum(o0 * o0 + o1 * o1);
    if (lane == 0) ((float*)(F.ws + WS_PSATT))[(size_t)tok * 16 + h] = ssq;
}

template <int dir> __device__ __forceinline__ void ssm_slow_task(const Frame& F, int task) {
    const int lane = F.lane, p = lane;
    const int g = (task >> 1) & 127, seq = task >> 8;
    const int t0 = seq == 0 ? 0 : (seq == 1 ? 4096 : 8192); const int L = seq == 2 ? 16384 : 4096;
    const float* lam_re = ARGP(dir ? 14 : 7); const float* lam_im = ARGP(dir ? 15 : 8); const float* log_dt = ARGP(dir ? 16 : 9);
    const float* b_re = ARGP(dir ? 17 : 10); const float* b_im = ARGP(dir ? 18 : 11); const float* c_re = ARGP(dir ? 19 : 12); const float* c_im = ARGP(dir ? 20 : 13);
    const float lr = fminf(lam_re[g * SP + p], -1e-4f), li = lam_im[g * SP + p], dt = expf(log_dt[g]);
    const float mag = expf(lr * dt); float sn, cs; sincosf(li * dt, &sn, &cs);
    const float lbr = mag * cs, lbi = mag * sn, den = lr * lr + li * li, nr = lbr - 1.0f;
    const float cr = (nr * lr + lbi * li) / den, ci = (lbi * lr - nr * li) / den;
    float bbr[16], bbi[16], ccr[16], cci[16];
#pragma unroll
    for (int h = 0; h < 16; ++h) { const float br = b_re[(size_t)(g * SP + p) * 16 + h], bi = b_im[(size_t)(g * SP + p) * 16 + h];
        bbr[h] = cr * br - ci * bi; bbi[h] = cr * bi + ci * br;
        ccr[h] = c_re[(size_t)(g * 16 + h) * SP + p]; cci[h] = c_im[(size_t)(g * 16 + h) * SP + p]; }
    const bf16* Ug = (const bf16*)(F.ws + WS_UG) + (size_t)g * T * 16;
    float* Y = F.out + (size_t)dir * T * AW;
    unsigned vz; asm volatile("v_mov_b32 %0, 0" : "=v"(vz));
    float sr = 0.f, si = 0.f;
    const int hsel = (lane >> 2) & 15; const bool b5 = lane & 32, b4 = lane & 16, b3 = lane & 8, b2 = lane & 4;
    for (int blk = 0; blk < L / 4; ++blk) {
        const int tb = dir ? (L - 4 - 4 * blk) : 4 * blk;
        const u32x4* up = (const u32x4*)(Ug + (size_t)(t0 + tb) * 16 + vz);
        u32x4 uu[8];
#pragma unroll
        for (int i = 0; i < 8; ++i) uu[i] = up[i];
#pragma unroll
        for (int s4 = 0; s4 < 4; ++s4) { const int ti = dir ? 3 - s4 : s4; const int tok = t0 + tb + ti;
            const u32x4 ua = dir ? uu[2 * (3 - s4)] : uu[2 * s4], ub = dir ? uu[2 * (3 - s4) + 1] : uu[2 * s4 + 1];
            float u[16];
            u[0] = bf_lo(ua.x); u[1] = bf_hi(ua.x); u[2] = bf_lo(ua.y); u[3] = bf_hi(ua.y); u[4] = bf_lo(ua.z); u[5] = bf_hi(ua.z); u[6] = bf_lo(ua.w); u[7] = bf_hi(ua.w);
            u[8] = bf_lo(ub.x); u[9] = bf_hi(ub.x); u[10] = bf_lo(ub.y); u[11] = bf_hi(ub.y); u[12] = bf_lo(ub.z); u[13] = bf_hi(ub.z); u[14] = bf_lo(ub.w); u[15] = bf_hi(ub.w);
            float bur = 0.f, bui = 0.f;
#pragma unroll
            for (int h = 0; h < 16; ++h) { bur += bbr[h] * u[h]; bui += bbi[h] * u[h]; }
            const float nsr = lbr * sr - lbi * si + bur, nsi = lbr * si + lbi * sr + bui; sr = nsr; si = nsi;
            float v[16];
#pragma unroll
            for (int h = 0; h < 16; ++h) v[h] = ccr[h] * sr - cci[h] * si;
            float w8[8], w4[4], w2[2];
#pragma unroll
            for (int i = 0; i < 8; ++i) { const float keep = b5 ? v[8 + i] : v[i], send = b5 ? v[i] : v[8 + i]; w8[i] = keep + __shfl_xor(send, 32); }
#pragma unroll
            for (int i = 0; i < 4; ++i) { const float keep = b4 ? w8[4 + i] : w8[i], send = b4 ? w8[i] : w8[4 + i]; w4[i] = keep + __shfl_xor(send, 16); }
#pragma unroll
            for (int i = 0; i < 2; ++i) { const float keep = b3 ? w4[2 + i] : w4[i], send = b3 ? w4[i] : w4[2 + i]; w2[i] = keep + __shfl_xor(send, 8); }
            float w1 = (b2 ? w2[1] : w2[0]) + __shfl_xor(b2 ? w2[0] : w2[1], 4);
            w1 += __shfl_xor(w1, 2); w1 += __shfl_xor(w1, 1);
            if ((lane & 3) == 0) Y[(size_t)tok * AW + g * 16 + hsel] = w1; }
    }
}

__global__ void __launch_bounds__(NWAVES * 64, 2) fwd_kernel(Args args) {
    extern __shared__ __attribute__((aligned(16))) unsigned char lds_raw[];
    Frame F;
    F.lds = (LAS unsigned char*)lds_raw;
    F.wave = __builtin_amdgcn_readfirstlane((int)threadIdx.x >> 6); F.lane = lane_op(); F.tid = F.wave * 64 + F.lane;
    F.G = gridDim.x; F.gw = blockIdx.x * NWAVES + F.wave; F.NGW = F.G * NWAVES;
    F.out = args.out; F.ws = args.ws;
    unsigned char* ws = args.ws;
    volatile LAS unsigned* MISC = (volatile LAS unsigned*)(F.lds + MISC_OFF);
    for (int u = F.tid; u < (LDS_BYTES - RING_BYTES) / 4; u += NWAVES * 64) ((LAS unsigned*)(F.lds + RING_BYTES))[u] = 0u;
    __syncthreads();
    XcdBarrier bar = xcd_barrier_post((unsigned*)(ws + WS_CTL) + CW_BAR, MISC + 8, F.wave);
    const int lo = args.ph_lo, hi = args.ph_hi;
#define IN(k) (lo <= (k) && (k) < hi)
#define PH_BEGIN() do { F.lane = lane_op(); F.tid = F.wave * 64 + F.lane; } while (0)
#define SEAM(k) do { if (IN(k) && IN((k) + 1)) xcd_barrier(bar); } while (0)

    bf16* XB = (bf16*)(ws + WS_XB);
    float* rstd0 = (float*)(ws + WS_RSTD0); float* rstd1 = (float*)(ws + WS_RSTD1); float* rstd2 = (float*)(ws + WS_RSTD2);
    float* ratio = (float*)(ws + WS_RATIO); float* rsssm = (float*)(ws + WS_RSSSM);
    float* psatt = (float*)(ws + WS_PSATT); float* psssm = (float*)(ws + WS_PSSSM); float* psmix = (float*)(ws + WS_PSMIX); float* psm = (float*)(ws + WS_PSM);
    LAS float* scr = (LAS float*)(F.lds + F.wave * 16384);

    if (IN(0)) { PH_BEGIN();
        constexpr int I_IN = (D / 64) * (NIN / 32), I_GLU = (AW / 64) * (AW / 32), I_OUT = (D / 64) * (D / 32);
        { const float* w_in = ARGP(5); const float* g_pre = ARGP(4); const float* w_glu = ARGP(22); const float* w_out = ARGP(26); const float* g_att = ARGP(24); const float* g_ssm = ARGP(25);
        for (int it = F.gw; it < I_IN + I_GLU + I_OUT; it += F.NGW) {
            int r = it;
            if (r < I_IN) { transpose_item(w_in, D, NIN, (bf16*)(ws + WS_WIN), g_pre, AW, QSCALE, scr, r, F.lane); continue; } r -= I_IN;
            if (r < I_GLU) { transpose_item(w_glu, AW, AW, (bf16*)(ws + WS_WGLU), nullptr, 0, 1.f, scr, r, F.lane); continue; } r -= I_GLU;
            {
                const int nblk = D / 32, kb = r / nblk; const int k0 = 64 * kb;
                const float* gk = k0 < AW ? g_att : g_ssm - AW;
                transpose_item(w_out, D, D, (bf16*)(ws + WS_WOUT), gk, 0, 1.f, scr, r, F.lane); }
        } }
        { const float* xp = ARGP(0); const float* xs = ARGP(1);
        for (int m = F.gw; m < T; m += F.NGW) xb_row(F, xp, xs, m); }
        const float* pep = ARGP(2); const float* pes = ARGP(3);
        for (int i = F.gw * 64 + F.lane; i < T * PLE / 4; i += F.NGW * 64) { const int m = i / (PLE / 4), c4 = i % (PLE / 4);
            const f32x4 v = ((const f32x4*)perow(pep, pes, m))[c4]; u32x2 w; w.x = cvt_pk_bf16(v[0], v[1]); w.y = cvt_pk_bf16(v[2], v[3]);
            ((u32x2*)(ws + WS_PEB))[i] = w; }
    }
    SEAM(0);
    if (IN(1)) { PH_BEGIN();
        pg8::Gemm g{XB, (const bf16*)(ws + WS_WIN), T, NIN, D, F.wave}; pg8::StaticOrder S; S.init(T, NIN, F.G, (int)blockIdx.x);
        pg8::EpiProj E{(bf16*)(ws + WS_Q), (bf16*)(ws + WS_UG), rstd0};
        pg8::gemm_phase<pg8::EpiProj, pg8::StaticOrder, true, true>(F.lds, g, S, E);
    }
    SEAM(1);
    if (IN(2)) { PH_BEGIN();
        for (int task = F.gw; task < 768; task += F.NGW) { if (task & 1) ssm_slow_task<1>(F, task); else ssm_slow_task<0>(F, task); }
        const float* rpb = ARGP(6);
        for (int task = F.gw; task < T * NH; task += F.NGW) attn_slow_task(F, rpb, task >> 4, task & 15);
    }
    SEAM(2);
    if (IN(3)) { PH_BEGIN();
        const float* dsk = ARGP(21); const bf16* Ug = (const bf16*)(ws + WS_UG); bf16* Z = (bf16*)(ws + WS_Z);
        for (int i = F.gw * 64 + F.lane; i < T * (AW / 8); i += F.NGW * 64) { const int tok = i >> 8, col = (i & 255) * 8; const int g = col >> 4, h0 = col & 15;
            const f32x4 f0 = *(const f32x4*)(F.out + (size_t)tok * AW + col), f1 = *(const f32x4*)(F.out + (size_t)tok * AW + col + 4);
            const f32x4 b0 = *(const f32x4*)(F.out + (size_t)(T + tok) * AW + col), b1 = *(const f32x4*)(F.out + (size_t)(T + tok) * AW + col + 4);
            const u32x4 uu = *(const u32x4*)(Ug + ((size_t)g * T + tok) * 16 + h0);
            const f32x4 d0 = *(const f32x4*)(dsk + col), d1 = *(const f32x4*)(dsk + col + 4);
            float y[8];
            y[0] = f0[0] + b0[0] + d0[0] * bf_lo(uu.x); y[1] = f0[1] + b0[1] + d0[1] * bf_hi(uu.x); y[2] = f0[2] + b0[2] + d0[2] * bf_lo(uu.y); y[3] = f0[3] + b0[3] + d0[3] * bf_hi(uu.y);
            y[4] = f1[0] + b1[0] + d1[0] * bf_lo(uu.z); y[5] = f1[1] + b1[1] + d1[1] * bf_hi(uu.z); y[6] = f1[2] + b1[2] + d1[2] * bf_lo(uu.w); y[7] = f1[3] + b1[3] + d1[3] * bf_hi(uu.w);
            u32x4 w; w.x = cvt_pk_bf16(gelu_tanh(y[0]), gelu_tanh(y[1])); w.y = cvt_pk_bf16(gelu_tanh(y[2]), gelu_tanh(y[3])); w.z = cvt_pk_bf16(gelu_tanh(y[4]), gelu_tanh(y[5])); w.w = cvt_pk_bf16(gelu_tanh(y[6]), gelu_tanh(y[7]));
            *(u32x4*)(Z + (size_t)tok * AW + col) = w; }
    }
    SEAM(3);
    if (IN(4)) { PH_BEGIN();
        pg8::Gemm g{(const bf16*)(ws + WS_Z), (const bf16*)(ws + WS_WGLU), T, AW, AW, F.wave}; pg8::StaticOrder S; S.init(T, AW, F.G, (int)blockIdx.x);
        pg8::EpiGlu E{(const bf16*)(ws + WS_Z), XB, ARGP(23), psssm};
        pg8::gemm_phase<pg8::EpiGlu, pg8::StaticOrder, true, true>(F.lds, g, S, E);
    }
    SEAM(4);
    if (IN(5)) { PH_BEGIN();
        for (int m = blockIdx.x * 512 + F.tid; m < T; m += F.G * 512) {
            float sa = 0.f, ss = 0.f;
#pragma unroll
            for (int j = 0; j < 4; ++j) { const f32x4 v = ((const f32x4*)(psatt + (size_t)m * 16))[j]; sa += (v[0] + v[1]) + (v[2] + v[3]); }
#pragma unroll
            for (int j = 0; j < 8; ++j) { const f32x4 v = ((const f32x4*)(psssm + (size_t)m * 32))[j]; ss += (v[0] + v[1]) + (v[2] + v[3]); }
            const float ra = 1.0f / sqrtf(sa * (1.0f / AW) + RMS_EPS), rs = 1.0f / sqrtf(ss * (1.0f / AW) + RMS_EPS);
            ratio[m] = ra / rs; rsssm[m] = rs; }
    }
    SEAM(5);
    if (IN(6)) { PH_BEGIN();
        pg8::Gemm g{XB, (const bf16*)(ws + WS_WOUT), T, D, D, F.wave}; pg8::StaticOrder S; S.init(T, D, F.G, (int)blockIdx.x);
        pg8::EpiOut E{F.out, ratio, rsssm, psmix};
        pg8::gemm_phase<pg8::EpiOut, pg8::StaticOrder, true, true>(F.lds, g, S, E);
    }
    SEAM(6);
    if (IN(7)) { PH_BEGIN();
        { const float* xp = ARGP(0); const float* xs = ARGP(1); const float* gpm = ARGP(27);
        for (int m = F.gw; m < T; m += F.NGW)
            row_pass(F, xrow(xp, xs, m), F.out + (size_t)m * D, psmix + (size_t)m * 64, gpm, F.out + (size_t)m * D, XB + (size_t)m * D, rstd1 + m); }
        constexpr int I_UP = (D / 64) * (DFF / 32), I_DN = (DFF / 64) * (D / 32), I_GT = (D / 64) * (D / 32), I_PL = (PLE / 64) * (D / 32);
        const float* w_up = ARGP(29); const float* g_mlp = ARGP(28); const float* w_dn = ARGP(30); const float* w_gt = ARGP(33); const float* g_pl = ARGP(32); const float* w_pl = ARGP(34);
        for (int it = F.gw; it < I_UP + I_DN + I_GT + I_PL; it += F.NGW) {
            int r = it;
            if (r < I_UP) { transpose_item(w_up, D, DFF, (bf16*)(ws + WS_WUP), g_mlp, 0, 1.f, scr, r, F.lane); continue; } r -= I_UP;
            if (r < I_DN) { transpose_item(w_dn, DFF, D, (bf16*)(ws + WS_WDOWN), nullptr, 0, 1.f, scr, r, F.lane); continue; } r -= I_DN;
            if (r < I_GT) { transpose_item(w_gt, D, D, (bf16*)(ws + WS_WGATE), g_pl, 0, 1.f, scr, r, F.lane); continue; } r -= I_GT;
            transpose_item(w_pl, PLE, D, (bf16*)(ws + WS_WPLE), nullptr, 0, 1.f, scr, r, F.lane);
        }
    }
    SEAM(7);
    for (int ch = 0; ch < NCHUNK; ++ch) {
        const int row_off = ch * MCHUNK;
        if (IN(8 + 3 * ch)) { PH_BEGIN();
            pg8::Gemm g{XB + (size_t)row_off * D, (const bf16*)(ws + WS_WUP), MCHUNK, DFF, D, F.wave}; pg8::StaticOrder S; S.init(MCHUNK, DFF, F.G, (int)blockIdx.x);
            pg8::EpiUp E{(bf16*)(ws + WS_HBUF), rstd1, row_off};
            pg8::gemm_phase<pg8::EpiUp, pg8::StaticOrder, true, true>(F.lds, g, S, E);
        }
        SEAM(8 + 3 * ch);
        if (IN(9 + 3 * ch)) { PH_BEGIN();
            pg8::Gemm g{(const bf16*)(ws + WS_HBUF), (const bf16*)(ws + WS_WDOWN), MCHUNK, D, DFF, F.wave}; pg8::StaticOrder S; S.init(MCHUNK, D, F.G, (int)blockIdx.x);
            pg8::EpiDown E{(float*)(ws + WS_MCH), psm, row_off};
            pg8::gemm_phase<pg8::EpiDown, pg8::StaticOrder, true, true>(F.lds, g, S, E);
        }
        SEAM(9 + 3 * ch);
        if (IN(10 + 3 * ch)) { PH_BEGIN();
            const float* gpl = ARGP(31);
            for (int ml = F.gw; ml < MCHUNK; ml += F.NGW) { const int m = row_off + ml;
                row_pass(F, F.out + (size_t)m * D, (const float*)(ws + WS_MCH) + (size_t)ml * D, psm + (size_t)m * 64, gpl, F.out + (size_t)m * D, XB + (size_t)m * D, rstd2 + m); }
        }
        SEAM(10 + 3 * ch);
    }
    if (IN(17)) { PH_BEGIN();
        pg8::Gemm g{(const bf16*)(ws + WS_PEB), (const bf16*)(ws + WS_WPLE), T, D, PLE, F.wave}; pg8::StaticOrder S; S.init(T, D, F.G, (int)blockIdx.x);
        pg8::EpiPle E{(bf16*)(ws + WS_PP)};
        pg8::gemm_phase<pg8::EpiPle, pg8::StaticOrder, true, true>(F.lds, g, S, E);
    }
    SEAM(17);
    if (IN(18)) { PH_BEGIN();
        pg8::Gemm g{XB, (const bf16*)(ws + WS_WGATE), T, D, D, F.wave}; pg8::StaticOrder S; S.init(T, D, F.G, (int)blockIdx.x);
        pg8::EpiGate E{F.out, (const bf16*)(ws + WS_PP), rstd2};
        pg8::gemm_phase<pg8::EpiGate, pg8::StaticOrder, true, true>(F.lds, g, S, E);
    }
#undef IN
#undef SEAM
}

constexpr int N_PHASES = 19;
#ifndef MK_PER_PHASE
#define MK_PER_PHASE 0
#endif
extern "C" void kernel_launch(void* const* d_in, const int* in_sizes, int n_in, void* d_out, int out_size, void* d_ws, size_t ws_size, hipStream_t stream) {
    static int grid = 0;
    if (grid == 0) {
        if (n_in != 35 || out_size != T * D || ws_size < WS_END) { fprintf(stderr, "kernel_launch: unexpected problem (n_in %d, out %d, ws %zu)\n", n_in, out_size, ws_size); grid = -1; return; }
        int dev = 0, cus = 0;
        if (hipGetDevice(&dev) != hipSuccess || hipDeviceGetAttribute(&cus, hipDeviceAttributeMultiprocessorCount, dev) != hipSuccess) { grid = -1; return; }
        if (hipFuncSetAttribute((const void*)fwd_kernel, hipFuncAttributeMaxDynamicSharedMemorySize, LDS_BYTES) != hipSuccess) { fprintf(stderr, "kernel_launch: hipFuncSetAttribute failed\n"); grid = -1; return; }
        int per_cu = 0;
        if (hipOccupancyMaxActiveBlocksPerMultiprocessor(&per_cu, (const void*)fwd_kernel, NWAVES * 64, LDS_BYTES) != hipSuccess || per_cu < 1) fprintf(stderr, "kernel_launch: occupancy query reports %d\n", per_cu);
        (void)hipGetLastError();
        grid = cus;
    }
    if (grid < 0) return;
    (void)hipMemsetAsync((char*)d_ws + WS_CTL, 0, CTL_ZERO_BYTES, stream);
    Args a{};
    for (int i = 0; i < 35; ++i) a.in[i] = (const float*)d_in[i];
    a.out = (float*)d_out; a.ws = (unsigned char*)d_ws;
#if MK_PER_PHASE
    for (int p = 0; p < N_PHASES; ++p) { a.ph_lo = p; a.ph_hi = p + 1; hipLaunchKernelGGL(fwd_kernel, dim3(grid), dim3(NWAVES * 64), LDS_BYTES, stream, a); }
#else
    a.ph_lo = 0; a.ph_hi = N_PHASES;
    hipLaunchKernelGGL(fwd_kernel, dim3(grid), dim3(NWAVES * 64), LDS_BYTES, stream, a);
#endif
}
```

```cpp
#include <hip/hip_runtime.h>
#include <cstdio>
#include <cstdint>

#define GAS __attribute__((address_space(1)))
#define LAS __attribute__((address_space(3)))
typedef unsigned short bf16;
typedef short bf16x8 __attribute__((ext_vector_type(8)));
typedef float f32x4 __attribute__((ext_vector_type(4)));
typedef float f32x2 __attribute__((ext_vector_type(2)));
typedef unsigned u32x4 __attribute__((ext_vector_type(4)));
typedef unsigned u32x2 __attribute__((ext_vector_type(2)));

constexpr int T = 24576, TPR = 8192, D = 4096, AW = 2048, NH = 16, HD = 128, NG = 128, SP = 64, DFF = 16384, PLE = 256, NIN = 8192;
constexpr float RMS_EPS = 1e-6f;
constexpr float LOG2E = 1.4426950408889634f;
constexpr float QSCALE = 0.08838834764831845f * 1.4426950408889634f;

constexpr size_t MiB = 1u << 20;
constexpr size_t WS_CTL = 0, CTL_ZERO_BYTES = 1 * MiB;
constexpr size_t WS_RSTD0 = 1 * MiB, WS_RSTD1 = WS_RSTD0 + 128 * 1024, WS_RSTD2 = WS_RSTD1 + 128 * 1024, WS_RATIO = WS_RSTD2 + 128 * 1024, WS_RSSSM = WS_RATIO + 128 * 1024;
constexpr size_t WS_PSATT = 2 * MiB, WS_PSSSM = 4 * MiB, WS_PSMIX = 8 * MiB, WS_PSM = 14 * MiB;
constexpr size_t WS_PEB = 24 * MiB;
constexpr size_t WS_KTAB = 36 * MiB, WS_MC = 40 * MiB, WS_MB = 72 * MiB;
constexpr size_t WS_WIN = 104 * MiB, WS_WGLU = 168 * MiB, WS_WOUT = 176 * MiB;
constexpr size_t WS_XB = 208 * MiB;
constexpr size_t WS_Q = 400 * MiB, WS_K = 496 * MiB, WS_V = 592 * MiB, WS_UG = 688 * MiB, WS_Z = 784 * MiB, WS_S = 880 * MiB, WS_HB = 976 * MiB;
constexpr size_t WS_WUP = 400 * MiB, WS_WDOWN = 528 * MiB, WS_WGATE = 656 * MiB, WS_WPLE = 688 * MiB;
constexpr size_t WS_HBUF = 692 * MiB;
constexpr size_t WS_MCH = 36 * MiB;
constexpr size_t WS_PP = 692 * MiB;
constexpr size_t WS_END = 1024 * MiB;
constexpr int MCHUNK = 8192, NCHUNK = T / MCHUNK;

constexpr int CW_BAR = 4096;

constexpr int RING_BYTES = 131072;
constexpr int MISC_OFF = RING_BYTES + 320;
constexpr int LDS_BYTES = 147456;
constexpr int NWAVES = 8;

__device__ __forceinline__ unsigned cvt_pk_bf16(float lo, float hi) { unsigned r; asm volatile("v_cvt_pk_bf16_f32 %0, %1, %2" : "=v"(r) : "v"(lo), "v"(hi)); return r; }
__device__ __forceinline__ float bf_lo(unsigned v) { return __builtin_bit_cast(float, v << 16); }
__device__ __forceinline__ float bf_hi(unsigned v) { return __builtin_bit_cast(float, v & 0xffff0000u); }
__device__ __forceinline__ float wave_sum(float v) {
#pragma unroll
    for (int o = 1; o < 64; o <<= 1) v += __shfl_xor(v, o);
    return v;
}
__device__ __forceinline__ float wave_max(float v) {
#pragma unroll
    for (int o = 1; o < 64; o <<= 1) v = fmaxf(v, __shfl_xor(v, o));
    return v;
}
__device__ __forceinline__ int lane_id() { return (int)__builtin_amdgcn_mbcnt_hi(~0u, __builtin_amdgcn_mbcnt_lo(~0u, 0u)); }
__device__ __forceinline__ int lane_op() { int l = lane_id(); asm volatile("" : "+v"(l)); return l; }
__device__ __forceinline__ float sigmoidf_(float x) { return 1.0f / (1.0f + __expf(-x)); }
__device__ __forceinline__ float gelu_tanh(float x) { const float a = 1.5957691216057308f * (x + 0.044715f * x * x * x); return x / (1.0f + __expf(-a)); }

namespace pg8 {
#define PG8_LAS __attribute__((address_space(3)))
typedef unsigned short bf16_t;
constexpr int BM = 256, BK = 64, HALF = 128, HTB = HALF * BK * 2, STAGE_BYTES = 8 * HTB, NXCD = 8, WGM = 8;
__host__ __device__ __forceinline__ int lds_byte(int r, int c) { const int st = (r >> 4) * 2 + (c >> 5), rr = r & 15, cc = c & 31, ob = rr * 64 + cc * 2; return st * 1024 + (ob ^ (((ob >> 9) & 1) << 5)); }
__host__ __device__ __forceinline__ void stage_rc(int b, int& R, int& C) { const int st = b / 1024, sb = b % 1024, swz = sb ^ (((sb >> 9) & 1) << 5); R = (st >> 1) * 16 + swz / 64; C = (st & 1) * 32 + (swz % 64) / 2; }
__host__ __device__ __forceinline__ int perm32(int rho) { const int n = rho >> 4, i = rho & 15; return 8 * (i >> 2) + 4 * n + (i & 3); }
struct Unit { int pm, pn; };
struct Gemm { const bf16_t* A; const bf16_t* Bt; int M, N, K, wave; };
struct StaticOrder {
    int nM, nN, nwg, G, c;
    __host__ __device__ void init(int M, int N, int G_, int c_) { nM = M / BM; nN = N / BM; nwg = nM * nN; G = G_; c = c_; }
    __host__ __device__ bool next(int i, Unit& u) const {
        const long L = (long)i * G + c; if (L >= nwg) return false;
        int wgid = (int)L; { const int q = nwg / NXCD, r = nwg % NXCD, xcd = wgid % NXCD, off = wgid / NXCD; wgid = (xcd < r ? xcd * (q + 1) : r * (q + 1) + (xcd - r) * q) + off; }
        const int nig = WGM * nN, gid = wgid / nig, fm = gid * WGM, gsz = (nM - fm) < WGM ? (nM - fm) : WGM;
        u.pm = fm + ((wgid % nig) % gsz); u.pn = (wgid % nig) / gsz; return true;
    }
    __device__ __forceinline__ void a_ready(const Unit&) const {}
    __device__ __forceinline__ void done(const Unit&) const {}
};

template <class Epi, class Sched, bool ALIGN_EPI = false, bool SP2 = false>
__device__ __forceinline__ void gemm_phase(PG8_LAS unsigned char* lds, const Gemm g, const Sched& S, const Epi& E) {
    const int lane = lane_op(), wid = g.wave, tid = wid * 64 + lane, wr = wid >> 2, wc = wid & 3, fr = lane & 15, fq = lane >> 4;
    const int K = g.K, nt = K / BK;
    unsigned voffA[2], voffB[2];
#pragma unroll
    for (int i = 0; i < 2; ++i) { int R, C; stage_rc(tid * 16 + i * 8192, R, C); const int Rb = Epi::PERM ? ((R & ~31) + perm32(R & 31)) : R;
        voffA[i] = (unsigned)(R * K + C) * 2u; voffB[i] = (unsigned)(Rb * K + C) * 2u; }
    const size_t kstep = (size_t)(BK * 2);
    const size_t hstep = (size_t)HALF * K * 2;
    const size_t tstep = 2 * hstep;
    const unsigned ldsw = (unsigned)wid * 1024u;
    const int aoff = lds_byte(wr * 64 + fr, fq * 8), boff = lds_byte(wc * 32 + fr, fq * 8);
#define PG8_SA(b, h) (((b) * 2 + (h)) * HTB)
#define PG8_SB(b, h) ((4 + (b) * 2 + (h)) * HTB)
#define PG8_STAGE(bufoff, gbase, voff) do { _Pragma("unroll") for (int _i = 0; _i < 2; ++_i) \
        __builtin_amdgcn_global_load_lds((const unsigned*)((const char*)(gbase) + (voff)[_i]), (PG8_LAS unsigned*)(lds + (bufoff) + ldsw + _i * 8192), 16, 0, 0); } while (0)
#define PG8_LDA(dst, b, h) do { _Pragma("unroll") for (int m = 0; m < 4; ++m) _Pragma("unroll") for (int k = 0; k < 2; ++k) dst[m][k] = *(const PG8_LAS bf16x8*)(lds + PG8_SA(b, h) + aoff + m * 2048 + k * 1024); } while (0)
#define PG8_LDB(dst, b, h) do { _Pragma("unroll") for (int n = 0; n < 2; ++n) _Pragma("unroll") for (int k = 0; k < 2; ++k) dst[n][k] = *(const PG8_LAS bf16x8*)(lds + PG8_SB(b, h) + boff + n * 2048 + k * 1024); } while (0)
#define PG8_MMA(ai, bj, At, Bt) do { __builtin_amdgcn_s_setprio(1); _Pragma("unroll") for (int m = 0; m < 4; ++m) _Pragma("unroll") for (int n = 0; n < 2; ++n) _Pragma("unroll") for (int k = 0; k < 2; ++k) \
        acc[ai][bj][m][n] = __builtin_amdgcn_mfma_f32_16x16x32_bf16(Bt[n][k], At[m][k], acc[ai][bj][m][n], 0, 0, 0); __builtin_amdgcn_s_setprio(0); } while (0)
#define PG8_WAIT_V(n) asm volatile("s_waitcnt vmcnt(" #n ")" ::: "memory")
#define PG8_WAIT_L(n) asm volatile("s_waitcnt lgkmcnt(" #n ")" ::: "memory")
#define PG8_BAR __builtin_amdgcn_s_barrier()
#define PG8_SCHED __builtin_amdgcn_sched_barrier(0)
    Unit cur, nxt; int ui = 0;
    if (!S.next(0, cur)) return;
    f32x4 acc[2][2][4][2];
#pragma unroll
    for (int a = 0; a < 2; ++a)
#pragma unroll
        for (int b = 0; b < 2; ++b)
#pragma unroll
            for (int m = 0; m < 4; ++m)
#pragma unroll
                for (int n = 0; n < 2; ++n) acc[a][b][m][n] = (f32x4){0.f, 0.f, 0.f, 0.f};
    bf16x8 At[4][2], B0[2][2], B1[2][2];
    const char* cA = (const char*)g.A + (size_t)cur.pm * tstep; const char* cB = (const char*)g.Bt + (size_t)cur.pn * tstep;
    S.a_ready(cur);
    if constexpr (SP2) {
        PG8_STAGE(PG8_SB(0, 0), cB, voffB); PG8_STAGE(PG8_SB(0, 1), cB + hstep, voffB); PG8_STAGE(PG8_SA(0, 0), cA, voffA); PG8_STAGE(PG8_SA(0, 1), cA + hstep, voffA);
        if (wr == 1) PG8_BAR;
        PG8_WAIT_V(2); PG8_BAR;
        PG8_STAGE(PG8_SB(1, 0), cB + kstep, voffB); PG8_STAGE(PG8_SA(1, 0), cA + kstep, voffA); PG8_STAGE(PG8_SB(1, 1), cB + hstep + kstep, voffB);
        PG8_WAIT_V(6); PG8_BAR;
    } else {
        PG8_STAGE(PG8_SB(0, 0), cB, voffB); PG8_STAGE(PG8_SA(0, 0), cA, voffA); PG8_STAGE(PG8_SB(0, 1), cB + hstep, voffB); PG8_STAGE(PG8_SA(0, 1), cA + hstep, voffA);
        if (wr == 1) PG8_BAR;
        PG8_WAIT_V(4); PG8_BAR;
        PG8_STAGE(PG8_SB(1, 0), cB + kstep, voffB); PG8_STAGE(PG8_SA(1, 0), cA + kstep, voffA); PG8_STAGE(PG8_SB(1, 1), cB + hstep + kstep, voffB);
        PG8_WAIT_V(6); PG8_BAR;
    }
    for (;;) {
        const bool has_next = S.next(ui + 1, nxt);
        const char* nA = has_next ? (const char*)g.A + (size_t)nxt.pm * tstep : cA; const char* nB = has_next ? (const char*)g.Bt + (size_t)nxt.pn * tstep : cB;
#pragma nounroll
        for (int t = 0; t < nt; t += 2) {
            const bool last = (t == nt - 2);
            const char* a1 = cA + (size_t)(t + 1) * kstep;
            const char* a2 = last ? nA : cA + (size_t)(t + 2) * kstep; const char* b2 = last ? nB : cB + (size_t)(t + 2) * kstep;
            const char* a3 = a2 + kstep; const char* b3 = b2 + kstep;
            if (last && has_next) S.a_ready(nxt);
            if constexpr (Epi::MIDK) { if (t == (nt >> 1)) E.midk(acc, cur, wr, wc, fr, fq); }
            if constexpr (SP2) {
            PG8_LDB(B0, 0, 0); PG8_LDB(B1, 0, 1); PG8_SCHED; PG8_LDA(At, 0, 0); PG8_STAGE(PG8_SA(1, 1), a1 + hstep, voffA);
            PG8_WAIT_V(8); PG8_WAIT_L(0); PG8_BAR; PG8_MMA(0, 0, At, B0); PG8_MMA(0, 1, At, B1); PG8_BAR; PG8_SCHED;
            PG8_LDA(At, 0, 1); PG8_STAGE(PG8_SB(0, 0), b2, voffB); PG8_STAGE(PG8_SB(0, 1), b2 + hstep, voffB); PG8_STAGE(PG8_SA(0, 0), a2, voffA);
            PG8_WAIT_V(8); PG8_WAIT_L(0); PG8_BAR; PG8_MMA(1, 0, At, B0); PG8_MMA(1, 1, At, B1); PG8_BAR; PG8_SCHED;
            PG8_LDB(B0, 1, 0); PG8_LDB(B1, 1, 1); PG8_SCHED; PG8_LDA(At, 1, 0); PG8_STAGE(PG8_SA(0, 1), a2 + hstep, voffA);
            PG8_WAIT_V(8); PG8_WAIT_L(0); PG8_BAR; PG8_MMA(0, 0, At, B0); PG8_MMA(0, 1, At, B1); PG8_BAR; PG8_SCHED;
            PG8_LDA(At, 1, 1); PG8_STAGE(PG8_SB(1, 0), b3, voffB); PG8_STAGE(PG8_SB(1, 1), b3 + hstep, voffB); PG8_STAGE(PG8_SA(1, 0), a3, voffA);
            PG8_WAIT_V(8); PG8_WAIT_L(0); PG8_BAR; PG8_MMA(1, 0, At, B0); PG8_MMA(1, 1, At, B1); PG8_BAR; PG8_SCHED;
            } else {
            PG8_LDB(B0, 0, 0); PG8_SCHED; PG8_LDA(At, 0, 0); PG8_STAGE(PG8_SA(1, 1), a1 + hstep, voffA);
            PG8_WAIT_L(8); PG8_BAR; PG8_WAIT_L(0); PG8_MMA(0, 0, At, B0); PG8_BAR; PG8_SCHED;
            PG8_LDB(B1, 0, 1); PG8_STAGE(PG8_SB(0, 0), b2, voffB);
            PG8_BAR; PG8_WAIT_L(0); PG8_MMA(0, 1, At, B1); PG8_BAR;
            PG8_LDA(At, 0, 1); PG8_STAGE(PG8_SA(0, 0), a2, voffA);
            PG8_BAR; PG8_WAIT_L(0); PG8_MMA(1, 0, At, B0); PG8_BAR; PG8_SCHED;
            PG8_STAGE(PG8_SB(0, 1), b2 + hstep, voffB);
            PG8_WAIT_V(6); PG8_BAR; PG8_MMA(1, 1, At, B1); PG8_BAR;
            PG8_LDB(B0, 1, 0); PG8_SCHED; PG8_LDA(At, 1, 0); PG8_STAGE(PG8_SA(0, 1), a2 + hstep, voffA);
            PG8_WAIT_L(8); PG8_BAR; PG8_WAIT_L(0); PG8_MMA(0, 0, At, B0); PG8_BAR; PG8_SCHED;
            PG8_LDB(B1, 1, 1); PG8_STAGE(PG8_SB(1, 0), b3, voffB);
            PG8_BAR; PG8_WAIT_L(0); PG8_MMA(0, 1, At, B1); PG8_BAR;
            PG8_LDA(At, 1, 1); PG8_STAGE(PG8_SA(1, 0), a3, voffA);
            PG8_BAR; PG8_WAIT_L(0); PG8_MMA(1, 0, At, B0); PG8_BAR; PG8_SCHED;
            PG8_STAGE(PG8_SB(1, 1), b3 + hstep, voffB);
            PG8_WAIT_V(6); PG8_BAR; PG8_MMA(1, 1, At, B1); PG8_BAR;
            }
        }
        if constexpr (ALIGN_EPI) { if (wr == 0) PG8_BAR; }
        E(acc, cur, wr, wc, fr, fq); S.done(cur);
        if (!has_next) break;
#pragma unroll
        for (int a = 0; a < 2; ++a)
#pragma unroll
            for (int b = 0; b < 2; ++b)
#pragma unroll
                for (int m = 0; m < 4; ++m)
#pragma unroll
                    for (int n = 0; n < 2; ++n) acc[a][b][m][n] = (f32x4){0.f, 0.f, 0.f, 0.f};
        cur = nxt; cA = nA; cB = nB; ++ui;
        if constexpr (ALIGN_EPI) { if (wr == 1) PG8_BAR; }
    }
    PG8_WAIT_V(0);
    if constexpr (!ALIGN_EPI) { if (wr == 0) PG8_BAR; }
    PG8_BAR;
#undef PG8_SA
#undef PG8_SB
#undef PG8_STAGE
#undef PG8_LDA
#undef PG8_LDB
#undef PG8_MMA
#undef PG8_WAIT_V
#undef PG8_WAIT_L
#undef PG8_BAR
#undef PG8_SCHED
}

typedef f32x4 Acc[2][2][4][2];

struct EpiProj {
    static constexpr bool PERM = true, MIDK = false;
    bf16_t *Q, *Ug; const float* rstd;
    __device__ __forceinline__ void operator()(const Acc& acc, const Unit& u, int wr, int wc, int fr, int fq) const {
        const int row0 = u.pm * BM + wr * 64 + fr; const int t = u.pn >> 3;
        const int colt = (u.pn & 7) * BM + wc * 32 + 8 * fq;
        bf16_t* base = Q + (size_t)t * ((size_t)T * AW);
#pragma unroll
        for (int ai = 0; ai < 2; ++ai)
#pragma unroll
            for (int m = 0; m < 4; ++m) { const int row = row0 + ai * HALF + m * 16; const float rs = rstd[row];
#pragma unroll
                for (int bj = 0; bj < 2; ++bj) { const f32x4 v0 = acc[ai][bj][m][0] * rs, v1 = acc[ai][bj][m][1] * rs;
                    u32x4 w; w.x = cvt_pk_bf16(v0[0], v0[1]); w.y = cvt_pk_bf16(v0[2], v0[3]); w.z = cvt_pk_bf16(v1[0], v1[1]); w.w = cvt_pk_bf16(v1[2], v1[3]);
                    const int col = colt + bj * HALF;
                    if (t < 3) *(u32x4*)(base + (size_t)row * AW + col) = w;
                    else *(u32x4*)(Ug + ((size_t)(col >> 4) * T + row) * 16 + (col & 15)) = w; } }
    }
};
struct EpiGlu {
    static constexpr bool PERM = true, MIDK = false;
    const bf16_t* Z; bf16_t* cat; const float* bglu; float* ps;
    __device__ __forceinline__ void operator()(const Acc& acc, const Unit& u, int wr, int wc, int fr, int fq) const {
        const int row0 = u.pm * BM + wr * 64 + fr; const int col0 = u.pn * BM + wc * 32 + 8 * fq;
        f32x4 bv[2][2];
#pragma unroll
        for (int bj = 0; bj < 2; ++bj)
#pragma unroll
            for (int n = 0; n < 2; ++n) bv[bj][n] = *(const f32x4*)(bglu + col0 + bj * HALF + 4 * n);
#pragma unroll
        for (int ai = 0; ai < 2; ++ai)
#pragma unroll
            for (int m = 0; m < 4; ++m) { const int row = row0 + ai * HALF + m * 16; float ssq = 0.f;
#pragma unroll
                for (int bj = 0; bj < 2; ++bj) { const int col = col0 + bj * HALF;
                    const u32x4 zr = *(const u32x4*)(Z + (size_t)row * AW + col);
                    const f32x4 a0 = acc[ai][bj][m][0] + bv[bj][0], a1 = acc[ai][bj][m][1] + bv[bj][1];
                    f32x4 s0, s1;
                    s0[0] = bf_lo(zr.x) * sigmoidf_(a0[0]); s0[1] = bf_hi(zr.x) * sigmoidf_(a0[1]); s0[2] = bf_lo(zr.y) * sigmoidf_(a0[2]); s0[3] = bf_hi(zr.y) * sigmoidf_(a0[3]);
                    s1[0] = bf_lo(zr.z) * sigmoidf_(a1[0]); s1[1] = bf_hi(zr.z) * sigmoidf_(a1[1]); s1[2] = bf_lo(zr.w) * sigmoidf_(a1[2]); s1[3] = bf_hi(zr.w) * sigmoidf_(a1[3]);
                    ssq += (s0[0] * s0[0] + s0[1] * s0[1]) + (s0[2] * s0[2] + s0[3] * s0[3]) + (s1[0] * s1[0] + s1[1] * s1[1]) + (s1[2] * s1[2] + s1[3] * s1[3]);
                    u32x4 w; w.x = cvt_pk_bf16(s0[0], s0[1]); w.y = cvt_pk_bf16(s0[2], s0[3]); w.z = cvt_pk_bf16(s1[0], s1[1]); w.w = cvt_pk_bf16(s1[2], s1[3]);
                    *(u32x4*)(cat + (size_t)row * D + AW + col) = w; }
                ssq += __shfl_xor(ssq, 16); ssq += __shfl_xor(ssq, 32);
                if (fq == 0) ps[(size_t)row * 32 + u.pn * 4 + wc] = ssq;
                asm volatile("" ::: "memory"); }
    }
};
struct EpiOut {
    static constexpr bool PERM = false, MIDK = true;
    float* out; const float* ratio; const float* rsssm; float* ps;
    __device__ __forceinline__ void midk(Acc& acc, const Unit& u, int wr, int wc, int fr, int fq) const {
        const int row0 = u.pm * BM + wr * 64 + fr;
#pragma unroll
        for (int ai = 0; ai < 2; ++ai)
#pragma unroll
            for (int m = 0; m < 4; ++m) { const float r = ratio[row0 + ai * HALF + m * 16];
#pragma unroll
                for (int bj = 0; bj < 2; ++bj)
#pragma unroll
                    for (int n = 0; n < 2; ++n) acc[ai][bj][m][n] = acc[ai][bj][m][n] * r; }
    }
    __device__ __forceinline__ void operator()(const Acc& acc, const Unit& u, int wr, int wc, int fr, int fq) const {
        const int row0 = u.pm * BM + wr * 64 + fr; const int col0 = u.pn * BM + wc * 32 + 4 * fq;
#pragma unroll
        for (int ai = 0; ai < 2; ++ai)
#pragma unroll
            for (int m = 0; m < 4; ++m) { const int row = row0 + ai * HALF + m * 16; const float rs = rsssm[row]; float ssq = 0.f;
#pragma unroll
                for (int bj = 0; bj < 2; ++bj)
#pragma unroll
                    for (int n = 0; n < 2; ++n) { const f32x4 v = acc[ai][bj][m][n] * rs; ssq += (v[0] * v[0] + v[1] * v[1]) + (v[2] * v[2] + v[3] * v[3]);
                        *(f32x4*)(out + (size_t)row * D + col0 + bj * HALF + n * 16) = v; }
                ssq += __shfl_xor(ssq, 16); ssq += __shfl_xor(ssq, 32);
                if (fq == 0) ps[(size_t)row * 64 + u.pn * 4 + wc] = ssq; }
    }
};
struct EpiUp {
    static constexpr bool PERM = true, MIDK = false;
    bf16_t* H; const float* rstd; int row_off;
    __device__ __forceinline__ void operator()(const Acc& acc, const Unit& u, int wr, int wc, int fr, int fq) const {
        const int row0 = u.pm * BM + wr * 64 + fr; const int col0 = u.pn * BM + wc * 32 + 8 * fq;
#pragma unroll
        for (int ai = 0; ai < 2; ++ai)
#pragma unroll
            for (int m = 0; m < 4; ++m) { const int row = row0 + ai * HALF + m * 16; const float rs = rstd[row_off + row];
#pragma unroll
                for (int bj = 0; bj < 2; ++bj) { f32x4 v0 = acc[ai][bj][m][0] * rs, v1 = acc[ai][bj][m][1] * rs;
#pragma unroll
                    for (int j = 0; j < 4; ++j) { const float a = fmaxf(v0[j], 0.f), b = fmaxf(v1[j], 0.f); v0[j] = a * a; v1[j] = b * b; }
                    u32x4 w; w.x = cvt_pk_bf16(v0[0], v0[1]); w.y = cvt_pk_bf16(v0[2], v0[3]); w.z = cvt_pk_bf16(v1[0], v1[1]); w.w = cvt_pk_bf16(v1[2], v1[3]);
                    *(u32x4*)(H + (size_t)row * DFF + col0 + bj * HALF) = w; } }
    }
};
struct EpiDown {
    static constexpr bool PERM = false, MIDK = false;
    float* Mo; float* ps; int row_off;
    __device__ __forceinline__ void operator()(const Acc& acc, const Unit& u, int wr, int wc, int fr, int fq) const {
        const int row0 = u.pm * BM + wr * 64 + fr; const int col0 = u.pn * BM + wc * 32 + 4 * fq;
#pragma unroll
        for (int ai = 0; ai < 2; ++ai)
#pragma unroll
            for (int m = 0; m < 4; ++m) { const int row = row0 + ai * HALF + m * 16; float ssq = 0.f;
#pragma unroll
                for (int bj = 0; bj < 2; ++bj)
#pragma unroll
                    for (int n = 0; n < 2; ++n) { const f32x4 v = acc[ai][bj][m][n]; ssq += (v[0] * v[0] + v[1] * v[1]) + (v[2] * v[2] + v[3] * v[3]);
                        *(f32x4*)(Mo + (size_t)row * D + col0 + bj * HALF + n * 16) = v; }
                ssq += __shfl_xor(ssq, 16); ssq += __shfl_xor(ssq, 32);
                if (fq == 0) ps[(size_t)(row_off + row) * 64 + u.pn * 4 + wc] = ssq; }
    }
};
struct EpiPle {
    static constexpr bool PERM = true, MIDK = false;
    bf16_t* P;
    __device__ __forceinline__ void operator()(const Acc& acc, const Unit& u, int wr, int wc, int fr, int fq) const {
        const int row0 = u.pm * BM + wr * 64 + fr; const int col0 = u.pn * BM + wc * 32 + 8 * fq;
#pragma unroll
        for (int ai = 0; ai < 2; ++ai)
#pragma unroll
            for (int m = 0; m < 4; ++m) { const int row = row0 + ai * HALF + m * 16;
#pragma unroll
                for (int bj = 0; bj < 2; ++bj) { const f32x4 v0 = acc[ai][bj][m][0], v1 = acc[ai][bj][m][1];
                    u32x4 w; w.x = cvt_pk_bf16(v0[0], v0[1]); w.y = cvt_pk_bf16(v0[2], v0[3]); w.z = cvt_pk_bf16(v1[0], v1[1]); w.w = cvt_pk_bf16(v1[2], v1[3]);
                    *(u32x4*)(P + (size_t)row * D + col0 + bj * HALF) = w; } }
    }
};
struct EpiGate {
    static constexpr bool PERM = false, MIDK = false;
    float* out; const bf16_t* P; const float* rstd;
    __device__ __forceinline__ void operator()(const Acc& acc, const Unit& u, int wr, int wc, int fr, int fq) const {
        const int row0 = u.pm * BM + wr * 64 + fr; const int col0 = u.pn * BM + wc * 32 + 4 * fq;
#pragma unroll
        for (int ai = 0; ai < 2; ++ai)
#pragma unroll
            for (int m = 0; m < 4; ++m) { const int row = row0 + ai * HALF + m * 16; const float rs = rstd[row];
#pragma unroll
                for (int bj = 0; bj < 2; ++bj)
#pragma unroll
                    for (int n = 0; n < 2; ++n) { const size_t off = (size_t)row * D + col0 + bj * HALF + n * 16;
                        const f32x4 h2 = *(const f32x4*)(out + off); const u32x2 pr = *(const u32x2*)(P + off); const f32x4 a = acc[ai][bj][m][n] * rs;
                        f32x4 o; o[0] = h2[0] + bf_lo(pr.x) * sigmoidf_(a[0]); o[1] = h2[1] + bf_hi(pr.x) * sigmoidf_(a[1]); o[2] = h2[2] + bf_lo(pr.y) * sigmoidf_(a[2]); o[3] = h2[3] + bf_hi(pr.y) * sigmoidf_(a[3]);
                        *(f32x4*)(out + off) = o; }
                asm volatile("" ::: "memory"); }
    }
};
}

#define XB_TMO      128
#define XB_XCNT(j)  (256  + 64 * (j))
#define XB_XSUB(j)  (1280 + 64 * (j))
#define XB_XGEN(j)  (2304 + 64 * (j))
#define XB_TOP      3328
#define XB_TOPGEN   3392
#define XCD_BAR_WORDS 3456
#define XB_SPIN_CAP (1u << 18)
__device__ __forceinline__ unsigned xb_ld(unsigned* p)              { return __hip_atomic_load(p, __ATOMIC_RELAXED, __HIP_MEMORY_SCOPE_AGENT); }
__device__ __forceinline__ unsigned xb_add(unsigned* p, unsigned v) { return __hip_atomic_fetch_add(p, v, __ATOMIC_RELAXED, __HIP_MEMORY_SCOPE_AGENT); }
__device__ __forceinline__ unsigned xb_xcc_id() { return (unsigned)__builtin_amdgcn_s_getreg((3 << 11) | 20) & 0xFu; }
#define XB_SPIN(cond, bar) do { unsigned _sp = 0; while (cond) { __builtin_amdgcn_s_sleep(1); \
    if ((++_sp & 255u) == 0u) { if (xb_ld(&(bar)[XB_TMO])) break; if (_sp > XB_SPIN_CAP) { atomicAdd(&(bar)[XB_TMO], 1u); break; } } } } while (0)
struct XcdBarrier { unsigned* bar; unsigned x; volatile LAS unsigned* st; int wave; };
__device__ __forceinline__ XcdBarrier xcd_barrier_post(unsigned* bar, volatile LAS unsigned* st, int wave) {
    XcdBarrier b; b.bar = bar; b.x = xb_xcc_id(); b.st = st; b.wave = wave;
    if (wave == 0 && lane_id() == 0) (void)xb_add(&bar[XB_XCNT(b.x)], 1u);
    return b;
}
__device__ __forceinline__ void xcd_barrier_complete(unsigned* bar, unsigned x, unsigned& nloc, unsigned& nx) {
    const unsigned G = gridDim.x * gridDim.y * gridDim.z;
    unsigned sum, cnt, mine, sp = 0u;
    for (;;) {
        sum = 0u; cnt = 0u; mine = 0u;
#pragma unroll
        for (unsigned j = 0; j < 16; ++j) { const unsigned c = xb_ld(&bar[XB_XCNT(j)]); sum += c; cnt += (c > 0u) ? 1u : 0u; mine = (j == x) ? c : mine; }
        if (sum == G) break;
        __builtin_amdgcn_s_sleep(1);
        if ((++sp & 255u) == 0u) { if (xb_ld(&bar[XB_TMO])) break; if (sp > XB_SPIN_CAP) { atomicAdd(&bar[XB_TMO], 1u); break; } }
    }
    nloc = mine > 0u ? mine : 1u; nx = cnt > 0u ? cnt : 1u;
}
__device__ __forceinline__ void xcd_barrier(const XcdBarrier& b) {
    asm volatile("s_waitcnt vmcnt(0)" ::: "memory");
    __syncthreads();
    if (b.wave == 0 && lane_id() == 0) {
        unsigned* bar = b.bar;
        __builtin_amdgcn_s_waitcnt(0);
        unsigned nloc = b.st[0], nx = b.st[1];
        if (nloc == 0u) { xcd_barrier_complete(bar, b.x, nloc, nx); b.st[0] = nloc; b.st[1] = nx; }
        const unsigned old = xb_add(&bar[XB_XSUB(b.x)], 1u);
        const unsigned gen = old / nloc;
        if (old + 1u == (gen + 1u) * nloc) {
            __builtin_amdgcn_fence(__ATOMIC_RELEASE, "agent");
            asm volatile("s_waitcnt vmcnt(0)" ::: "memory");
            const unsigned og = xb_add(&bar[XB_TOP], 1u);
            const unsigned tg = og / nx;
            if (og + 1u == (tg + 1u) * nx) xb_add(&bar[XB_TOPGEN], 1u);
            else XB_SPIN(xb_ld(&bar[XB_TOPGEN]) == tg, bar);
            __builtin_amdgcn_fence(__ATOMIC_ACQUIRE, "agent");
            xb_add(&bar[XB_XGEN(b.x)], 1u);
            asm volatile("s_waitcnt vmcnt(0)" ::: "memory");
        } else {
            XB_SPIN(xb_ld(&bar[XB_XGEN(b.x)]) == gen, bar);
            __builtin_amdgcn_fence(__ATOMIC_ACQUIRE, "agent");
            asm volatile("s_waitcnt vmcnt(0)" ::: "memory");
        }
    }
    __syncthreads();
}

struct Args { const float* in[35]; float* out; unsigned char* ws; int ph_lo, ph_hi; };
template <int I> __device__ __forceinline__ const float* argp() {
    const unsigned long long kp = (unsigned long long)__builtin_amdgcn_kernarg_segment_ptr(); unsigned long long v;
    asm volatile("s_load_dwordx2 %0, %1, %2\n\ts_waitcnt lgkmcnt(0)" : "=s"(v) : "s"(kp), "n"(I * 8) : "memory");
    return (const float*)v;
}
#define ARGP(i) argp<(i)>()
struct Frame {
    LAS unsigned char* lds;
    int tid, lane, wave, G, gw, NGW;
    float* out; unsigned char* ws;
};
#define LDS_WAIT() asm volatile("s_waitcnt lgkmcnt(0)" ::: "memory")

__device__ __forceinline__ const float* xrow(const float* xp, const float* xs, int m) { return m < TPR ? xp + (size_t)m * D : xs + (size_t)(m - TPR) * D; }
__device__ __forceinline__ const float* perow(const float* pp_, const float* ps_, int m) { return m < TPR ? pp_ + (size_t)m * PLE : ps_ + (size_t)(m - TPR) * PLE; }

__device__ __forceinline__ void transpose_item(const float* W, int K, int N, bf16* WT, const float* gk, int ncs, float cscale, LAS float* scr, int item, int lane) {
    const int nblk = N / 32, kb = item / nblk, nb = item % nblk, k0 = 64 * kb, n0 = 32 * nb;
    const float cs = (n0 < ncs) ? cscale : 1.0f;
#pragma unroll 8
    for (int i = 0; i < 32; ++i) { const int kk = 2 * i + (lane >> 5); const float gs = gk ? gk[k0 + kk] * cs : cs;
        scr[kk * 33 + (lane & 31)] = W[(size_t)(k0 + kk) * N + n0 + (lane & 31)] * gs; }
    LDS_WAIT(); asm volatile("" ::: "memory");
    const int c = lane & 7;
#pragma unroll
    for (int j = 0; j < 4; ++j) { const int n = (lane >> 3) + 8 * j; const LAS float* s = scr + (8 * c) * 33 + n;
        u32x4 o; o.x = cvt_pk_bf16(s[0 * 33], s[1 * 33]); o.y = cvt_pk_bf16(s[2 * 33], s[3 * 33]); o.z = cvt_pk_bf16(s[4 * 33], s[5 * 33]); o.w = cvt_pk_bf16(s[6 * 33], s[7 * 33]);
        *(u32x4*)(WT + (size_t)(n0 + n) * K + k0 + 8 * c) = o; }
    LDS_WAIT(); asm volatile("" ::: "memory");
}

__device__ __forceinline__ void xb_row(const Frame& F, const float* xp, const float* xs, int m) {
    const f32x4* xr = (const f32x4*)xrow(xp, xs, m) + F.lane;
    bf16* orow = (bf16*)(F.ws + WS_XB) + (size_t)m * D;
    float ssq = 0.f;
#pragma unroll
    for (int j = 0; j < 16; ++j) { const f32x4 v = xr[64 * j]; ssq += (v[0] * v[0] + v[1] * v[1]) + (v[2] * v[2] + v[3] * v[3]);
        u32x2 w; w.x = cvt_pk_bf16(v[0], v[1]); w.y = cvt_pk_bf16(v[2], v[3]); *((u32x2*)orow + F.lane + 64 * j) = w; }
    ssq = wave_sum(ssq);
    if (F.lane == 0) ((float*)(F.ws + WS_RSTD0))[m] = 1.0f / sqrtf(ssq * (1.0f / D) + RMS_EPS);
}
__device__ __forceinline__ void row_pass(const Frame& F, const float* base, const float* add, const float* ps, const float* g, float* out, bf16* outb, float* rstd_out) {
    const float rsa = 1.0f / sqrtf(wave_sum(ps[F.lane]) * (1.0f / D) + RMS_EPS);
    float ssq = 0.f;
#pragma unroll
    for (int j = 0; j < 16; ++j) { const int c4 = F.lane + 64 * j;
        const f32x4 b = ((const f32x4*)base)[c4], a = ((const f32x4*)add)[c4], gg = ((const f32x4*)g)[c4];
        const f32x4 h = b + a * rsa * gg;
        ssq += (h[0] * h[0] + h[1] * h[1]) + (h[2] * h[2] + h[3] * h[3]);
        ((f32x4*)out)[c4] = h;
        u32x2 w; w.x = cvt_pk_bf16(h[0], h[1]); w.y = cvt_pk_bf16(h[2], h[3]); ((u32x2*)outb)[c4] = w;
        if ((j & 3) == 3) asm volatile("" ::: "memory"); }
    ssq = wave_sum(ssq);
    if (F.lane == 0) *rstd_out = 1.0f / sqrtf(ssq * (1.0f / D) + RMS_EPS);
}

__device__ __forceinline__ float dot8(const u32x4 a, const u32x4 b) {
    return (bf_lo(a.x) * bf_lo(b.x) + bf_hi(a.x) * bf_hi(b.x)) + (bf_lo(a.y) * bf_lo(b.y) + bf_hi(a.y) * bf_hi(b.y)) +
           (bf_lo(a.z) * bf_lo(b.z) + bf_hi(a.z) * bf_hi(b.z)) + (bf_lo(a.w) * bf_lo(b.w) + bf_hi(a.w) * bf_hi(b.w));
}
__device__ __forceinline__ void attn_slow_task(const Frame& F, const float* rpb, int tok, int h) {
    const int lane = F.lane;
    const bf16* Qb = (const bf16*)(F.ws + WS_Q); const bf16* Kb = (const bf16*)(F.ws + WS_K); const bf16* Vb = (const bf16*)(F.ws + WS_V);
    const int R = tok >> 6, c = tok & 63;
    int Rb, rows; if (R < 64) { Rb = 0; rows = 64; } else if (R < 128) { Rb = 64; rows = 64; } else { Rb = 128; rows = 256; }
    const int r = R - Rb;
    int rs = r - 4; rs = rs < 0 ? 0 : rs; rs = rs > rows - 8 ? rows - 8 : rs;
    int cs = c - 8; cs = cs < 0 ? 0 : cs; cs = cs > 48 ? 48 : cs;
    const u32x4* qp = (const u32x4*)(Qb + (size_t)tok * AW + h * HD);
    float sc[2];
#pragma unroll
    for (int j2 = 0; j2 < 2; ++j2) { const int kk = lane + 64 * j2, kr = kk >> 4, kc = cs + (kk & 15);
        const int ktok = (Rb + rs + kr) * 64 + kc;
        const u32x4* kp = (const u32x4*)(Kb + (size_t)ktok * AW + h * HD);
        float s = 0.f;
#pragma unroll
        for (int d8 = 0; d8 < 16; ++d8) s += dot8(qp[d8], kp[d8]);
        const int dr = (rs + kr) - r + 7; int dc = kc - c + 15; dc = dc < 0 ? 0 : dc; dc = dc > 30 ? 30 : dc;
        s += rpb[(h * 15 + dr) * 31 + dc] * LOG2E;
        sc[j2] = s; }
    const float mx = wave_max(fmaxf(sc[0], sc[1]));
    const float p0 = exp2f(sc[0] - mx), p1 = exp2f(sc[1] - mx);
    const float l = wave_sum(p0 + p1);
    float o0 = 0.f, o1 = 0.f;
    for (int kk = 0; kk < 128; ++kk) { const float pk = __shfl(kk < 64 ? p0 : p1, kk & 63);
        const int kr = kk >> 4, kc = cs + (kk & 15); const int ktok = (Rb + rs + kr) * 64 + kc;
        const unsigned vv = *(const unsigned*)(Vb + (size_t)ktok * AW + h * HD + 2 * lane);
        o0 += pk * bf_lo(vv); o1 += pk * bf_hi(vv); }
    const float inv = 1.0f / l; o0 *= inv; o1 *= inv;
    *(unsigned*)((bf16*)(F.ws + WS_XB) + (size_t)tok * D + h * HD + 2 * lane) = cvt_pk_bf16(o0, o1);
    const float ssq = wave_sum(o0 * o0 + o1 * o1);
    if (lane == 0) ((float*)(F.ws + WS_PSATT))[(size_t)tok * 16 + h] = ssq;
}

template <int dir> __device__ __forceinline__ void ssm_slow_task(const Frame& F, int task) {
    const int lane = F.lane, p = lane;
    const int g = (task >> 1) & 127, seq = task >> 8;
    const int t0 = seq == 0 ? 0 : (seq == 1 ? 4096 : 8192); const int L = seq == 2 ? 16384 : 4096;
    const float* lam_re = ARGP(dir ? 14 : 7); const float* lam_im = ARGP(dir ? 15 : 8); const float* log_dt = ARGP(dir ? 16 : 9);
    const float* b_re = ARGP(dir ? 17 : 10); const float* b_im = ARGP(dir ? 18 : 11); const float* c_re = ARGP(dir ? 19 : 12); const float* c_im = ARGP(dir ? 20 : 13);
    const float lr = fminf(lam_re[g * SP + p], -1e-4f), li = lam_im[g * SP + p], dt = expf(log_dt[g]);
    const float mag = expf(lr * dt); float sn, cs; sincosf(li * dt, &sn, &cs);
    const float lbr = mag * cs, lbi = mag * sn, den = lr * lr + li * li, nr = lbr - 1.0f;
    const float cr = (nr * lr + lbi * li) / den, ci = (lbi * lr - nr * li) / den;
    float bbr[16], bbi[16], ccr[16], cci[16];
#pragma unroll
    for (int h = 0; h < 16; ++h) { const float br = b_re[(size_t)(g * SP + p) * 16 + h], bi = b_im[(size_t)(g * SP + p) * 16 + h];
        bbr[h] = cr * br - ci * bi; bbi[h] = cr * bi + ci * br;
        ccr[h] = c_re[(size_t)(g * 16 + h) * SP + p]; cci[h] = c_im[(size_t)(g * 16 + h) * SP + p]; }
    const bf16* Ug = (const bf16*)(F.ws + WS_UG) + (size_t)g * T * 16;
    float* Y = F.out + (size_t)dir * T * AW;
    unsigned vz; asm volatile("v_mov_b32 %0, 0" : "=v"(vz));
    float sr = 0.f, si = 0.f;
    const int hsel = (lane >> 2) & 15; const bool b5 = lane & 32, b4 = lane & 16, b3 = lane & 8, b2 = lane & 4;
    for (int blk = 0; blk < L / 4; ++blk) {
        const int tb = dir ? (L - 4 - 4 * blk) : 4 * blk;
        const u32x4* up = (const u32x4*)(Ug + (size_t)(t0 + tb) * 16 + vz);
        u32x4 uu[8];
#pragma unroll
        for (int i = 0; i < 8; ++i) uu[i] = up[i];
#pragma unroll
        for (int s4 = 0; s4 < 4; ++s4) { const int ti = dir ? 3 - s4 : s4; const int tok = t0 + tb + ti;
            const u32x4 ua = dir ? uu[2 * (3 - s4)] : uu[2 * s4], ub = dir ? uu[2 * (3 - s4) + 1] : uu[2 * s4 + 1];
            float u[16];
            u[0] = bf_lo(ua.x); u[1] = bf_hi(ua.x); u[2] = bf_lo(ua.y); u[3] = bf_hi(ua.y); u[4] = bf_lo(ua.z); u[5] = bf_hi(ua.z); u[6] = bf_lo(ua.w); u[7] = bf_hi(ua.w);
            u[8] = bf_lo(ub.x); u[9] = bf_hi(ub.x); u[10] = bf_lo(ub.y); u[11] = bf_hi(ub.y); u[12] = bf_lo(ub.z); u[13] = bf_hi(ub.z); u[14] = bf_lo(ub.w); u[15] = bf_hi(ub.w);
            float bur = 0.f, bui = 0.f;
#pragma unroll
            for (int h = 0; h < 16; ++h) { bur += bbr[h] * u[h]; bui += bbi[h] * u[h]; }
            const float nsr = lbr * sr - lbi * si + bur, nsi = lbr * si + lbi * sr + bui; sr = nsr; si = nsi;
            float v[16];
#pragma unroll
            for (int h = 0; h < 16; ++h) v[h] = ccr[h] * sr - cci[h] * si;
            float w8[8], w4[4], w2[2];
#pragma unroll
            for (int i = 0; i < 8; ++i) { const float keep = b5 ? v[8 + i] : v[i], send = b5 ? v[i] : v[8 + i]; w8[i] = keep + __shfl_xor(send, 32); }
#pragma unroll
            for (int i = 0; i < 4; ++i) { const float keep = b4 ? w8[4 + i] : w8[i], send = b4 ? w8[i] : w8[4 + i]; w4[i] = keep + __shfl_xor(send, 16); }
#pragma unroll
            for (int i = 0; i < 2; ++i) { const float keep = b3 ? w4[2 + i] : w4[i], send = b3 ? w4[i] : w4[2 + i]; w2[i] = keep + __shfl_xor(send, 8); }
            float w1 = (b2 ? w2[1] : w2[0]) + __shfl_xor(b2 ? w2[0] : w2[1], 4);
            w1 += __shfl_xor(w1, 2); w1 += __shfl_xor(w1, 1);
            if ((lane & 3) == 0) Y[(size_t)tok * AW + g * 16 + hsel] = w1; }
    }
}


typedef float f32x16 __attribute__((ext_vector_type(16)));
typedef short s16x4 __attribute__((ext_vector_type(4)));
#define MFMA32(a, b, c) __builtin_amdgcn_mfma_f32_32x32x16_bf16((a), (b), (c), 0, 0, 0)
constexpr int NCH = T / 32;

__device__ __forceinline__ void ssm_tables(const Frame& F, int g) {
    LAS float* BBr = (LAS float*)F.lds; LAS float* BBi = BBr + 2048; LAS float* CCr = BBi + 2048; LAS float* CCi = CCr + 2048;
    LAS float* PWr = CCi + 2048; LAS float* PWi = PWr + 4224;
    const int tid = F.tid;
    const float* lamre[2] = {ARGP(7), ARGP(14)}; const float* lamim[2] = {ARGP(8), ARGP(15)}; const float* logdt[2] = {ARGP(9), ARGP(16)};
    {   const float* bre0 = ARGP(10); const float* bim0 = ARGP(11); const float* bre1 = ARGP(17); const float* bim1 = ARGP(18);
        const float* cre0 = ARGP(12); const float* cim0 = ARGP(13); const float* cre1 = ARGP(19); const float* cim1 = ARGP(20);
        for (int idx = tid; idx < 2048; idx += 512) {
            { const int dir = idx >> 10, p = (idx >> 4) & 63, h = idx & 15;
              const float lr = fminf((dir ? lamre[1] : lamre[0])[g * SP + p], -1e-4f), li = (dir ? lamim[1] : lamim[0])[g * SP + p], dt = expf((dir ? logdt[1] : logdt[0])[g]);
              const float mag = expf(lr * dt); float sn, cs; sincosf(li * dt, &sn, &cs);
              const float lbr = mag * cs, lbi = mag * sn, den = lr * lr + li * li, nr = lbr - 1.0f;
              const float cr = (nr * lr + lbi * li) / den, ci = (lbi * lr - nr * li) / den;
              const float br = (dir ? bre1 : bre0)[(size_t)(g * SP + p) * 16 + h], bi = (dir ? bim1 : bim0)[(size_t)(g * SP + p) * 16 + h];
              BBr[idx] = cr * br - ci * bi; BBi[idx] = cr * bi + ci * br; }
            { const int dir = idx >> 10, h = (idx >> 6) & 15, p = idx & 63;
              CCr[idx] = (dir ? cre1 : cre0)[(size_t)(g * 16 + h) * SP + p]; CCi[idx] = (dir ? cim1 : cim0)[(size_t)(g * 16 + h) * SP + p]; }
        }
        for (int idx = tid; idx < 4224; idx += 512) { const int dir = idx / 2112, n = (idx % 2112) >> 6, p = idx & 63;
            const float lr = fminf((dir ? lamre[1] : lamre[0])[g * SP + p], -1e-4f), li = (dir ? lamim[1] : lamim[0])[g * SP + p], dt = expf((dir ? logdt[1] : logdt[0])[g]);
            const float mag = expf(lr * dt * (float)n); float sn, cs; sincosf(li * dt * (float)n, &sn, &cs);
            PWr[idx] = mag * cs; PWi[idx] = mag * sn; }
    }
    __syncthreads();
    bf16* MBg = (bf16*)(F.ws + WS_MB) + (size_t)g * 256 * 512; bf16* MCg = (bf16*)(F.ws + WS_MC) + (size_t)g * 512 * 256; bf16* Kt = (bf16*)(F.ws + WS_KTAB) + (size_t)g * 16384;
    for (int task = tid; task < 8192; task += 512) { const int hb = task & 1, ip = (task >> 1) & 31, p = (task >> 6) & 63, dir = task >> 12;
        const int n = dir ? ip : 31 - ip; const float pr = PWr[dir * 2112 + n * 64 + p], pi = PWi[dir * 2112 + n * 64 + p];
        float vr[8], vi[8];
#pragma unroll
        for (int j = 0; j < 8; ++j) { const float br = BBr[(dir * 64 + p) * 16 + 8 * hb + j], bi = BBi[(dir * 64 + p) * 16 + 8 * hb + j]; vr[j] = pr * br - pi * bi; vi[j] = pr * bi + pi * br; }
        u32x4 wr_, wi_; wr_.x = cvt_pk_bf16(vr[0], vr[1]); wr_.y = cvt_pk_bf16(vr[2], vr[3]); wr_.z = cvt_pk_bf16(vr[4], vr[5]); wr_.w = cvt_pk_bf16(vr[6], vr[7]);
        wi_.x = cvt_pk_bf16(vi[0], vi[1]); wi_.y = cvt_pk_bf16(vi[2], vi[3]); wi_.z = cvt_pk_bf16(vi[4], vi[5]); wi_.w = cvt_pk_bf16(vi[6], vi[7]);
        *(u32x4*)(MBg + (size_t)(dir * 128 + 2 * p) * 512 + ip * 16 + 8 * hb) = wr_;
        *(u32x4*)(MBg + (size_t)(dir * 128 + 2 * p + 1) * 512 + ip * 16 + 8 * hb) = wi_; }
    for (int task = tid; task < 16384; task += 512) { const int pb = task & 15, dir = (task >> 4) & 1, h = (task >> 5) & 15, i = task >> 9;
        const int n = dir ? 32 - i : i + 1; float v[8];
#pragma unroll
        for (int j = 0; j < 4; ++j) { const int p = 4 * pb + j; const float cr = CCr[(dir * 16 + h) * 64 + p], ci = CCi[(dir * 16 + h) * 64 + p], pr = PWr[dir * 2112 + n * 64 + p], pi = PWi[dir * 2112 + n * 64 + p];
            v[2 * j] = cr * pr - ci * pi; v[2 * j + 1] = -(cr * pi + ci * pr); }
        u32x4 w; w.x = cvt_pk_bf16(v[0], v[1]); w.y = cvt_pk_bf16(v[2], v[3]); w.z = cvt_pk_bf16(v[4], v[5]); w.w = cvt_pk_bf16(v[6], v[7]);
        *(u32x4*)(MCg + (size_t)(i * 16 + h) * 256 + dir * 128 + 8 * pb) = w; }
    const float* dsk = ARGP(21);
    for (int task = tid; task < 2016; task += 512) { const int hb = task & 1, h = (task >> 1) & 15, di = task >> 5; const int d = di - 31;
        float acc[8];
#pragma unroll
        for (int j = 0; j < 8; ++j) acc[j] = 0.f;
        for (int dir = 0; dir < 2; ++dir) { if ((dir == 0 && d < 0) || (dir == 1 && d > 0)) continue; const int n = d < 0 ? -d : d;
            for (int p = 0; p < 64; ++p) { const float cr = CCr[(dir * 16 + h) * 64 + p], ci = CCi[(dir * 16 + h) * 64 + p], pr = PWr[dir * 2112 + n * 64 + p], pi = PWi[dir * 2112 + n * 64 + p];
                const float wr_ = cr * pr - ci * pi, wi_ = cr * pi + ci * pr;
#pragma unroll
                for (int j = 0; j < 8; ++j) acc[j] += wr_ * BBr[(dir * 64 + p) * 16 + 8 * hb + j] - wi_ * BBi[(dir * 64 + p) * 16 + 8 * hb + j]; } }
        if (d == 0) {
#pragma unroll
            for (int j = 0; j < 8; ++j) if (8 * hb + j == h) acc[j] += dsk[g * 16 + h]; }
        u32x4 w; w.x = cvt_pk_bf16(acc[0], acc[1]); w.y = cvt_pk_bf16(acc[2], acc[3]); w.z = cvt_pk_bf16(acc[4], acc[5]); w.w = cvt_pk_bf16(acc[6], acc[7]);
        *(u32x4*)(Kt + (size_t)(di * 16 + h) * 16 + 8 * hb) = w; }
    __syncthreads();
}

__device__ __forceinline__ void ssm_stage_a(const Frame& F, int unit) {
    const int mh = unit & 1, ct = (unit >> 1) % 24, G8 = unit / 48;
    const int g = G8 * 8 + F.wave, r = F.lane & 31, hf = F.lane >> 5;
    const bf16* Up = (const bf16*)(F.ws + WS_UG) + ((size_t)g * T + (size_t)(ct * 32 + r) * 32) * 16 + 8 * hf;
    const bf16* Ap = (const bf16*)(F.ws + WS_MB) + ((size_t)g * 256 + 128 * mh + r) * 512 + 8 * hf;
    f32x16 acc[4];
#pragma unroll
    for (int m = 0; m < 4; ++m)
#pragma unroll
        for (int i = 0; i < 16; ++i) acc[m][i] = 0.f;
#pragma unroll 4
    for (int ks = 0; ks < 32; ++ks) { const bf16x8 b = *(const bf16x8*)(Up + ks * 16);
#pragma unroll
        for (int m = 0; m < 4; ++m) { const bf16x8 a = *(const bf16x8*)(Ap + (size_t)m * 32 * 512 + ks * 16); acc[m] = MFMA32(a, b, acc[m]); } }
    float* Sp = (float*)(F.ws + WS_S) + ((size_t)g * NCH + ct * 32 + r) * 256 + 128 * mh + 4 * hf;
#pragma unroll
    for (int m = 0; m < 4; ++m)
#pragma unroll
        for (int q = 0; q < 4; ++q) *(f32x4*)(Sp + 32 * m + 8 * q) = (f32x4){acc[m][4 * q], acc[m][4 * q + 1], acc[m][4 * q + 2], acc[m][4 * q + 3]};
}

template <int dir> __device__ __forceinline__ void ssm_scan_task(const Frame& F, int task) {
    const int p = F.lane, g = (task >> 1) & 127, seq = task >> 8;
    const int c0 = seq == 0 ? 0 : (seq == 1 ? 128 : 256), nc = seq == 2 ? 512 : 128;
    const float lr = fminf(ARGP(dir ? 14 : 7)[g * SP + p], -1e-4f), li = ARGP(dir ? 15 : 8)[g * SP + p], dt = expf(ARGP(dir ? 16 : 9)[g]);
    const float mag = expf(lr * dt * 32.0f); float sn, cs; sincosf(li * dt * 32.0f, &sn, &cs);
    const float qr = mag * cs, qi = mag * sn;
    const float* Sg = (const float*)(F.ws + WS_S) + (size_t)g * NCH * 256 + dir * 128 + 2 * p;
    bf16* Hg = (bf16*)(F.ws + WS_HB) + (size_t)g * NCH * 256 + dir * 128 + 2 * p;
    float hr = 0.f, hi = 0.f;
    f32x2 cur[32];
#pragma unroll
    for (int j = 0; j < 32; ++j) { const int c = dir ? (c0 + nc - 1 - j) : (c0 + j); cur[j] = *(const f32x2*)(Sg + (size_t)c * 256); }
    for (int sb = 0; sb < nc / 32; ++sb) {
        f32x2 nxt[32];
        const int sbn = (sb + 1 < nc / 32) ? sb + 1 : sb;
#pragma unroll
        for (int j = 0; j < 32; ++j) { const int k = sbn * 32 + j; const int c = dir ? (c0 + nc - 1 - k) : (c0 + k); nxt[j] = *(const f32x2*)(Sg + (size_t)c * 256); }
#pragma unroll
        for (int j = 0; j < 32; ++j) { const int k = sb * 32 + j; const int c = dir ? (c0 + nc - 1 - k) : (c0 + k);
            *(unsigned*)(Hg + (size_t)c * 256) = cvt_pk_bf16(hr, hi);
            const float nr = qr * hr - qi * hi + cur[j].x, ni = qr * hi + qi * hr + cur[j].y; hr = nr; hi = ni; }
#pragma unroll
        for (int j = 0; j < 32; ++j) cur[j] = nxt[j];
    }
}

__device__ __forceinline__ void ssm_stage_c(const Frame& F, int unit) {
    const int mb = unit & 3, ct = (unit >> 2) % 24, G8 = unit / 96;
    const int g = G8 * 8 + F.wave, r = F.lane & 31, hf = F.lane >> 5;
    const bf16* Up = (const bf16*)(F.ws + WS_UG) + ((size_t)g * T + (size_t)(ct * 32 + r) * 32) * 16 + 8 * hf;
    const bf16* Kp = (const bf16*)(F.ws + WS_KTAB) + (size_t)g * 16384 + ((r >> 4) + 31 + 8 * mb) * 256 + (r & 15) * 16 + 8 * hf;
    const bf16* Hp = (const bf16*)(F.ws + WS_HB) + ((size_t)g * NCH + ct * 32 + r) * 256 + 8 * hf;
    const bf16* Cp = (const bf16*)(F.ws + WS_MC) + ((size_t)g * 512 + 128 * mb + r) * 256 + 8 * hf;
    f32x16 acc[4];
#pragma unroll
    for (int m = 0; m < 4; ++m)
#pragma unroll
        for (int i = 0; i < 16; ++i) acc[m][i] = 0.f;
#pragma unroll 4
    for (int ks = 0; ks < 32; ++ks) { const bf16x8 b = *(const bf16x8*)(Up + ks * 16);
#pragma unroll
        for (int m = 0; m < 4; ++m) { const bf16x8 a = *(const bf16x8*)(Kp + (2 * m - ks) * 256); acc[m] = MFMA32(a, b, acc[m]); } }
#pragma unroll 4
    for (int ks = 0; ks < 16; ++ks) { const bf16x8 b = *(const bf16x8*)(Hp + ks * 16);
#pragma unroll
        for (int m = 0; m < 4; ++m) { const bf16x8 a = *(const bf16x8*)(Cp + (size_t)m * 32 * 256 + ks * 16); acc[m] = MFMA32(a, b, acc[m]); } }
    bf16* Zp = (bf16*)(F.ws + WS_Z) + ((size_t)(ct * 32 + r) * 32 + 8 * mb) * AW + g * 16 + 4 * hf;
#pragma unroll
    for (int m = 0; m < 4; ++m)
#pragma unroll
        for (int q = 0; q < 4; ++q) { u32x2 w; w.x = cvt_pk_bf16(gelu_tanh(acc[m][4 * q]), gelu_tanh(acc[m][4 * q + 1])); w.y = cvt_pk_bf16(gelu_tanh(acc[m][4 * q + 2]), gelu_tanh(acc[m][4 * q + 3]));
            *(u32x2*)(Zp + (size_t)(2 * m + (q >> 1)) * AW + 8 * (q & 1)) = w; }
}

constexpr int BT_OFF = 132096;
__device__ __forceinline__ void attn_unit(const Frame& F, const float* rpb, int unit) {
    const int h = unit & 15, rg = unit >> 4;
    const int lane = F.lane, wave = F.wave, qrow = wave >> 1, qt = wave & 1;
    const int R = 4 * rg + qrow;
    int Rb, rows; if (R < 64) { Rb = 0; rows = 64; } else if (R < 128) { Rb = 64; rows = 64; } else { Rb = 128; rows = 256; }
    const int r = R - Rb; int rs = r - 4; rs = rs < 0 ? 0 : rs; rs = rs > rows - 8 ? rows - 8 : rs;
    const int j31 = lane & 31, hf = lane >> 5;
    const int c = 32 * qt + j31; int cs = c - 8; cs = cs < 0 ? 0 : cs; cs = cs > 48 ? 48 : cs;
    const int tokq = R * 64 + c;
    LAS float* bt = (LAS float*)(F.lds + BT_OFF);
    __syncthreads();
    for (int i = F.tid; i < 465; i += 512) bt[i] = rpb[h * 465 + i] * LOG2E;
    __syncthreads();
    const bf16* Qb = (const bf16*)(F.ws + WS_Q); const bf16* Kb = (const bf16*)(F.ws + WS_K); const bf16* Vb = (const bf16*)(F.ws + WS_V);
    bf16x8 qf[8];
    { const bf16* qp = Qb + (size_t)tokq * AW + h * HD + 8 * hf;
#pragma unroll
      for (int s_ = 0; s_ < 8; ++s_) qf[s_] = *(const bf16x8*)(qp + 16 * s_); }
    f32x16 O[4];
#pragma unroll
    for (int d = 0; d < 4; ++d)
#pragma unroll
        for (int i = 0; i < 16; ++i) O[d][i] = 0.f;
    float mrun = -1e30f, lrun = 0.f;
    LAS unsigned char* vl = F.lds + wave * 16384; const unsigned vbase = (unsigned)(uintptr_t)vl;
    const int i16 = lane & 15, q4 = i16 >> 2, pp = i16 & 3, g1 = (lane >> 4) & 1;
    unsigned tb[4][2];
#pragma unroll
    for (int d = 0; d < 4; ++d)
#pragma unroll
        for (int sec = 0; sec < 2; ++sec) { const int row_l = 4 * hf + 8 * sec + q4, swz = (q4 << 2) | ((hf + 2 * sec) & 3), ch = 4 * d + 2 * g1 + (pp >> 1);
            tb[d][sec] = vbase + 256 * row_l + 16 * (ch ^ swz) + 8 * (pp & 1); }
    const int vrow = lane >> 4, vch = lane & 15;
    for (int j = 0; j < 8; ++j) {
        const int Rk = Rb + rs + j;
        { const bf16* vp = Vb + (size_t)(Rk * 64 + vrow) * AW + h * HD + vch * 8;
#pragma unroll
          for (int hh = 0; hh < 2; ++hh) { u32x4 vv[8];
#pragma unroll
            for (int i8 = 0; i8 < 8; ++i8) vv[i8] = *(const u32x4*)(vp + (size_t)(4 * (hh * 8 + i8)) * AW);
#pragma unroll
            for (int i8 = 0; i8 < 8; ++i8) { const int i = hh * 8 + i8; *(LAS u32x4*)(vl + 256 * (vrow + 4 * i) + 16 * (vch ^ (((vrow & 3) << 2) | (i & 3)))) = vv[i8]; } } }
        f32x16 sacc[2];
        { const bf16* kp = Kb + (size_t)(Rk * 64 + j31) * AW + h * HD + 8 * hf;
#pragma unroll
          for (int kt = 0; kt < 2; ++kt) {
#pragma unroll
            for (int i = 0; i < 16; ++i) sacc[kt][i] = 0.f;
#pragma unroll
            for (int s_ = 0; s_ < 8; ++s_) { const bf16x8 a = *(const bf16x8*)(kp + (size_t)(32 * kt) * AW + 16 * s_); sacc[kt] = MFMA32(a, qf[s_], sacc[kt]); } } }
        const int dr = (rs + j) - r + 7;
        float mloc = -1e30f;
#pragma unroll
        for (int kt = 0; kt < 2; ++kt)
#pragma unroll
            for (int rg_ = 0; rg_ < 16; ++rg_) { const int kc = 32 * kt + (rg_ & 3) + 8 * (rg_ >> 2) + 4 * hf;
                int idx = kc - c + 15; idx = idx < 0 ? 0 : idx; idx = idx > 30 ? 30 : idx;
                const float sc = ((unsigned)(kc - cs) < 16u) ? sacc[kt][rg_] + bt[dr * 31 + idx] : -1e30f;
                sacc[kt][rg_] = sc; mloc = fmaxf(mloc, sc); }
        mloc = fmaxf(mloc, __shfl_xor(mloc, 32));
        const float mnew = fmaxf(mrun, mloc), alpha = __builtin_amdgcn_exp2f(mrun - mnew); mrun = mnew;
        float psum = 0.f;
#pragma unroll
        for (int kt = 0; kt < 2; ++kt)
#pragma unroll
            for (int rg_ = 0; rg_ < 16; ++rg_) { const float p = __builtin_amdgcn_exp2f(sacc[kt][rg_] - mnew); sacc[kt][rg_] = p; psum += p; }
        lrun = lrun * alpha + psum;
#pragma unroll
        for (int d = 0; d < 4; ++d)
#pragma unroll
            for (int i = 0; i < 16; ++i) O[d][i] *= alpha;
        bf16x8 pb[2][2];
#pragma unroll
        for (int kt = 0; kt < 2; ++kt)
#pragma unroll
            for (int s2 = 0; s2 < 2; ++s2) { u32x4 w; w.x = cvt_pk_bf16(sacc[kt][8 * s2], sacc[kt][8 * s2 + 1]); w.y = cvt_pk_bf16(sacc[kt][8 * s2 + 2], sacc[kt][8 * s2 + 3]);
                w.z = cvt_pk_bf16(sacc[kt][8 * s2 + 4], sacc[kt][8 * s2 + 5]); w.w = cvt_pk_bf16(sacc[kt][8 * s2 + 6], sacc[kt][8 * s2 + 7]); pb[kt][s2] = __builtin_bit_cast(bf16x8, w); }
#pragma unroll
        for (int d = 0; d < 4; ++d) { s16x4 f0, f1, f2, f3, f4, f5, f6, f7;
            asm volatile("ds_read_b64_tr_b16 %0, %8\n\tds_read_b64_tr_b16 %1, %9\n\tds_read_b64_tr_b16 %2, %8 offset:4096\n\tds_read_b64_tr_b16 %3, %9 offset:4096\n\t"
                         "ds_read_b64_tr_b16 %4, %8 offset:8192\n\tds_read_b64_tr_b16 %5, %9 offset:8192\n\tds_read_b64_tr_b16 %6, %8 offset:12288\n\tds_read_b64_tr_b16 %7, %9 offset:12288\n\ts_waitcnt lgkmcnt(0)"
                         : "=&v"(f0), "=&v"(f1), "=&v"(f2), "=&v"(f3), "=&v"(f4), "=&v"(f5), "=&v"(f6), "=&v"(f7) : "v"(tb[d][0]), "v"(tb[d][1]) : "memory");
            O[d] = MFMA32(__builtin_shufflevector(f0, f1, 0, 1, 2, 3, 4, 5, 6, 7), pb[0][0], O[d]);
            O[d] = MFMA32(__builtin_shufflevector(f2, f3, 0, 1, 2, 3, 4, 5, 6, 7), pb[0][1], O[d]);
            O[d] = MFMA32(__builtin_shufflevector(f4, f5, 0, 1, 2, 3, 4, 5, 6, 7), pb[1][0], O[d]);
            O[d] = MFMA32(__builtin_shufflevector(f6, f7, 0, 1, 2, 3, 4, 5, 6, 7), pb[1][1], O[d]); }
    }
    const float inv = 1.0f / (lrun + __shfl_xor(lrun, 32));
    bf16* op = (bf16*)(F.ws + WS_XB) + (size_t)tokq * D + h * HD + 4 * hf;
    float ssq = 0.f;
#pragma unroll
    for (int d = 0; d < 4; ++d)
#pragma unroll
        for (int q = 0; q < 4; ++q) { const float o0 = O[d][4 * q] * inv, o1 = O[d][4 * q + 1] * inv, o2 = O[d][4 * q + 2] * inv, o3 = O[d][4 * q + 3] * inv;
            ssq += (o0 * o0 + o1 * o1) + (o2 * o2 + o3 * o3);
            u32x2 w; w.x = cvt_pk_bf16(o0, o1); w.y = cvt_pk_bf16(o2, o3); *(u32x2*)(op + 32 * d + 8 * q) = w; }
    ssq += __shfl_xor(ssq, 32);
    if (hf == 0) ((float*)(F.ws + WS_PSATT))[(size_t)tokq * 16 + h] = ssq;
}

__global__ void __launch_bounds__(NWAVES * 64, 2) fwd_kernel(Args args) {
    extern __shared__ __attribute__((aligned(16))) unsigned char lds_raw[];
    Frame F;
    F.lds = (LAS unsigned char*)lds_raw;
    F.wave = __builtin_amdgcn_readfirstlane((int)threadIdx.x >> 6); F.lane = lane_op(); F.tid = F.wave * 64 + F.lane;
    F.G = gridDim.x; F.gw = blockIdx.x * NWAVES + F.wave; F.NGW = F.G * NWAVES;
    F.out = args.out; F.ws = args.ws;
    unsigned char* ws = args.ws;
    volatile LAS unsigned* MISC = (volatile LAS unsigned*)(F.lds + MISC_OFF);
    for (int u = F.tid; u < (LDS_BYTES - RING_BYTES) / 4; u += NWAVES * 64) ((LAS unsigned*)(F.lds + RING_BYTES))[u] = 0u;
    __syncthreads();
    XcdBarrier bar = xcd_barrier_post((unsigned*)(ws + WS_CTL) + CW_BAR, MISC + 8, F.wave);
    const int lo = args.ph_lo, hi = args.ph_hi;
#define IN(k) (lo <= (k) && (k) < hi)
#define PH_BEGIN() do { F.lane = lane_op(); F.tid = F.wave * 64 + F.lane; } while (0)
#define SEAM(k) do { if (IN(k) && IN((k) + 1)) xcd_barrier(bar); } while (0)

    bf16* XB = (bf16*)(ws + WS_XB);
    float* rstd0 = (float*)(ws + WS_RSTD0); float* rstd1 = (float*)(ws + WS_RSTD1); float* rstd2 = (float*)(ws + WS_RSTD2);
    float* ratio = (float*)(ws + WS_RATIO); float* rsssm = (float*)(ws + WS_RSSSM);
    float* psatt = (float*)(ws + WS_PSATT); float* psssm = (float*)(ws + WS_PSSSM); float* psmix = (float*)(ws + WS_PSMIX); float* psm = (float*)(ws + WS_PSM);
    LAS float* scr = (LAS float*)(F.lds + F.wave * 16384);

    if (IN(0)) { PH_BEGIN();
        for (int g = blockIdx.x; g < NG; g += F.G) ssm_tables(F, g);
        constexpr int I_IN = (D / 64) * (NIN / 32), I_GLU = (AW / 64) * (AW / 32), I_OUT = (D / 64) * (D / 32);
        { const float* w_in = ARGP(5); const float* g_pre = ARGP(4); const float* w_glu = ARGP(22); const float* w_out = ARGP(26); const float* g_att = ARGP(24); const float* g_ssm = ARGP(25);
        for (int it = F.gw; it < I_IN + I_GLU + I_OUT; it += F.NGW) {
            int r = it;
            if (r < I_IN) { transpose_item(w_in, D, NIN, (bf16*)(ws + WS_WIN), g_pre, AW, QSCALE, scr, r, F.lane); continue; } r -= I_IN;
            if (r < I_GLU) { transpose_item(w_glu, AW, AW, (bf16*)(ws + WS_WGLU), nullptr, 0, 1.f, scr, r, F.lane); continue; } r -= I_GLU;
            {
                const int nblk = D / 32, kb = r / nblk; const int k0 = 64 * kb;
                const float* gk = k0 < AW ? g_att : g_ssm - AW;
                transpose_item(w_out, D, D, (bf16*)(ws + WS_WOUT), gk, 0, 1.f, scr, r, F.lane); }
        } }
        { const float* xp = ARGP(0); const float* xs = ARGP(1);
        for (int m = F.gw; m < T; m += F.NGW) xb_row(F, xp, xs, m); }
        const float* pep = ARGP(2); const float* pes = ARGP(3);
        for (int i = F.gw * 64 + F.lane; i < T * PLE / 4; i += F.NGW * 64) { const int m = i / (PLE / 4), c4 = i % (PLE / 4);
            const f32x4 v = ((const f32x4*)perow(pep, pes, m))[c4]; u32x2 w; w.x = cvt_pk_bf16(v[0], v[1]); w.y = cvt_pk_bf16(v[2], v[3]);
            ((u32x2*)(ws + WS_PEB))[i] = w; }
    }
    SEAM(0);
    if (IN(1)) { PH_BEGIN();
        pg8::Gemm g{XB, (const bf16*)(ws + WS_WIN), T, NIN, D, F.wave}; pg8::StaticOrder S; S.init(T, NIN, F.G, (int)blockIdx.x);
        pg8::EpiProj E{(bf16*)(ws + WS_Q), (bf16*)(ws + WS_UG), rstd0};
        pg8::gemm_phase<pg8::EpiProj, pg8::StaticOrder, true, true>(F.lds, g, S, E);
    }
    SEAM(1);
    if (IN(2)) { PH_BEGIN();
        for (int unit = blockIdx.x; unit < 768; unit += F.G) ssm_stage_a(F, unit);
        const float* rpb = ARGP(6);
        for (int unit = blockIdx.x; unit < 1536; unit += F.G) attn_unit(F, rpb, unit);
    }
    SEAM(2);
    if (IN(3)) { PH_BEGIN();
        for (int task = F.wave * F.G + blockIdx.x; task < 768; task += F.NGW) { if (task & 1) ssm_scan_task<1>(F, task); else ssm_scan_task<0>(F, task); }
    }
    SEAM(3);
    if (IN(4)) { PH_BEGIN();
        for (int unit = blockIdx.x; unit < 1536; unit += F.G) ssm_stage_c(F, unit);
    }
    SEAM(4);
    if (IN(5)) { PH_BEGIN();
        pg8::Gemm g{(const bf16*)(ws + WS_Z), (const bf16*)(ws + WS_WGLU), T, AW, AW, F.wave}; pg8::StaticOrder S; S.init(T, AW, F.G, (int)blockIdx.x);
        pg8::EpiGlu E{(const bf16*)(ws + WS_Z), XB, ARGP(23), psssm};
        pg8::gemm_phase<pg8::EpiGlu, pg8::StaticOrder, true, true>(F.lds, g, S, E);
    }
    SEAM(5);
    if (IN(6)) { PH_BEGIN();
        for (int m = blockIdx.x * 512 + F.tid; m < T; m += F.G * 512) {
            float sa = 0.f, ss = 0.f;
#pragma unroll
            for (int j = 0; j < 4; ++j) { const f32x4 v = ((const f32x4*)(psatt + (size_t)m * 16))[j]; sa += (v[0] + v[1]) + (v[2] + v[3]); }
#pragma unroll
            for (int j = 0; j < 8; ++j) { const f32x4 v = ((const f32x4*)(psssm + (size_t)m * 32))[j]; ss += (v[0] + v[1]) + (v[2] + v[3]); }
            const float ra = 1.0f / sqrtf(sa * (1.0f / AW) + RMS_EPS), rs = 1.0f / sqrtf(ss * (1.0f / AW) + RMS_EPS);
            ratio[m] = ra / rs; rsssm[m] = rs; }
    }
    SEAM(6);
    if (IN(7)) { PH_BEGIN();
        pg8::Gemm g{XB, (const bf16*)(ws + WS_WOUT), T, D, D, F.wave}; pg8::StaticOrder S; S.init(T, D, F.G, (int)blockIdx.x);
        pg8::EpiOut E{F.out, ratio, rsssm, psmix};
        pg8::gemm_phase<pg8::EpiOut, pg8::StaticOrder, true, true>(F.lds, g, S, E);
    }
    SEAM(7);
    if (IN(8)) { PH_BEGIN();
        { const float* xp = ARGP(0); const float* xs = ARGP(1); const float* gpm = ARGP(27);
        for (int m = F.gw; m < T; m += F.NGW)
            row_pass(F, xrow(xp, xs, m), F.out + (size_t)m * D, psmix + (size_t)m * 64, gpm, F.out + (size_t)m * D, XB + (size_t)m * D, rstd1 + m); }
        constexpr int I_UP = (D / 64) * (DFF / 32), I_DN = (DFF / 64) * (D / 32), I_GT = (D / 64) * (D / 32), I_PL = (PLE / 64) * (D / 32);
        const float* w_up = ARGP(29); const float* g_mlp = ARGP(28); const float* w_dn = ARGP(30); const float* w_gt = ARGP(33); const float* g_pl = ARGP(32); const float* w_pl = ARGP(34);
        for (int it = F.gw; it < I_UP + I_DN + I_GT + I_PL; it += F.NGW) {
            int r = it;
            if (r < I_UP) { transpose_item(w_up, D, DFF, (bf16*)(ws + WS_WUP), g_mlp, 0, 1.f, scr, r, F.lane); continue; } r -= I_UP;
            if (r < I_DN) { transpose_item(w_dn, DFF, D, (bf16*)(ws + WS_WDOWN), nullptr, 0, 1.f, scr, r, F.lane); continue; } r -= I_DN;
            if (r < I_GT) { transpose_item(w_gt, D, D, (bf16*)(ws + WS_WGATE), g_pl, 0, 1.f, scr, r, F.lane); continue; } r -= I_GT;
            transpose_item(w_pl, PLE, D, (bf16*)(ws + WS_WPLE), nullptr, 0, 1.f, scr, r, F.lane);
        }
    }
    SEAM(8);
    for (int ch = 0; ch < NCHUNK; ++ch) {
        const int row_off = ch * MCHUNK;
        if (IN(9 + 3 * ch)) { PH_BEGIN();
            pg8::Gemm g{XB + (size_t)row_off * D, (const bf16*)(ws + WS_WUP), MCHUNK, DFF, D, F.wave}; pg8::StaticOrder S; S.init(MCHUNK, DFF, F.G, (int)blockIdx.x);
            pg8::EpiUp E{(bf16*)(ws + WS_HBUF), rstd1, row_off};
            pg8::gemm_phase<pg8::EpiUp, pg8::StaticOrder, true, true>(F.lds, g, S, E);
        }
        SEAM(9 + 3 * ch);
        if (IN(10 + 3 * ch)) { PH_BEGIN();
            pg8::Gemm g{(const bf16*)(ws + WS_HBUF), (const bf16*)(ws + WS_WDOWN), MCHUNK, D, DFF, F.wave}; pg8::StaticOrder S; S.init(MCHUNK, D, F.G, (int)blockIdx.x);
            pg8::EpiDown E{(float*)(ws + WS_MCH), psm, row_off};
            pg8::gemm_phase<pg8::EpiDown, pg8::StaticOrder, true, true>(F.lds, g, S, E);
        }
        SEAM(10 + 3 * ch);
        if (IN(11 + 3 * ch)) { PH_BEGIN();
            const float* gpl = ARGP(31);
            for (int ml = F.gw; ml < MCHUNK; ml += F.NGW) { const int m = row_off + ml;
                row_pass(F, F.out + (size_t)m * D, (const float*)(ws + WS_MCH) + (size_t)ml * D, psm + (size_t)m * 64, gpl, F.out + (size_t)m * D, XB + (size_t)m * D, rstd2 + m); }
        }
        SEAM(11 + 3 * ch);
    }
    if (IN(18)) { PH_BEGIN();
        pg8::Gemm g{(const bf16*)(ws + WS_PEB), (const bf16*)(ws + WS_WPLE), T, D, PLE, F.wave}; pg8::StaticOrder S; S.init(T, D, F.G, (int)blockIdx.x);
        pg8::EpiPle E{(bf16*)(ws + WS_PP)};
        pg8::gemm_phase<pg8::EpiPle, pg8::StaticOrder, true, true>(F.lds, g, S, E);
    }
    SEAM(18);
    if (IN(19)) { PH_BEGIN();
        pg8::Gemm g{XB, (const bf16*)(ws + WS_WGATE), T, D, D, F.wave}; pg8::StaticOrder S; S.init(T, D, F.G, (int)blockIdx.x);
        pg8::EpiGate E{F.out, (const bf16*)(ws + WS_PP), rstd2};
        pg8::gemm_phase<pg8::EpiGate, pg8::StaticOrder, true, true>(F.lds, g, S, E);
    }
#undef IN
#undef SEAM
}

constexpr int N_PHASES = 20;
#ifndef MK_PER_PHASE
#define MK_PER_PHASE 0
#endif
extern "C" void kernel_launch(void* const* d_in, const int* in_sizes, int n_in, void* d_out, int out_size, void* d_ws, size_t ws_size, hipStream_t stream) {
    static int grid = 0;
    if (grid == 0) {
        if (n_in != 35 || out_size != T * D || ws_size < WS_END) { fprintf(stderr, "kernel_launch: unexpected problem (n_in %d, out %d, ws %zu)\n", n_in, out_size, ws_size); grid = -1; return; }
        int dev = 0, cus = 0;
        if (hipGetDevice(&dev) != hipSuccess || hipDeviceGetAttribute(&cus, hipDeviceAttributeMultiprocessorCount, dev) != hipSuccess) { grid = -1; return; }
        if (hipFuncSetAttribute((const void*)fwd_kernel, hipFuncAttributeMaxDynamicSharedMemorySize, LDS_BYTES) != hipSuccess) { fprintf(stderr, "kernel_launch: hipFuncSetAttribute failed\n"); grid = -1; return; }
        int per_cu = 0;
        if (hipOccupancyMaxActiveBlocksPerMultiprocessor(&per_cu, (const void*)fwd_kernel, NWAVES * 64, LDS_BYTES) != hipSuccess || per_cu < 1) fprintf(stderr, "kernel_launch: occupancy query reports %d\n", per_cu);
        (void)hipGetLastError();
        grid = cus;
    }
    if (grid < 0) return;
    (void)hipMemsetAsync((char*)d_ws + WS_CTL, 0, CTL_ZERO_BYTES, stream);
    Args a{};
    for (int i = 0; i < 35; ++i) a.in[i] = (const float*)d_in[i];
    a.out = (float*)d_out; a.ws = (unsigned char*)d_ws;
#if MK_PER_PHASE
    for (int p = 0; p < N_PHASES; ++p) { a.ph_lo = p; a.ph_hi = p + 1; hipLaunchKernelGGL(fwd_kernel, dim3(grid), dim3(NWAVES * 64), LDS_BYTES, stream, a); }
#else
    a.ph_lo = 0; a.ph_hi = N_PHASES;
    hipLaunchKernelGGL(fwd_kernel, dim3(grid), dim3(NWAVES * 64), LDS_BYTES, stream, a);
#endif
}
```

```cpp
#include <hip/hip_runtime.h>
#include <cstdio>
#include <cstdint>

#define GAS __attribute__((address_space(1)))
#define LAS __attribute__((address_space(3)))
typedef unsigned short bf16;
typedef short bf16x8 __attribute__((ext_vector_type(8)));
typedef float f32x4 __attribute__((ext_vector_type(4)));
typedef float f32x2 __attribute__((ext_vector_type(2)));
typedef unsigned u32x4 __attribute__((ext_vector_type(4)));
typedef unsigned u32x2 __attribute__((ext_vector_type(2)));

constexpr int T = 24576, TPR = 8192, D = 4096, AW = 2048, NH = 16, HD = 128, NG = 128, SP = 64, DFF = 16384, PLE = 256, NIN = 8192;
constexpr float RMS_EPS = 1e-6f;
constexpr float LOG2E = 1.4426950408889634f;
constexpr float QSCALE = 0.08838834764831845f * 1.4426950408889634f;

constexpr size_t MiB = 1u << 20;
constexpr size_t WS_CTL = 0, CTL_ZERO_BYTES = 1 * MiB;
constexpr size_t WS_RSTD0 = 1 * MiB, WS_RSTD1 = WS_RSTD0 + 128 * 1024, WS_RSTD2 = WS_RSTD1 + 128 * 1024, WS_RATIO = WS_RSTD2 + 128 * 1024, WS_RSSSM = WS_RATIO + 128 * 1024;
constexpr size_t WS_PSATT = 2 * MiB, WS_PSSSM = 4 * MiB, WS_PSMIX = 8 * MiB, WS_PSM = 14 * MiB;
constexpr size_t WS_PEB = 24 * MiB;
constexpr size_t WS_KTAB = 36 * MiB, WS_MC = 40 * MiB, WS_MB = 72 * MiB;
constexpr size_t WS_WIN = 104 * MiB, WS_WGLU = 168 * MiB, WS_WOUT = 176 * MiB;
constexpr size_t WS_XB = 208 * MiB;
constexpr size_t WS_Q = 400 * MiB, WS_K = 496 * MiB, WS_V = 592 * MiB, WS_UG = 688 * MiB, WS_Z = 784 * MiB, WS_S = 880 * MiB, WS_HB = 976 * MiB;
constexpr size_t WS_WUP = 400 * MiB, WS_WDOWN = 528 * MiB, WS_WGATE = 656 * MiB, WS_WPLE = 688 * MiB;
constexpr size_t WS_HBUF = 692 * MiB;
constexpr size_t WS_MCH = 36 * MiB;
constexpr size_t WS_PP = 692 * MiB;
constexpr size_t WS_END = 1216 * MiB;
constexpr int MCHUNK = 8192, NCHUNK = T / MCHUNK;

constexpr int CW_BAR = 4096;

constexpr int RING_BYTES = 131072;
constexpr int MISC_OFF = RING_BYTES + 320;
constexpr int LDS_BYTES = 147456;
constexpr int NWAVES = 8;

__device__ __forceinline__ unsigned cvt_pk_bf16(float lo, float hi) { unsigned r; asm volatile("v_cvt_pk_bf16_f32 %0, %1, %2" : "=v"(r) : "v"(lo), "v"(hi)); return r; }
__device__ __forceinline__ float bf_lo(unsigned v) { return __builtin_bit_cast(float, v << 16); }
__device__ __forceinline__ float bf_hi(unsigned v) { return __builtin_bit_cast(float, v & 0xffff0000u); }
__device__ __forceinline__ float wave_sum(float v) {
#pragma unroll
    for (int o = 1; o < 64; o <<= 1) v += __shfl_xor(v, o);
    return v;
}
__device__ __forceinline__ float wave_max(float v) {
#pragma unroll
    for (int o = 1; o < 64; o <<= 1) v = fmaxf(v, __shfl_xor(v, o));
    return v;
}
__device__ __forceinline__ int lane_id() { return (int)__builtin_amdgcn_mbcnt_hi(~0u, __builtin_amdgcn_mbcnt_lo(~0u, 0u)); }
__device__ __forceinline__ int lane_op() { int l = lane_id(); asm volatile("" : "+v"(l)); return l; }
__device__ __forceinline__ float sigmoidf_(float x) { return 1.0f / (1.0f + __expf(-x)); }
__device__ __forceinline__ float gelu_tanh(float x) { const float a = 1.5957691216057308f * (x + 0.044715f * x * x * x); return x / (1.0f + __expf(-a)); }

namespace pg8 {
#define PG8_LAS __attribute__((address_space(3)))
typedef unsigned short bf16_t;
constexpr int BM = 256, BK = 64, HALF = 128, HTB = HALF * BK * 2, STAGE_BYTES = 8 * HTB, NXCD = 8, WGM = 8;
__host__ __device__ __forceinline__ int lds_byte(int r, int c) { const int st = (r >> 4) * 2 + (c >> 5), rr = r & 15, cc = c & 31, ob = rr * 64 + cc * 2; return st * 1024 + (ob ^ (((ob >> 9) & 1) << 5)); }
__host__ __device__ __forceinline__ void stage_rc(int b, int& R, int& C) { const int st = b / 1024, sb = b % 1024, swz = sb ^ (((sb >> 9) & 1) << 5); R = (st >> 1) * 16 + swz / 64; C = (st & 1) * 32 + (swz % 64) / 2; }
__host__ __device__ __forceinline__ int perm32(int rho) { const int n = rho >> 4, i = rho & 15; return 8 * (i >> 2) + 4 * n + (i & 3); }
struct Unit { int pm, pn; };
struct Gemm { const bf16_t* A; const bf16_t* Bt; int M, N, K, wave; };
struct StaticOrder {
    int nM, nN, nwg, G, c;
    __host__ __device__ void init(int M, int N, int G_, int c_) { nM = M / BM; nN = N / BM; nwg = nM * nN; G = G_; c = c_; }
    __host__ __device__ bool next(int i, Unit& u) const {
        const long L = (long)i * G + c; if (L >= nwg) return false;
        int wgid = (int)L; { const int q = nwg / NXCD, r = nwg % NXCD, xcd = wgid % NXCD, off = wgid / NXCD; wgid = (xcd < r ? xcd * (q + 1) : r * (q + 1) + (xcd - r) * q) + off; }
        const int nig = WGM * nN, gid = wgid / nig, fm = gid * WGM, gsz = (nM - fm) < WGM ? (nM - fm) : WGM;
        u.pm = fm + ((wgid % nig) % gsz); u.pn = (wgid % nig) / gsz; return true;
    }
    __device__ __forceinline__ void a_ready(const Unit&) const {}
    __device__ __forceinline__ void done(const Unit&) const {}
};

template <class Epi, class Sched, bool ALIGN_EPI = false, bool SP2 = false>
__device__ __forceinline__ void gemm_phase(PG8_LAS unsigned char* lds, const Gemm g, const Sched& S, const Epi& E) {
    const int lane = lane_op(), wid = g.wave, tid = wid * 64 + lane, wr = wid >> 2, wc = wid & 3, fr = lane & 15, fq = lane >> 4;
    const int K = g.K, nt = K / BK;
    unsigned voffA[2], voffB[2];
#pragma unroll
    for (int i = 0; i < 2; ++i) { int R, C; stage_rc(tid * 16 + i * 8192, R, C); const int Rb = Epi::PERM ? ((R & ~31) + perm32(R & 31)) : R;
        voffA[i] = (unsigned)(R * K + C) * 2u; voffB[i] = (unsigned)(Rb * K + C) * 2u; }
    const size_t kstep = (size_t)(BK * 2);
    const size_t hstep = (size_t)HALF * K * 2;
    const size_t tstep = 2 * hstep;
    const unsigned ldsw = (unsigned)wid * 1024u;
    const int aoff = lds_byte(wr * 64 + fr, fq * 8), boff = lds_byte(wc * 32 + fr, fq * 8);
#define PG8_SA(b, h) (((b) * 2 + (h)) * HTB)
#define PG8_SB(b, h) ((4 + (b) * 2 + (h)) * HTB)
#define PG8_STAGE(bufoff, gbase, voff) do { _Pragma("unroll") for (int _i = 0; _i < 2; ++_i) \
        __builtin_amdgcn_global_load_lds((const unsigned*)((const char*)(gbase) + (voff)[_i]), (PG8_LAS unsigned*)(lds + (bufoff) + ldsw + _i * 8192), 16, 0, 0); } while (0)
#define PG8_LDA(dst, b, h) do { _Pragma("unroll") for (int m = 0; m < 4; ++m) _Pragma("unroll") for (int k = 0; k < 2; ++k) dst[m][k] = *(const PG8_LAS bf16x8*)(lds + PG8_SA(b, h) + aoff + m * 2048 + k * 1024); } while (0)
#define PG8_LDB(dst, b, h) do { _Pragma("unroll") for (int n = 0; n < 2; ++n) _Pragma("unroll") for (int k = 0; k < 2; ++k) dst[n][k] = *(const PG8_LAS bf16x8*)(lds + PG8_SB(b, h) + boff + n * 2048 + k * 1024); } while (0)
#define PG8_MMA(ai, bj, At, Bt) do { __builtin_amdgcn_s_setprio(1); _Pragma("unroll") for (int m = 0; m < 4; ++m) _Pragma("unroll") for (int n = 0; n < 2; ++n) _Pragma("unroll") for (int k = 0; k < 2; ++k) \
        acc[ai][bj][m][n] = __builtin_amdgcn_mfma_f32_16x16x32_bf16(Bt[n][k], At[m][k], acc[ai][bj][m][n], 0, 0, 0); __builtin_amdgcn_s_setprio(0); } while (0)
#define PG8_WAIT_V(n) asm volatile("s_waitcnt vmcnt(" #n ")" ::: "memory")
#define PG8_WAIT_L(n) asm volatile("s_waitcnt lgkmcnt(" #n ")" ::: "memory")
#define PG8_BAR __builtin_amdgcn_s_barrier()
#define PG8_SCHED __builtin_amdgcn_sched_barrier(0)
    Unit cur, nxt; int ui = 0;
    if (!S.next(0, cur)) return;
    f32x4 acc[2][2][4][2];
#pragma unroll
    for (int a = 0; a < 2; ++a)
#pragma unroll
        for (int b = 0; b < 2; ++b)
#pragma unroll
            for (int m = 0; m < 4; ++m)
#pragma unroll
                for (int n = 0; n < 2; ++n) acc[a][b][m][n] = (f32x4){0.f, 0.f, 0.f, 0.f};
    bf16x8 At[4][2], B0[2][2], B1[2][2];
    const char* cA = (const char*)g.A + (size_t)cur.pm * tstep; const char* cB = (const char*)g.Bt + (size_t)cur.pn * tstep;
    S.a_ready(cur);
    if constexpr (SP2) {
        PG8_STAGE(PG8_SB(0, 0), cB, voffB); PG8_STAGE(PG8_SB(0, 1), cB + hstep, voffB); PG8_STAGE(PG8_SA(0, 0), cA, voffA); PG8_STAGE(PG8_SA(0, 1), cA + hstep, voffA);
        if (wr == 1) PG8_BAR;
        PG8_WAIT_V(2); PG8_BAR;
        PG8_STAGE(PG8_SB(1, 0), cB + kstep, voffB); PG8_STAGE(PG8_SA(1, 0), cA + kstep, voffA); PG8_STAGE(PG8_SB(1, 1), cB + hstep + kstep, voffB);
        PG8_WAIT_V(6); PG8_BAR;
    } else {
        PG8_STAGE(PG8_SB(0, 0), cB, voffB); PG8_STAGE(PG8_SA(0, 0), cA, voffA); PG8_STAGE(PG8_SB(0, 1), cB + hstep, voffB); PG8_STAGE(PG8_SA(0, 1), cA + hstep, voffA);
        if (wr == 1) PG8_BAR;
        PG8_WAIT_V(4); PG8_BAR;
        PG8_STAGE(PG8_SB(1, 0), cB + kstep, voffB); PG8_STAGE(PG8_SA(1, 0), cA + kstep, voffA); PG8_STAGE(PG8_SB(1, 1), cB + hstep + kstep, voffB);
        PG8_WAIT_V(6); PG8_BAR;
    }
    for (;;) {
        const bool has_next = S.next(ui + 1, nxt);
        const char* nA = has_next ? (const char*)g.A + (size_t)nxt.pm * tstep : cA; const char* nB = has_next ? (const char*)g.Bt + (size_t)nxt.pn * tstep : cB;
#pragma nounroll
        for (int t = 0; t < nt; t += 2) {
            const bool last = (t == nt - 2);
            const char* a1 = cA + (size_t)(t + 1) * kstep;
            const char* a2 = last ? nA : cA + (size_t)(t + 2) * kstep; const char* b2 = last ? nB : cB + (size_t)(t + 2) * kstep;
            const char* a3 = a2 + kstep; const char* b3 = b2 + kstep;
            if (last && has_next) S.a_ready(nxt);
            if constexpr (Epi::MIDK) { if (t == (nt >> 1)) E.midk(acc, cur, wr, wc, fr, fq); }
            if constexpr (SP2) {
            PG8_LDB(B0, 0, 0); PG8_LDB(B1, 0, 1); PG8_SCHED; PG8_LDA(At, 0, 0); PG8_STAGE(PG8_SA(1, 1), a1 + hstep, voffA);
            PG8_WAIT_V(8); PG8_WAIT_L(0); PG8_BAR; PG8_MMA(0, 0, At, B0); PG8_MMA(0, 1, At, B1); PG8_BAR; PG8_SCHED;
            PG8_LDA(At, 0, 1); PG8_STAGE(PG8_SB(0, 0), b2, voffB); PG8_STAGE(PG8_SB(0, 1), b2 + hstep, voffB); PG8_STAGE(PG8_SA(0, 0), a2, voffA);
            PG8_WAIT_V(8); PG8_WAIT_L(0); PG8_BAR; PG8_MMA(1, 0, At, B0); PG8_MMA(1, 1, At, B1); PG8_BAR; PG8_SCHED;
            PG8_LDB(B0, 1, 0); PG8_LDB(B1, 1, 1); PG8_SCHED; PG8_LDA(At, 1, 0); PG8_STAGE(PG8_SA(0, 1), a2 + hstep, voffA);
            PG8_WAIT_V(8); PG8_WAIT_L(0); PG8_BAR; PG8_MMA(0, 0, At, B0); PG8_MMA(0, 1, At, B1); PG8_BAR; PG8_SCHED;
            PG8_LDA(At, 1, 1); PG8_STAGE(PG8_SB(1, 0), b3, voffB); PG8_STAGE(PG8_SB(1, 1), b3 + hstep, voffB); PG8_STAGE(PG8_SA(1, 0), a3, voffA);
            PG8_WAIT_V(8); PG8_WAIT_L(0); PG8_BAR; PG8_MMA(1, 0, At, B0); PG8_MMA(1, 1, At, B1); PG8_BAR; PG8_SCHED;
            } else {
            PG8_LDB(B0, 0, 0); PG8_SCHED; PG8_LDA(At, 0, 0); PG8_STAGE(PG8_SA(1, 1), a1 + hstep, voffA);
            PG8_WAIT_L(8); PG8_BAR; PG8_WAIT_L(0); PG8_MMA(0, 0, At, B0); PG8_BAR; PG8_SCHED;
            PG8_LDB(B1, 0, 1); PG8_STAGE(PG8_SB(0, 0), b2, voffB);
            PG8_BAR; PG8_WAIT_L(0); PG8_MMA(0, 1, At, B1); PG8_BAR;
            PG8_LDA(At, 0, 1); PG8_STAGE(PG8_SA(0, 0), a2, voffA);
            PG8_BAR; PG8_WAIT_L(0); PG8_MMA(1, 0, At, B0); PG8_BAR; PG8_SCHED;
            PG8_STAGE(PG8_SB(0, 1), b2 + hstep, voffB);
            PG8_WAIT_V(6); PG8_BAR; PG8_MMA(1, 1, At, B1); PG8_BAR;
            PG8_LDB(B0, 1, 0); PG8_SCHED; PG8_LDA(At, 1, 0); PG8_STAGE(PG8_SA(0, 1), a2 + hstep, voffA);
            PG8_WAIT_L(8); PG8_BAR; PG8_WAIT_L(0); PG8_MMA(0, 0, At, B0); PG8_BAR; PG8_SCHED;
            PG8_LDB(B1, 1, 1); PG8_STAGE(PG8_SB(1, 0), b3, voffB);
            PG8_BAR; PG8_WAIT_L(0); PG8_MMA(0, 1, At, B1); PG8_BAR;
            PG8_LDA(At, 1, 1); PG8_STAGE(PG8_SA(1, 0), a3, voffA);
            PG8_BAR; PG8_WAIT_L(0); PG8_MMA(1, 0, At, B0); PG8_BAR; PG8_SCHED;
            PG8_STAGE(PG8_SB(1, 1), b3 + hstep, voffB);
            PG8_WAIT_V(6); PG8_BAR; PG8_MMA(1, 1, At, B1); PG8_BAR;
            }
        }
        if constexpr (ALIGN_EPI) { if (wr == 0) PG8_BAR; }
        E(acc, cur, wr, wc, fr, fq); S.done(cur);
        if (!has_next) break;
#pragma unroll
        for (int a = 0; a < 2; ++a)
#pragma unroll
            for (int b = 0; b < 2; ++b)
#pragma unroll
                for (int m = 0; m < 4; ++m)
#pragma unroll
                    for (int n = 0; n < 2; ++n) acc[a][b][m][n] = (f32x4){0.f, 0.f, 0.f, 0.f};
        cur = nxt; cA = nA; cB = nB; ++ui;
        if constexpr (ALIGN_EPI) { if (wr == 1) PG8_BAR; }
    }
    PG8_WAIT_V(0);
    if constexpr (!ALIGN_EPI) { if (wr == 0) PG8_BAR; }
    PG8_BAR;
#undef PG8_SA
#undef PG8_SB
#undef PG8_STAGE
#undef PG8_LDA
#undef PG8_LDB
#undef PG8_MMA
#undef PG8_WAIT_V
#undef PG8_WAIT_L
#undef PG8_BAR
#undef PG8_SCHED
}

typedef f32x4 Acc[2][2][4][2];

struct EpiProj {
    static constexpr bool PERM = true, MIDK = false;
    bf16_t *Q, *Ug; const float* rstd;
    __device__ __forceinline__ void operator()(const Acc& acc, const Unit& u, int wr, int wc, int fr, int fq) const {
        const int row0 = u.pm * BM + wr * 64 + fr; const int t = u.pn >> 3;
        const int colt = (u.pn & 7) * BM + wc * 32 + 8 * fq;
        bf16_t* base = Q + (size_t)t * ((size_t)T * AW);
#pragma unroll
        for (int ai = 0; ai < 2; ++ai)
#pragma unroll
            for (int m = 0; m < 4; ++m) { const int row = row0 + ai * HALF + m * 16; const float rs = rstd[row];
#pragma unroll
                for (int bj = 0; bj < 2; ++bj) { const f32x4 v0 = acc[ai][bj][m][0] * rs, v1 = acc[ai][bj][m][1] * rs;
                    u32x4 w; w.x = cvt_pk_bf16(v0[0], v0[1]); w.y = cvt_pk_bf16(v0[2], v0[3]); w.z = cvt_pk_bf16(v1[0], v1[1]); w.w = cvt_pk_bf16(v1[2], v1[3]);
                    const int col = colt + bj * HALF;
                    if (t < 3) *(u32x4*)(base + (size_t)row * AW + col) = w;
                    else *(u32x4*)(Ug + ((size_t)(col >> 4) * T + row) * 16 + (col & 15)) = w; } }
    }
};
struct EpiGlu {
    static constexpr bool PERM = true, MIDK = false;
    const bf16_t* Z; bf16_t* cat; const float* bglu; float* ps;
    __device__ __forceinline__ void operator()(const Acc& acc, const Unit& u, int wr, int wc, int fr, int fq) const {
        const int row0 = u.pm * BM + wr * 64 + fr; const int col0 = u.pn * BM + wc * 32 + 8 * fq;
        f32x4 bv[2][2];
#pragma unroll
        for (int bj = 0; bj < 2; ++bj)
#pragma unroll
            for (int n = 0; n < 2; ++n) bv[bj][n] = *(const f32x4*)(bglu + col0 + bj * HALF + 4 * n);
#pragma unroll
        for (int ai = 0; ai < 2; ++ai)
#pragma unroll
            for (int m = 0; m < 4; ++m) { const int row = row0 + ai * HALF + m * 16; float ssq = 0.f;
#pragma unroll
                for (int bj = 0; bj < 2; ++bj) { const int col = col0 + bj * HALF;
                    const u32x4 zr = *(const u32x4*)(Z + (size_t)row * AW + col);
                    const f32x4 a0 = acc[ai][bj][m][0] + bv[bj][0], a1 = acc[ai][bj][m][1] + bv[bj][1];
                    f32x4 s0, s1;
                    s0[0] = bf_lo(zr.x) * sigmoidf_(a0[0]); s0[1] = bf_hi(zr.x) * sigmoidf_(a0[1]); s0[2] = bf_lo(zr.y) * sigmoidf_(a0[2]); s0[3] = bf_hi(zr.y) * sigmoidf_(a0[3]);
                    s1[0] = bf_lo(zr.z) * sigmoidf_(a1[0]); s1[1] = bf_hi(zr.z) * sigmoidf_(a1[1]); s1[2] = bf_lo(zr.w) * sigmoidf_(a1[2]); s1[3] = bf_hi(zr.w) * sigmoidf_(a1[3]);
                    ssq += (s0[0] * s0[0] + s0[1] * s0[1]) + (s0[2] * s0[2] + s0[3] * s0[3]) + (s1[0] * s1[0] + s1[1] * s1[1]) + (s1[2] * s1[2] + s1[3] * s1[3]);
                    u32x4 w; w.x = cvt_pk_bf16(s0[0], s0[1]); w.y = cvt_pk_bf16(s0[2], s0[3]); w.z = cvt_pk_bf16(s1[0], s1[1]); w.w = cvt_pk_bf16(s1[2], s1[3]);
                    *(u32x4*)(cat + (size_t)row * D + AW + col) = w; }
                ssq += __shfl_xor(ssq, 16); ssq += __shfl_xor(ssq, 32);
                if (fq == 0) ps[(size_t)row * 32 + u.pn * 4 + wc] = ssq;
                asm volatile("" ::: "memory"); }
    }
};
struct EpiOut {
    static constexpr bool PERM = false, MIDK = true;
    float* out; const float* ratio; const float* rsssm; float* ps;
    __device__ __forceinline__ void midk(Acc& acc, const Unit& u, int wr, int wc, int fr, int fq) const {
        const int row0 = u.pm * BM + wr * 64 + fr;
#pragma unroll
        for (int ai = 0; ai < 2; ++ai)
#pragma unroll
            for (int m = 0; m < 4; ++m) { const float r = ratio[row0 + ai * HALF + m * 16];
#pragma unroll
                for (int bj = 0; bj < 2; ++bj)
#pragma unroll
                    for (int n = 0; n < 2; ++n) acc[ai][bj][m][n] = acc[ai][bj][m][n] * r; }
    }
    __device__ __forceinline__ void operator()(const Acc& acc, const Unit& u, int wr, int wc, int fr, int fq) const {
        const int row0 = u.pm * BM + wr * 64 + fr; const int col0 = u.pn * BM + wc * 32 + 4 * fq;
#pragma unroll
        for (int ai = 0; ai < 2; ++ai)
#pragma unroll
            for (int m = 0; m < 4; ++m) { const int row = row0 + ai * HALF + m * 16; const float rs = rsssm[row]; float ssq = 0.f;
#pragma unroll
                for (int bj = 0; bj < 2; ++bj)
#pragma unroll
                    for (int n = 0; n < 2; ++n) { const f32x4 v = acc[ai][bj][m][n] * rs; ssq += (v[0] * v[0] + v[1] * v[1]) + (v[2] * v[2] + v[3] * v[3]);
                        *(f32x4*)(out + (size_t)row * D + col0 + bj * HALF + n * 16) = v; }
                ssq += __shfl_xor(ssq, 16); ssq += __shfl_xor(ssq, 32);
                if (fq == 0) ps[(size_t)row * 64 + u.pn * 4 + wc] = ssq; }
    }
};
struct EpiUp {
    static constexpr bool PERM = true, MIDK = false;
    bf16_t* H; const float* rstd; int row_off;
    __device__ __forceinline__ void operator()(const Acc& acc, const Unit& u, int wr, int wc, int fr, int fq) const {
        const int row0 = u.pm * BM + wr * 64 + fr; const int col0 = u.pn * BM + wc * 32 + 8 * fq;
#pragma unroll
        for (int ai = 0; ai < 2; ++ai)
#pragma unroll
            for (int m = 0; m < 4; ++m) { const int row = row0 + ai * HALF + m * 16; const float rs = rstd[row_off + row];
#pragma unroll
                for (int bj = 0; bj < 2; ++bj) { f32x4 v0 = acc[ai][bj][m][0] * rs, v1 = acc[ai][bj][m][1] * rs;
#pragma unroll
                    for (int j = 0; j < 4; ++j) { const float a = fmaxf(v0[j], 0.f), b = fmaxf(v1[j], 0.f); v0[j] = a * a; v1[j] = b * b; }
                    u32x4 w; w.x = cvt_pk_bf16(v0[0], v0[1]); w.y = cvt_pk_bf16(v0[2], v0[3]); w.z = cvt_pk_bf16(v1[0], v1[1]); w.w = cvt_pk_bf16(v1[2], v1[3]);
                    *(u32x4*)(H + (size_t)row * DFF + col0 + bj * HALF) = w; } }
    }
};
struct EpiDown {
    static constexpr bool PERM = false, MIDK = false;
    float* Mo; float* ps; int row_off;
    __device__ __forceinline__ void operator()(const Acc& acc, const Unit& u, int wr, int wc, int fr, int fq) const {
        const int row0 = u.pm * BM + wr * 64 + fr; const int col0 = u.pn * BM + wc * 32 + 4 * fq;
#pragma unroll
        for (int ai = 0; ai < 2; ++ai)
#pragma unroll
            for (int m = 0; m < 4; ++m) { const int row = row0 + ai * HALF + m * 16; float ssq = 0.f;
#pragma unroll
                for (int bj = 0; bj < 2; ++bj)
#pragma unroll
                    for (int n = 0; n < 2; ++n) { const f32x4 v = acc[ai][bj][m][n]; ssq += (v[0] * v[0] + v[1] * v[1]) + (v[2] * v[2] + v[3] * v[3]);
                        *(f32x4*)(Mo + (size_t)row * D + col0 + bj * HALF + n * 16) = v; }
                ssq += __shfl_xor(ssq, 16); ssq += __shfl_xor(ssq, 32);
                if (fq == 0) ps[(size_t)(row_off + row) * 64 + u.pn * 4 + wc] = ssq; }
    }
};
struct EpiPle {
    static constexpr bool PERM = true, MIDK = false;
    bf16_t* P;
    __device__ __forceinline__ void operator()(const Acc& acc, const Unit& u, int wr, int wc, int fr, int fq) const {
        const int row0 = u.pm * BM + wr * 64 + fr; const int col0 = u.pn * BM + wc * 32 + 8 * fq;
#pragma unroll
        for (int ai = 0; ai < 2; ++ai)
#pragma unroll
            for (int m = 0; m < 4; ++m) { const int row = row0 + ai * HALF + m * 16;
#pragma unroll
                for (int bj = 0; bj < 2; ++bj) { const f32x4 v0 = acc[ai][bj][m][0], v1 = acc[ai][bj][m][1];
                    u32x4 w; w.x = cvt_pk_bf16(v0[0], v0[1]); w.y = cvt_pk_bf16(v0[2], v0[3]); w.z = cvt_pk_bf16(v1[0], v1[1]); w.w = cvt_pk_bf16(v1[2], v1[3]);
                    *(u32x4*)(P + (size_t)row * D + col0 + bj * HALF) = w; } }
    }
};
struct EpiGate {
    static constexpr bool PERM = false, MIDK = false;
    float* out; const bf16_t* P; const float* rstd;
    __device__ __forceinline__ void operator()(const Acc& acc, const Unit& u, int wr, int wc, int fr, int fq) const {
        const int row0 = u.pm * BM + wr * 64 + fr; const int col0 = u.pn * BM + wc * 32 + 4 * fq;
#pragma unroll
        for (int ai = 0; ai < 2; ++ai)
#pragma unroll
            for (int m = 0; m < 4; ++m) { const int row = row0 + ai * HALF + m * 16; const float rs = rstd[row];
#pragma unroll
                for (int bj = 0; bj < 2; ++bj)
#pragma unroll
                    for (int n = 0; n < 2; ++n) { const size_t off = (size_t)row * D + col0 + bj * HALF + n * 16;
                        const f32x4 h2 = *(const f32x4*)(out + off); const u32x2 pr = *(const u32x2*)(P + off); const f32x4 a = acc[ai][bj][m][n] * rs;
                        f32x4 o; o[0] = h2[0] + bf_lo(pr.x) * sigmoidf_(a[0]); o[1] = h2[1] + bf_hi(pr.x) * sigmoidf_(a[1]); o[2] = h2[2] + bf_lo(pr.y) * sigmoidf_(a[2]); o[3] = h2[3] + bf_hi(pr.y) * sigmoidf_(a[3]);
                        *(f32x4*)(out + off) = o; }
                asm volatile("" ::: "memory"); }
    }
};
}

#define XB_TMO      128
#define XB_XCNT(j)  (256  + 64 * (j))
#define XB_XSUB(j)  (1280 + 64 * (j))
#define XB_XGEN(j)  (2304 + 64 * (j))
#define XB_TOP      3328
#define XB_TOPGEN   3392
#define XCD_BAR_WORDS 3456
#define XB_SPIN_CAP (1u << 18)
__device__ __forceinline__ unsigned xb_ld(unsigned* p)              { return __hip_atomic_load(p, __ATOMIC_RELAXED, __HIP_MEMORY_SCOPE_AGENT); }
__device__ __forceinline__ unsigned xb_add(unsigned* p, unsigned v) { return __hip_atomic_fetch_add(p, v, __ATOMIC_RELAXED, __HIP_MEMORY_SCOPE_AGENT); }
__device__ __forceinline__ unsigned xb_xcc_id() { return (unsigned)__builtin_amdgcn_s_getreg((3 << 11) | 20) & 0xFu; }
#define XB_SPIN(cond, bar) do { unsigned _sp = 0; while (cond) { __builtin_amdgcn_s_sleep(1); \
    if ((++_sp & 255u) == 0u) { if (xb_ld(&(bar)[XB_TMO])) break; if (_sp > XB_SPIN_CAP) { atomicAdd(&(bar)[XB_TMO], 1u); break; } } } } while (0)
struct XcdBarrier { unsigned* bar; unsigned x; volatile LAS unsigned* st; int wave; };
__device__ __forceinline__ XcdBarrier xcd_barrier_post(unsigned* bar, volatile LAS unsigned* st, int wave) {
    XcdBarrier b; b.bar = bar; b.x = xb_xcc_id(); b.st = st; b.wave = wave;
    if (wave == 0 && lane_id() == 0) (void)xb_add(&bar[XB_XCNT(b.x)], 1u);
    return b;
}
__device__ __forceinline__ void xcd_barrier_complete(unsigned* bar, unsigned x, unsigned& nloc, unsigned& nx) {
    const unsigned G = gridDim.x * gridDim.y * gridDim.z;
    unsigned sum, cnt, mine, sp = 0u;
    for (;;) {
        sum = 0u; cnt = 0u; mine = 0u;
#pragma unroll
        for (unsigned j = 0; j < 16; ++j) { const unsigned c = xb_ld(&bar[XB_XCNT(j)]); sum += c; cnt += (c > 0u) ? 1u : 0u; mine = (j == x) ? c : mine; }
        if (sum == G) break;
        __builtin_amdgcn_s_sleep(1);
        if ((++sp & 255u) == 0u) { if (xb_ld(&bar[XB_TMO])) break; if (sp > XB_SPIN_CAP) { atomicAdd(&bar[XB_TMO], 1u); break; } }
    }
    nloc = mine > 0u ? mine : 1u; nx = cnt > 0u ? cnt : 1u;
}
__device__ __forceinline__ void xcd_barrier(const XcdBarrier& b) {
    asm volatile("s_waitcnt vmcnt(0)" ::: "memory");
    __syncthreads();
    if (b.wave == 0 && lane_id() == 0) {
        unsigned* bar = b.bar;
        __builtin_amdgcn_s_waitcnt(0);
        unsigned nloc = b.st[0], nx = b.st[1];
        if (nloc == 0u) { xcd_barrier_complete(bar, b.x, nloc, nx); b.st[0] = nloc; b.st[1] = nx; }
        const unsigned old = xb_add(&bar[XB_XSUB(b.x)], 1u);
        const unsigned gen = old / nloc;
        if (old + 1u == (gen + 1u) * nloc) {
            __builtin_amdgcn_fence(__ATOMIC_RELEASE, "agent");
            asm volatile("s_waitcnt vmcnt(0)" ::: "memory");
            const unsigned og = xb_add(&bar[XB_TOP], 1u);
            const unsigned tg = og / nx;
            if (og + 1u == (tg + 1u) * nx) xb_add(&bar[XB_TOPGEN], 1u);
            else XB_SPIN(xb_ld(&bar[XB_TOPGEN]) == tg, bar);
            __builtin_amdgcn_fence(__ATOMIC_ACQUIRE, "agent");
            xb_add(&bar[XB_XGEN(b.x)], 1u);
            asm volatile("s_waitcnt vmcnt(0)" ::: "memory");
        } else {
            XB_SPIN(xb_ld(&bar[XB_XGEN(b.x)]) == gen, bar);
            __builtin_amdgcn_fence(__ATOMIC_ACQUIRE, "agent");
            asm volatile("s_waitcnt vmcnt(0)" ::: "memory");
        }
    }
    __syncthreads();
}

struct Args { const float* in[35]; float* out; unsigned char* ws; int ph_lo, ph_hi; };
template <int I> __device__ __forceinline__ const float* argp() {
    const unsigned long long kp = (unsigned long long)__builtin_amdgcn_kernarg_segment_ptr(); unsigned long long v;
    asm volatile("s_load_dwordx2 %0, %1, %2\n\ts_waitcnt lgkmcnt(0)" : "=s"(v) : "s"(kp), "n"(I * 8) : "memory");
    return (const float*)v;
}
#define ARGP(i) argp<(i)>()
struct Frame {
    LAS unsigned char* lds;
    int tid, lane, wave, G, gw, NGW;
    float* out; unsigned char* ws;
};
#define LDS_WAIT() asm volatile("s_waitcnt lgkmcnt(0)" ::: "memory")

__device__ __forceinline__ const float* xrow(const float* xp, const float* xs, int m) { return m < TPR ? xp + (size_t)m * D : xs + (size_t)(m - TPR) * D; }
__device__ __forceinline__ const float* perow(const float* pp_, const float* ps_, int m) { return m < TPR ? pp_ + (size_t)m * PLE : ps_ + (size_t)(m - TPR) * PLE; }

__device__ __forceinline__ void transpose_item(const float* W, int K, int N, bf16* WT, const float* gk, int ncs, float cscale, LAS float* scr, int item, int lane) {
    const int nblk = N / 64, kb = item / nblk, nb = item % nblk, k0 = 64 * kb, n0 = 64 * nb;
    const float cs = (n0 < ncs) ? cscale : 1.0f;
    const int kl = lane >> 4, n4 = 4 * (lane & 15);
    f32x4 v[16];
#pragma unroll
    for (int i = 0; i < 16; ++i) v[i] = *(const f32x4*)(W + (size_t)(k0 + 4 * i + kl) * N + n0 + n4);
    float gs[16];
#pragma unroll
    for (int i = 0; i < 16; ++i) gs[i] = gk ? gk[k0 + 4 * i + kl] * cs : cs;
    const int rn = lane >> 2, rc = lane & 3;
#pragma unroll
    for (int hh = 0; hh < 2; ++hh) {
#pragma unroll
        for (int i8 = 0; i8 < 8; ++i8) { const int i = hh * 8 + i8, kk = 4 * i8 + kl, c = kk >> 3; *(LAS f32x4*)(scr + kk * 68 + (n4 ^ (8 * c))) = v[i] * gs[i]; }
        LDS_WAIT(); asm volatile("" ::: "memory");
#pragma unroll
        for (int j = 0; j < 4; ++j) { const int n = rn + 16 * j; const LAS float* sp = scr + (8 * rc) * 68 + (n ^ (8 * rc));
            u32x4 o; o.x = cvt_pk_bf16(sp[0 * 68], sp[1 * 68]); o.y = cvt_pk_bf16(sp[2 * 68], sp[3 * 68]); o.z = cvt_pk_bf16(sp[4 * 68], sp[5 * 68]); o.w = cvt_pk_bf16(sp[6 * 68], sp[7 * 68]);
            *(u32x4*)(WT + (size_t)(n0 + n) * K + k0 + 32 * hh + 8 * rc) = o; }
        LDS_WAIT(); asm volatile("" ::: "memory");
    }
}

__device__ __forceinline__ void xb_row(const Frame& F, const float* xp, const float* xs, int m) {
    const f32x4* xr = (const f32x4*)xrow(xp, xs, m) + F.lane;
    bf16* orow = (bf16*)(F.ws + WS_XB) + (size_t)m * D;
    float ssq = 0.f;
#pragma unroll
    for (int j = 0; j < 16; ++j) { const f32x4 v = xr[64 * j]; ssq += (v[0] * v[0] + v[1] * v[1]) + (v[2] * v[2] + v[3] * v[3]);
        u32x2 w; w.x = cvt_pk_bf16(v[0], v[1]); w.y = cvt_pk_bf16(v[2], v[3]); *((u32x2*)orow + F.lane + 64 * j) = w; }
    ssq = wave_sum(ssq);
    if (F.lane == 0) ((float*)(F.ws + WS_RSTD0))[m] = 1.0f / sqrtf(ssq * (1.0f / D) + RMS_EPS);
}
__device__ __forceinline__ void row_pass(const Frame& F, const float* base, const float* add, const float* ps, const float* g, float* out, bf16* outb, float* rstd_out) {
    const float rsa = 1.0f / sqrtf(wave_sum(ps[F.lane]) * (1.0f / D) + RMS_EPS);
    float ssq = 0.f;
#pragma unroll
    for (int j = 0; j < 16; ++j) { const int c4 = F.lane + 64 * j;
        const f32x4 b = ((const f32x4*)base)[c4], a = ((const f32x4*)add)[c4], gg = ((const f32x4*)g)[c4];
        const f32x4 h = b + a * rsa * gg;
        ssq += (h[0] * h[0] + h[1] * h[1]) + (h[2] * h[2] + h[3] * h[3]);
        ((f32x4*)out)[c4] = h;
        u32x2 w; w.x = cvt_pk_bf16(h[0], h[1]); w.y = cvt_pk_bf16(h[2], h[3]); ((u32x2*)outb)[c4] = w;
        if ((j & 3) == 3) asm volatile("" ::: "memory"); }
    ssq = wave_sum(ssq);
    if (F.lane == 0) *rstd_out = 1.0f / sqrtf(ssq * (1.0f / D) + RMS_EPS);
}

__device__ __forceinline__ float dot8(const u32x4 a, const u32x4 b) {
    return (bf_lo(a.x) * bf_lo(b.x) + bf_hi(a.x) * bf_hi(b.x)) + (bf_lo(a.y) * bf_lo(b.y) + bf_hi(a.y) * bf_hi(b.y)) +
           (bf_lo(a.z) * bf_lo(b.z) + bf_hi(a.z) * bf_hi(b.z)) + (bf_lo(a.w) * bf_lo(b.w) + bf_hi(a.w) * bf_hi(b.w));
}
__device__ __forceinline__ void attn_slow_task(const Frame& F, const float* rpb, int tok, int h) {
    const int lane = F.lane;
    const bf16* Qb = (const bf16*)(F.ws + WS_Q); const bf16* Kb = (const bf16*)(F.ws + WS_K); const bf16* Vb = (const bf16*)(F.ws + WS_V);
    const int R = tok >> 6, c = tok & 63;
    int Rb, rows; if (R < 64) { Rb = 0; rows = 64; } else if (R < 128) { Rb = 64; rows = 64; } else { Rb = 128; rows = 256; }
    const int r = R - Rb;
    int rs = r - 4; rs = rs < 0 ? 0 : rs; rs = rs > rows - 8 ? rows - 8 : rs;
    int cs = c - 8; cs = cs < 0 ? 0 : cs; cs = cs > 48 ? 48 : cs;
    const u32x4* qp = (const u32x4*)(Qb + (size_t)tok * AW + h * HD);
    float sc[2];
#pragma unroll
    for (int j2 = 0; j2 < 2; ++j2) { const int kk = lane + 64 * j2, kr = kk >> 4, kc = cs + (kk & 15);
        const int ktok = (Rb + rs + kr) * 64 + kc;
        const u32x4* kp = (const u32x4*)(Kb + (size_t)ktok * AW + h * HD);
        float s = 0.f;
#pragma unroll
        for (int d8 = 0; d8 < 16; ++d8) s += dot8(qp[d8], kp[d8]);
        const int dr = (rs + kr) - r + 7; int dc = kc - c + 15; dc = dc < 0 ? 0 : dc; dc = dc > 30 ? 30 : dc;
        s += rpb[(h * 15 + dr) * 31 + dc] * LOG2E;
        sc[j2] = s; }
    const float mx = wave_max(fmaxf(sc[0], sc[1]));
    const float p0 = exp2f(sc[0] - mx), p1 = exp2f(sc[1] - mx);
    const float l = wave_sum(p0 + p1);
    float o0 = 0.f, o1 = 0.f;
    for (int kk = 0; kk < 128; ++kk) { const float pk = __shfl(kk < 64 ? p0 : p1, kk & 63);
        const int kr = kk >> 4, kc = cs + (kk & 15); const int ktok = (Rb + rs + kr) * 64 + kc;
        const unsigned vv = *(const unsigned*)(Vb + (size_t)ktok * AW + h * HD + 2 * lane);
        o0 += pk * bf_lo(vv); o1 += pk * bf_hi(vv); }
    const float inv = 1.0f / l; o0 *= inv; o1 *= inv;
    *(unsigned*)((bf16*)(F.ws + WS_XB) + (size_t)tok * D + h * HD + 2 * lane) = cvt_pk_bf16(o0, o1);
    const float ssq = wave_sum(o0 * o0 + o1 * o1);
    if (lane == 0) ((float*)(F.ws + WS_PSATT))[(size_t)tok * 16 + h] = ssq;
}

template <int dir> __device__ __forceinline__ void ssm_slow_task(const Frame& F, int task) {
    const int lane = F.lane, p = lane;
    const int g = (task >> 1) & 127, seq = task >> 8;
    const int t0 = seq == 0 ? 0 : (seq == 1 ? 4096 : 8192); const int L = seq == 2 ? 16384 : 4096;
    const float* lam_re = ARGP(dir ? 14 : 7); const float* lam_im = ARGP(dir ? 15 : 8); const float* log_dt = ARGP(dir ? 16 : 9);
    const float* b_re = ARGP(dir ? 17 : 10); const float* b_im = ARGP(dir ? 18 : 11); const float* c_re = ARGP(dir ? 19 : 12); const float* c_im = ARGP(dir ? 20 : 13);
    const float lr = fminf(lam_re[g * SP + p], -1e-4f), li = lam_im[g * SP + p], dt = expf(log_dt[g]);
    const float mag = expf(lr * dt); float sn, cs; sincosf(li * dt, &sn, &cs);
    const float lbr = mag * cs, lbi = mag * sn, den = lr * lr + li * li, nr = lbr - 1.0f;
    const float cr = (nr * lr + lbi * li) / den, ci = (lbi * lr - nr * li) / den;
    float bbr[16], bbi[16], ccr[16], cci[16];
#pragma unroll
    for (int h = 0; h < 16; ++h) { const float br = b_re[(size_t)(g * SP + p) * 16 + h], bi = b_im[(size_t)(g * SP + p) * 16 + h];
        bbr[h] = cr * br - ci * bi; bbi[h] = cr * bi + ci * br;
        ccr[h] = c_re[(size_t)(g * 16 + h) * SP + p]; cci[h] = c_im[(size_t)(g * 16 + h) * SP + p]; }
    const bf16* Ug = (const bf16*)(F.ws + WS_UG) + (size_t)g * T * 16;
    float* Y = F.out + (size_t)dir * T * AW;
    unsigned vz; asm volatile("v_mov_b32 %0, 0" : "=v"(vz));
    float sr = 0.f, si = 0.f;
    const int hsel = (lane >> 2) & 15; const bool b5 = lane & 32, b4 = lane & 16, b3 = lane & 8, b2 = lane & 4;
    for (int blk = 0; blk < L / 4; ++blk) {
        const int tb = dir ? (L - 4 - 4 * blk) : 4 * blk;
        const u32x4* up = (const u32x4*)(Ug + (size_t)(t0 + tb) * 16 + vz);
        u32x4 uu[8];
#pragma unroll
        for (int i = 0; i < 8; ++i) uu[i] = up[i];
#pragma unroll
        for (int s4 = 0; s4 < 4; ++s4) { const int ti = dir ? 3 - s4 : s4; const int tok = t0 + tb + ti;
            const u32x4 ua = dir ? uu[2 * (3 - s4)] : uu[2 * s4], ub = dir ? uu[2 * (3 - s4) + 1] : uu[2 * s4 + 1];
            float u[16];
            u[0] = bf_lo(ua.x); u[1] = bf_hi(ua.x); u[2] = bf_lo(ua.y); u[3] = bf_hi(ua.y); u[4] = bf_lo(ua.z); u[5] = bf_hi(ua.z); u[6] = bf_lo(ua.w); u[7] = bf_hi(ua.w);
            u[8] = bf_lo(ub.x); u[9] = bf_hi(ub.x); u[10] = bf_lo(ub.y); u[11] = bf_hi(ub.y); u[12] = bf_lo(ub.z); u[13] = bf_hi(ub.z); u[14] = bf_lo(ub.w); u[15] = bf_hi(ub.w);
            float bur = 0.f, bui = 0.f;
#pragma unroll
            for (int h = 0; h < 16; ++h) { bur += bbr[h] * u[h]; bui += bbi[h] * u[h]; }
            const float nsr = lbr * sr - lbi * si + bur, nsi = lbr * si + lbi * sr + bui; sr = nsr; si = nsi;
            float v[16];
#pragma unroll
            for (int h = 0; h < 16; ++h) v[h] = ccr[h] * sr - cci[h] * si;
            float w8[8], w4[4], w2[2];
#pragma unroll
            for (int i = 0; i < 8; ++i) { const float keep = b5 ? v[8 + i] : v[i], send = b5 ? v[i] : v[8 + i]; w8[i] = keep + __shfl_xor(send, 32); }
#pragma unroll
            for (int i = 0; i < 4; ++i) { const float keep = b4 ? w8[4 + i] : w8[i], send = b4 ? w8[i] : w8[4 + i]; w4[i] = keep + __shfl_xor(send, 16); }
#pragma unroll
            for (int i = 0; i < 2; ++i) { const float keep = b3 ? w4[2 + i] : w4[i], send = b3 ? w4[i] : w4[2 + i]; w2[i] = keep + __shfl_xor(send, 8); }
            float w1 = (b2 ? w2[1] : w2[0]) + __shfl_xor(b2 ? w2[0] : w2[1], 4);
            w1 += __shfl_xor(w1, 2); w1 += __shfl_xor(w1, 1);
            if ((lane & 3) == 0) Y[(size_t)tok * AW + g * 16 + hsel] = w1; }
    }
}


typedef float f32x16 __attribute__((ext_vector_type(16)));
typedef short s16x4 __attribute__((ext_vector_type(4)));
#define MFMA32(a, b, c) __builtin_amdgcn_mfma_f32_32x32x16_bf16((a), (b), (c), 0, 0, 0)
constexpr int NCH = T / 32;

__device__ __forceinline__ void ssm_tables(const Frame& F, int g) {
    LAS float* BBr = (LAS float*)F.lds; LAS float* BBi = BBr + 2048; LAS float* CCr = BBi + 2048; LAS float* CCi = CCr + 2048;
    LAS float* PWr = CCi + 2048; LAS float* PWi = PWr + 4224;
    const int tid = F.tid;
    const float* lamre[2] = {ARGP(7), ARGP(14)}; const float* lamim[2] = {ARGP(8), ARGP(15)}; const float* logdt[2] = {ARGP(9), ARGP(16)};
    {   const float* bre0 = ARGP(10); const float* bim0 = ARGP(11); const float* bre1 = ARGP(17); const float* bim1 = ARGP(18);
        const float* cre0 = ARGP(12); const float* cim0 = ARGP(13); const float* cre1 = ARGP(19); const float* cim1 = ARGP(20);
        for (int idx = tid; idx < 2048; idx += 512) {
            { const int dir = idx >> 10, p = (idx >> 4) & 63, h = idx & 15;
              const float lr = fminf((dir ? lamre[1] : lamre[0])[g * SP + p], -1e-4f), li = (dir ? lamim[1] : lamim[0])[g * SP + p], dt = expf((dir ? logdt[1] : logdt[0])[g]);
              const float mag = expf(lr * dt); float sn, cs; sincosf(li * dt, &sn, &cs);
              const float lbr = mag * cs, lbi = mag * sn, den = lr * lr + li * li, nr = lbr - 1.0f;
              const float cr = (nr * lr + lbi * li) / den, ci = (lbi * lr - nr * li) / den;
              const float br = (dir ? bre1 : bre0)[(size_t)(g * SP + p) * 16 + h], bi = (dir ? bim1 : bim0)[(size_t)(g * SP + p) * 16 + h];
              BBr[idx] = cr * br - ci * bi; BBi[idx] = cr * bi + ci * br; }
            { const int dir = idx >> 10, h = (idx >> 6) & 15, p = idx & 63;
              CCr[idx] = (dir ? cre1 : cre0)[(size_t)(g * 16 + h) * SP + p]; CCi[idx] = (dir ? cim1 : cim0)[(size_t)(g * 16 + h) * SP + p]; }
        }
        for (int idx = tid; idx < 4224; idx += 512) { const int dir = idx / 2112, n = (idx % 2112) >> 6, p = idx & 63;
            const float lr = fminf((dir ? lamre[1] : lamre[0])[g * SP + p], -1e-4f), li = (dir ? lamim[1] : lamim[0])[g * SP + p], dt = expf((dir ? logdt[1] : logdt[0])[g]);
            const float mag = expf(lr * dt * (float)n); float sn, cs; sincosf(li * dt * (float)n, &sn, &cs);
            PWr[idx] = mag * cs; PWi[idx] = mag * sn; }
    }
    __syncthreads();
    bf16* MBg = (bf16*)(F.ws + WS_MB) + (size_t)g * 256 * 512; bf16* MCg = (bf16*)(F.ws + WS_MC) + (size_t)g * 512 * 256; bf16* Kt = (bf16*)(F.ws + WS_KTAB) + (size_t)g * 16384;
    for (int task = tid; task < 8192; task += 512) { const int hb = task & 1, ip = (task >> 1) & 31, p = (task >> 6) & 63, dir = task >> 12;
        const int n = dir ? ip : 31 - ip; const float pr = PWr[dir * 2112 + n * 64 + p], pi = PWi[dir * 2112 + n * 64 + p];
        float vr[8], vi[8];
#pragma unroll
        for (int j = 0; j < 8; ++j) { const float br = BBr[(dir * 64 + p) * 16 + 8 * hb + j], bi = BBi[(dir * 64 + p) * 16 + 8 * hb + j]; vr[j] = pr * br - pi * bi; vi[j] = pr * bi + pi * br; }
        u32x4 wr_, wi_; wr_.x = cvt_pk_bf16(vr[0], vr[1]); wr_.y = cvt_pk_bf16(vr[2], vr[3]); wr_.z = cvt_pk_bf16(vr[4], vr[5]); wr_.w = cvt_pk_bf16(vr[6], vr[7]);
        wi_.x = cvt_pk_bf16(vi[0], vi[1]); wi_.y = cvt_pk_bf16(vi[2], vi[3]); wi_.z = cvt_pk_bf16(vi[4], vi[5]); wi_.w = cvt_pk_bf16(vi[6], vi[7]);
        *(u32x4*)(MBg + (size_t)(dir * 128 + 2 * p) * 512 + ip * 16 + 8 * hb) = wr_;
        *(u32x4*)(MBg + (size_t)(dir * 128 + 2 * p + 1) * 512 + ip * 16 + 8 * hb) = wi_; }
    for (int task = tid; task < 16384; task += 512) { const int pb = task & 15, dir = (task >> 4) & 1, h = (task >> 5) & 15, i = task >> 9;
        const int n = dir ? 32 - i : i + 1; float v[8];
#pragma unroll
        for (int j = 0; j < 4; ++j) { const int p = 4 * pb + j; const float cr = CCr[(dir * 16 + h) * 64 + p], ci = CCi[(dir * 16 + h) * 64 + p], pr = PWr[dir * 2112 + n * 64 + p], pi = PWi[dir * 2112 + n * 64 + p];
            v[2 * j] = cr * pr - ci * pi; v[2 * j + 1] = -(cr * pi + ci * pr); }
        u32x4 w; w.x = cvt_pk_bf16(v[0], v[1]); w.y = cvt_pk_bf16(v[2], v[3]); w.z = cvt_pk_bf16(v[4], v[5]); w.w = cvt_pk_bf16(v[6], v[7]);
        *(u32x4*)(MCg + (size_t)(i * 16 + h) * 256 + dir * 128 + 8 * pb) = w; }
    const float* dsk = ARGP(21);
    for (int task = tid; task < 2016; task += 512) { const int hb = task & 1, h = (task >> 1) & 15, di = task >> 5; const int d = di - 31;
        float acc[8];
#pragma unroll
        for (int j = 0; j < 8; ++j) acc[j] = 0.f;
        for (int dir = 0; dir < 2; ++dir) { if ((dir == 0 && d < 0) || (dir == 1 && d > 0)) continue; const int n = d < 0 ? -d : d;
            for (int p = 0; p < 64; ++p) { const float cr = CCr[(dir * 16 + h) * 64 + p], ci = CCi[(dir * 16 + h) * 64 + p], pr = PWr[dir * 2112 + n * 64 + p], pi = PWi[dir * 2112 + n * 64 + p];
                const float wr_ = cr * pr - ci * pi, wi_ = cr * pi + ci * pr;
#pragma unroll
                for (int j = 0; j < 8; ++j) acc[j] += wr_ * BBr[(dir * 64 + p) * 16 + 8 * hb + j] - wi_ * BBi[(dir * 64 + p) * 16 + 8 * hb + j]; } }
        if (d == 0) {
#pragma unroll
            for (int j = 0; j < 8; ++j) if (8 * hb + j == h) acc[j] += dsk[g * 16 + h]; }
        u32x4 w; w.x = cvt_pk_bf16(acc[0], acc[1]); w.y = cvt_pk_bf16(acc[2], acc[3]); w.z = cvt_pk_bf16(acc[4], acc[5]); w.w = cvt_pk_bf16(acc[6], acc[7]);
        *(u32x4*)(Kt + (size_t)(di * 16 + h) * 16 + 8 * hb) = w; }
    __syncthreads();
}

__device__ __forceinline__ void ssm_stage_a(const Frame& F, int unit) {
    const int mh = unit & 1, ct = (unit >> 1) % 24, G8 = unit / 48;
    const int g = G8 * 8 + F.wave, r = F.lane & 31, hf = F.lane >> 5;
    const bf16* Up = (const bf16*)(F.ws + WS_UG) + ((size_t)g * T + (size_t)(ct * 32 + r) * 32) * 16 + 8 * hf;
    const bf16* Ap = (const bf16*)(F.ws + WS_MB) + ((size_t)g * 256 + 128 * mh + r) * 512 + 8 * hf;
    f32x16 acc[4];
#pragma unroll
    for (int m = 0; m < 4; ++m)
#pragma unroll
        for (int i = 0; i < 16; ++i) acc[m][i] = 0.f;
#pragma unroll 4
    for (int ks = 0; ks < 32; ++ks) { const bf16x8 b = *(const bf16x8*)(Up + ks * 16);
#pragma unroll
        for (int m = 0; m < 4; ++m) { const bf16x8 a = *(const bf16x8*)(Ap + (size_t)m * 32 * 512 + ks * 16); acc[m] = MFMA32(a, b, acc[m]); } }
    float* Sp = (float*)(F.ws + WS_S) + ((size_t)g * NCH + ct * 32 + r) * 256 + 128 * mh + 4 * hf;
#pragma unroll
    for (int m = 0; m < 4; ++m)
#pragma unroll
        for (int q = 0; q < 4; ++q) *(f32x4*)(Sp + 32 * m + 8 * q) = (f32x4){acc[m][4 * q], acc[m][4 * q + 1], acc[m][4 * q + 2], acc[m][4 * q + 3]};
}

template <int dir> __device__ __forceinline__ void ssm_scan_task(const Frame& F, int task) {
    const int p = F.lane, g = (task >> 1) & 127, seq = task >> 8;
    const int c0 = seq == 0 ? 0 : (seq == 1 ? 128 : 256), nc = seq == 2 ? 512 : 128;
    const float lr = fminf(ARGP(dir ? 14 : 7)[g * SP + p], -1e-4f), li = ARGP(dir ? 15 : 8)[g * SP + p], dt = expf(ARGP(dir ? 16 : 9)[g]);
    const float mag = expf(lr * dt * 32.0f); float sn, cs; sincosf(li * dt * 32.0f, &sn, &cs);
    const float qr = mag * cs, qi = mag * sn;
    const float* Sg = (const float*)(F.ws + WS_S) + (size_t)g * NCH * 256 + dir * 128 + 2 * p;
    bf16* Hg = (bf16*)(F.ws + WS_HB) + (size_t)g * NCH * 256 + dir * 128 + 2 * p;
    float hr = 0.f, hi = 0.f;
    f32x2 cur[32];
#pragma unroll
    for (int j = 0; j < 32; ++j) { const int c = dir ? (c0 + nc - 1 - j) : (c0 + j); cur[j] = *(const f32x2*)(Sg + (size_t)c * 256); }
    for (int sb = 0; sb < nc / 32; ++sb) {
        f32x2 nxt[32];
        const int sbn = (sb + 1 < nc / 32) ? sb + 1 : sb;
#pragma unroll
        for (int j = 0; j < 32; ++j) { const int k = sbn * 32 + j; const int c = dir ? (c0 + nc - 1 - k) : (c0 + k); nxt[j] = *(const f32x2*)(Sg + (size_t)c * 256); }
#pragma unroll
        for (int j = 0; j < 32; ++j) { const int k = sb * 32 + j; const int c = dir ? (c0 + nc - 1 - k) : (c0 + k);
            *(unsigned*)(Hg + (size_t)c * 256) = cvt_pk_bf16(hr, hi);
            const float nr = qr * hr - qi * hi + cur[j].x, ni = qr * hi + qi * hr + cur[j].y; hr = nr; hi = ni; }
#pragma unroll
        for (int j = 0; j < 32; ++j) cur[j] = nxt[j];
    }
}

__device__ __forceinline__ void ssm_stage_c(const Frame& F, int unit) {
    const int mb = unit & 3, ct = (unit >> 2) % 24, G8 = unit / 96;
    const int g = G8 * 8 + F.wave, r = F.lane & 31, hf = F.lane >> 5;
    const bf16* Up = (const bf16*)(F.ws + WS_UG) + ((size_t)g * T + (size_t)(ct * 32 + r) * 32) * 16 + 8 * hf;
    const bf16* Kp = (const bf16*)(F.ws + WS_KTAB) + (size_t)g * 16384 + ((r >> 4) + 31 + 8 * mb) * 256 + (r & 15) * 16 + 8 * hf;
    const bf16* Hp = (const bf16*)(F.ws + WS_HB) + ((size_t)g * NCH + ct * 32 + r) * 256 + 8 * hf;
    const bf16* Cp = (const bf16*)(F.ws + WS_MC) + ((size_t)g * 512 + 128 * mb + r) * 256 + 8 * hf;
    f32x16 acc[4];
#pragma unroll
    for (int m = 0; m < 4; ++m)
#pragma unroll
        for (int i = 0; i < 16; ++i) acc[m][i] = 0.f;
#pragma unroll 4
    for (int ks = 0; ks < 32; ++ks) { const bf16x8 b = *(const bf16x8*)(Up + ks * 16);
#pragma unroll
        for (int m = 0; m < 4; ++m) { const bf16x8 a = *(const bf16x8*)(Kp + (2 * m - ks) * 256); acc[m] = MFMA32(a, b, acc[m]); } }
#pragma unroll 4
    for (int ks = 0; ks < 16; ++ks) { const bf16x8 b = *(const bf16x8*)(Hp + ks * 16);
#pragma unroll
        for (int m = 0; m < 4; ++m) { const bf16x8 a = *(const bf16x8*)(Cp + (size_t)m * 32 * 256 + ks * 16); acc[m] = MFMA32(a, b, acc[m]); } }
    bf16* Zp = (bf16*)(F.ws + WS_Z) + ((size_t)(ct * 32 + r) * 32 + 8 * mb) * AW + g * 16 + 4 * hf;
#pragma unroll
    for (int m = 0; m < 4; ++m)
#pragma unroll
        for (int q = 0; q < 4; ++q) { u32x2 w; w.x = cvt_pk_bf16(gelu_tanh(acc[m][4 * q]), gelu_tanh(acc[m][4 * q + 1])); w.y = cvt_pk_bf16(gelu_tanh(acc[m][4 * q + 2]), gelu_tanh(acc[m][4 * q + 3]));
            *(u32x2*)(Zp + (size_t)(2 * m + (q >> 1)) * AW + 8 * (q & 1)) = w; }
}

constexpr int BT_OFF = 132096;
__device__ __forceinline__ void attn_unit(const Frame& F, const float* rpb, int unit) {
    const int h = unit & 15, rg = unit >> 4;
    const int lane = F.lane, wave = F.wave, qrow = wave >> 1, qt = wave & 1;
    const int R = 4 * rg + qrow;
    int Rb, rows; if (R < 64) { Rb = 0; rows = 64; } else if (R < 128) { Rb = 64; rows = 64; } else { Rb = 128; rows = 256; }
    const int r = R - Rb; int rs = r - 4; rs = rs < 0 ? 0 : rs; rs = rs > rows - 8 ? rows - 8 : rs;
    const int j31 = lane & 31, hf = lane >> 5;
    const int c = 32 * qt + j31; int cs = c - 8; cs = cs < 0 ? 0 : cs; cs = cs > 48 ? 48 : cs;
    const int tokq = R * 64 + c;
    LAS float* bt = (LAS float*)(F.lds + BT_OFF);
    __syncthreads();
    for (int i = F.tid; i < 465; i += 512) bt[i] = rpb[h * 465 + i] * LOG2E;
    __syncthreads();
    const bf16* Qb = (const bf16*)(F.ws + WS_Q); const bf16* Kb = (const bf16*)(F.ws + WS_K); const bf16* Vb = (const bf16*)(F.ws + WS_V);
    bf16x8 qf[8];
    { const bf16* qp = Qb + (size_t)tokq * AW + h * HD + 8 * hf;
#pragma unroll
      for (int s_ = 0; s_ < 8; ++s_) qf[s_] = *(const bf16x8*)(qp + 16 * s_); }
    f32x16 O[4];
#pragma unroll
    for (int d = 0; d < 4; ++d)
#pragma unroll
        for (int i = 0; i < 16; ++i) O[d][i] = 0.f;
    float mrun = -1e30f, lrun = 0.f;
    LAS unsigned char* vl = F.lds + wave * 16384; const unsigned vbase = (unsigned)(uintptr_t)vl;
    const int i16 = lane & 15, q4 = i16 >> 2, pp = i16 & 3, g1 = (lane >> 4) & 1;
    unsigned tb[4][2];
#pragma unroll
    for (int d = 0; d < 4; ++d)
#pragma unroll
        for (int sec = 0; sec < 2; ++sec) { const int row_l = 4 * hf + 8 * sec + q4, swz = (q4 << 2) | ((hf + 2 * sec) & 3), ch = 4 * d + 2 * g1 + (pp >> 1);
            tb[d][sec] = vbase + 256 * row_l + 16 * (ch ^ swz) + 8 * (pp & 1); }
    const int vrow = lane >> 4, vch = lane & 15;
    for (int j = 0; j < 8; ++j) {
        const int Rk = Rb + rs + j;
        { const bf16* vp = Vb + (size_t)(Rk * 64 + vrow) * AW + h * HD + vch * 8;
#pragma unroll
          for (int hh = 0; hh < 2; ++hh) { u32x4 vv[8];
#pragma unroll
            for (int i8 = 0; i8 < 8; ++i8) vv[i8] = *(const u32x4*)(vp + (size_t)(4 * (hh * 8 + i8)) * AW);
#pragma unroll
            for (int i8 = 0; i8 < 8; ++i8) { const int i = hh * 8 + i8; *(LAS u32x4*)(vl + 256 * (vrow + 4 * i) + 16 * (vch ^ (((vrow & 3) << 2) | (i & 3)))) = vv[i8]; } } }
        f32x16 sacc[2];
        { const bf16* kp = Kb + (size_t)(Rk * 64 + j31) * AW + h * HD + 8 * hf;
#pragma unroll
          for (int kt = 0; kt < 2; ++kt) {
#pragma unroll
            for (int i = 0; i < 16; ++i) sacc[kt][i] = 0.f;
#pragma unroll
            for (int s_ = 0; s_ < 8; ++s_) { const bf16x8 a = *(const bf16x8*)(kp + (size_t)(32 * kt) * AW + 16 * s_); sacc[kt] = MFMA32(a, qf[s_], sacc[kt]); } } }
        const int dr = (rs + j) - r + 7;
        float mloc = -1e30f;
#pragma unroll
        for (int kt = 0; kt < 2; ++kt)
#pragma unroll
            for (int rg_ = 0; rg_ < 16; ++rg_) { const int kc = 32 * kt + (rg_ & 3) + 8 * (rg_ >> 2) + 4 * hf;
                int idx = kc - c + 15; idx = idx < 0 ? 0 : idx; idx = idx > 30 ? 30 : idx;
                const float sc = ((unsigned)(kc - cs) < 16u) ? sacc[kt][rg_] + bt[dr * 31 + idx] : -1e30f;
                sacc[kt][rg_] = sc; mloc = fmaxf(mloc, sc); }
        mloc = fmaxf(mloc, __shfl_xor(mloc, 32));
        const float mnew = fmaxf(mrun, mloc), alpha = __builtin_amdgcn_exp2f(mrun - mnew); mrun = mnew;
        float psum = 0.f;
#pragma unroll
        for (int kt = 0; kt < 2; ++kt)
#pragma unroll
            for (int rg_ = 0; rg_ < 16; ++rg_) { const float p = __builtin_amdgcn_exp2f(sacc[kt][rg_] - mnew); sacc[kt][rg_] = p; psum += p; }
        lrun = lrun * alpha + psum;
#pragma unroll
        for (int d = 0; d < 4; ++d)
#pragma unroll
            for (int i = 0; i < 16; ++i) O[d][i] *= alpha;
        bf16x8 pb[2][2];
#pragma unroll
        for (int kt = 0; kt < 2; ++kt)
#pragma unroll
            for (int s2 = 0; s2 < 2; ++s2) { u32x4 w; w.x = cvt_pk_bf16(sacc[kt][8 * s2], sacc[kt][8 * s2 + 1]); w.y = cvt_pk_bf16(sacc[kt][8 * s2 + 2], sacc[kt][8 * s2 + 3]);
                w.z = cvt_pk_bf16(sacc[kt][8 * s2 + 4], sacc[kt][8 * s2 + 5]); w.w = cvt_pk_bf16(sacc[kt][8 * s2 + 6], sacc[kt][8 * s2 + 7]); pb[kt][s2] = __builtin_bit_cast(bf16x8, w); }
#pragma unroll
        for (int d = 0; d < 4; ++d) { s16x4 f0, f1, f2, f3, f4, f5, f6, f7;
            asm volatile("ds_read_b64_tr_b16 %0, %8\n\tds_read_b64_tr_b16 %1, %9\n\tds_read_b64_tr_b16 %2, %8 offset:4096\n\tds_read_b64_tr_b16 %3, %9 offset:4096\n\t"
                         "ds_read_b64_tr_b16 %4, %8 offset:8192\n\tds_read_b64_tr_b16 %5, %9 offset:8192\n\tds_read_b64_tr_b16 %6, %8 offset:12288\n\tds_read_b64_tr_b16 %7, %9 offset:12288\n\ts_waitcnt lgkmcnt(0)"
                         : "=&v"(f0), "=&v"(f1), "=&v"(f2), "=&v"(f3), "=&v"(f4), "=&v"(f5), "=&v"(f6), "=&v"(f7) : "v"(tb[d][0]), "v"(tb[d][1]) : "memory");
            O[d] = MFMA32(__builtin_shufflevector(f0, f1, 0, 1, 2, 3, 4, 5, 6, 7), pb[0][0], O[d]);
            O[d] = MFMA32(__builtin_shufflevector(f2, f3, 0, 1, 2, 3, 4, 5, 6, 7), pb[0][1], O[d]);
            O[d] = MFMA32(__builtin_shufflevector(f4, f5, 0, 1, 2, 3, 4, 5, 6, 7), pb[1][0], O[d]);
            O[d] = MFMA32(__builtin_shufflevector(f6, f7, 0, 1, 2, 3, 4, 5, 6, 7), pb[1][1], O[d]); }
    }
    const float inv = 1.0f / (lrun + __shfl_xor(lrun, 32));
    bf16* op = (bf16*)(F.ws + WS_XB) + (size_t)tokq * D + h * HD + 4 * hf;
    float ssq = 0.f;
#pragma unroll
    for (int d = 0; d < 4; ++d)
#pragma unroll
        for (int q = 0; q < 4; ++q) { const float o0 = O[d][4 * q] * inv, o1 = O[d][4 * q + 1] * inv, o2 = O[d][4 * q + 2] * inv, o3 = O[d][4 * q + 3] * inv;
            ssq += (o0 * o0 + o1 * o1) + (o2 * o2 + o3 * o3);
            u32x2 w; w.x = cvt_pk_bf16(o0, o1); w.y = cvt_pk_bf16(o2, o3); *(u32x2*)(op + 32 * d + 8 * q) = w; }
    ssq += __shfl_xor(ssq, 32);
    if (hf == 0) ((float*)(F.ws + WS_PSATT))[(size_t)tokq * 16 + h] = ssq;
}

__global__ void __launch_bounds__(NWAVES * 64, 2) fwd_kernel(Args args) {
    extern __shared__ __attribute__((aligned(16))) unsigned char lds_raw[];
    Frame F;
    F.lds = (LAS unsigned char*)lds_raw;
    F.wave = __builtin_amdgcn_readfirstlane((int)threadIdx.x >> 6); F.lane = lane_op(); F.tid = F.wave * 64 + F.lane;
    F.G = gridDim.x; F.gw = blockIdx.x * NWAVES + F.wave; F.NGW = F.G * NWAVES;
    F.out = args.out; F.ws = args.ws;
    unsigned char* ws = args.ws;
    volatile LAS unsigned* MISC = (volatile LAS unsigned*)(F.lds + MISC_OFF);
    for (int u = F.tid; u < (LDS_BYTES - RING_BYTES) / 4; u += NWAVES * 64) ((LAS unsigned*)(F.lds + RING_BYTES))[u] = 0u;
    __syncthreads();
    XcdBarrier bar = xcd_barrier_post((unsigned*)(ws + WS_CTL) + CW_BAR, MISC + 8, F.wave);
    const int lo = args.ph_lo, hi = args.ph_hi;
#define IN(k) (lo <= (k) && (k) < hi)
#define PH_BEGIN() do { F.lane = lane_op(); F.tid = F.wave * 64 + F.lane; } while (0)
#define SEAM(k) do { if (IN(k) && IN((k) + 1)) xcd_barrier(bar); } while (0)

    bf16* XB = (bf16*)(ws + WS_XB);
    float* rstd0 = (float*)(ws + WS_RSTD0); float* rstd1 = (float*)(ws + WS_RSTD1); float* rstd2 = (float*)(ws + WS_RSTD2);
    float* ratio = (float*)(ws + WS_RATIO); float* rsssm = (float*)(ws + WS_RSSSM);
    float* psatt = (float*)(ws + WS_PSATT); float* psssm = (float*)(ws + WS_PSSSM); float* psmix = (float*)(ws + WS_PSMIX); float* psm = (float*)(ws + WS_PSM);
    LAS float* scr = (LAS float*)(F.lds + F.wave * 16384);

    if (IN(0)) { PH_BEGIN();
        for (int g = blockIdx.x; g < NG; g += F.G) ssm_tables(F, g);
        constexpr int I_IN = (D / 64) * (NIN / 64), I_GLU = (AW / 64) * (AW / 64), I_OUT = (D / 64) * (D / 64);
        { const float* w_in = ARGP(5); const float* g_pre = ARGP(4); const float* w_glu = ARGP(22); const float* w_out = ARGP(26); const float* g_att = ARGP(24); const float* g_ssm = ARGP(25);
        for (int it = F.gw; it < I_IN + I_GLU + I_OUT; it += F.NGW) {
            int r = it;
            if (r < I_IN) { transpose_item(w_in, D, NIN, (bf16*)(ws + WS_WIN), g_pre, AW, QSCALE, scr, r, F.lane); continue; } r -= I_IN;
            if (r < I_GLU) { transpose_item(w_glu, AW, AW, (bf16*)(ws + WS_WGLU), nullptr, 0, 1.f, scr, r, F.lane); continue; } r -= I_GLU;
            {
                const int nblk = D / 64, kb = r / nblk; const int k0 = 64 * kb;
                const float* gk = k0 < AW ? g_att : g_ssm - AW;
                transpose_item(w_out, D, D, (bf16*)(ws + WS_WOUT), gk, 0, 1.f, scr, r, F.lane); }
        } }
        { const float* xp = ARGP(0); const float* xs = ARGP(1);
        for (int m = F.gw; m < T; m += F.NGW) xb_row(F, xp, xs, m); }
        const float* pep = ARGP(2); const float* pes = ARGP(3);
        for (int i = F.gw * 64 + F.lane; i < T * PLE / 4; i += F.NGW * 64) { const int m = i / (PLE / 4), c4 = i % (PLE / 4);
            const f32x4 v = ((const f32x4*)perow(pep, pes, m))[c4]; u32x2 w; w.x = cvt_pk_bf16(v[0], v[1]); w.y = cvt_pk_bf16(v[2], v[3]);
            ((u32x2*)(ws + WS_PEB))[i] = w; }
    }
    SEAM(0);
    if (IN(1)) { PH_BEGIN();
        pg8::Gemm g{XB, (const bf16*)(ws + WS_WIN), T, NIN, D, F.wave}; pg8::StaticOrder S; S.init(T, NIN, F.G, (int)blockIdx.x);
        pg8::EpiProj E{(bf16*)(ws + WS_Q), (bf16*)(ws + WS_UG), rstd0};
        pg8::gemm_phase<pg8::EpiProj, pg8::StaticOrder, true, true>(F.lds, g, S, E);
    }
    SEAM(1);
    if (IN(2)) { PH_BEGIN();
        for (int unit = blockIdx.x; unit < 768; unit += F.G) ssm_stage_a(F, unit);
        const float* rpb = ARGP(6);
        for (int unit = blockIdx.x; unit < 1536; unit += F.G) attn_unit(F, rpb, unit);
    }
    SEAM(2);
    if (IN(3)) { PH_BEGIN();
        for (int task = F.wave * F.G + blockIdx.x; task < 768; task += F.NGW) { if (task & 1) ssm_scan_task<1>(F, task); else ssm_scan_task<0>(F, task); }
    }
    SEAM(3);
    if (IN(4)) { PH_BEGIN();
        for (int unit = blockIdx.x; unit < 1536; unit += F.G) ssm_stage_c(F, unit);
    }
    SEAM(4);
    if (IN(5)) { PH_BEGIN();
        pg8::Gemm g{(const bf16*)(ws + WS_Z), (const bf16*)(ws + WS_WGLU), T, AW, AW, F.wave}; pg8::StaticOrder S; S.init(T, AW, F.G, (int)blockIdx.x);
        pg8::EpiGlu E{(const bf16*)(ws + WS_Z), XB, ARGP(23), psssm};
        pg8::gemm_phase<pg8::EpiGlu, pg8::StaticOrder, true, true>(F.lds, g, S, E);
    }
    SEAM(5);
    if (IN(6)) { PH_BEGIN();
        for (int m = blockIdx.x * 512 + F.tid; m < T; m += F.G * 512) {
            float sa = 0.f, ss = 0.f;
#pragma unroll
            for (int j = 0; j < 4; ++j) { const f32x4 v = ((const f32x4*)(psatt + (size_t)m * 16))[j]; sa += (v[0] + v[1]) + (v[2] + v[3]); }
#pragma unroll
            for (int j = 0; j < 8; ++j) { const f32x4 v = ((const f32x4*)(psssm + (size_t)m * 32))[j]; ss += (v[0] + v[1]) + (v[2] + v[3]); }
            const float ra = 1.0f / sqrtf(sa * (1.0f / AW) + RMS_EPS), rs = 1.0f / sqrtf(ss * (1.0f / AW) + RMS_EPS);
            ratio[m] = ra / rs; rsssm[m] = rs; }
    }
    SEAM(6);
    if (IN(7)) { PH_BEGIN();
        pg8::Gemm g{XB, (const bf16*)(ws + WS_WOUT), T, D, D, F.wave}; pg8::StaticOrder S; S.init(T, D, F.G, (int)blockIdx.x);
        pg8::EpiOut E{F.out, ratio, rsssm, psmix};
        pg8::gemm_phase<pg8::EpiOut, pg8::StaticOrder, true, true>(F.lds, g, S, E);
    }
    SEAM(7);
    if (IN(8)) { PH_BEGIN();
        { const float* xp = ARGP(0); const float* xs = ARGP(1); const float* gpm = ARGP(27);
        for (int m = F.gw; m < T; m += F.NGW)
            row_pass(F, xrow(xp, xs, m), F.out + (size_t)m * D, psmix + (size_t)m * 64, gpm, F.out + (size_t)m * D, XB + (size_t)m * D, rstd1 + m); }
        constexpr int I_UP = (D / 64) * (DFF / 64), I_DN = (DFF / 64) * (D / 64), I_GT = (D / 64) * (D / 64), I_PL = (PLE / 64) * (D / 64);
        const float* w_up = ARGP(29); const float* g_mlp = ARGP(28); const float* w_dn = ARGP(30); const float* w_gt = ARGP(33); const float* g_pl = ARGP(32); const float* w_pl = ARGP(34);
        for (int it = F.gw; it < I_UP + I_DN + I_GT + I_PL; it += F.NGW) {
            int r = it;
            if (r < I_UP) { transpose_item(w_up, D, DFF, (bf16*)(ws + WS_WUP), g_mlp, 0, 1.f, scr, r, F.lane); continue; } r -= I_UP;
            if (r < I_DN) { transpose_item(w_dn, DFF, D, (bf16*)(ws + WS_WDOWN), nullptr, 0, 1.f, scr, r, F.lane); continue; } r -= I_DN;
            if (r < I_GT) { transpose_item(w_gt, D, D, (bf16*)(ws + WS_WGATE), g_pl, 0, 1.f, scr, r, F.lane); continue; } r -= I_GT;
            transpose_item(w_pl, PLE, D, (bf16*)(ws + WS_WPLE), nullptr, 0, 1.f, scr, r, F.lane);
        }
    }
    SEAM(8);
    for (int ch = 0; ch < NCHUNK; ++ch) {
        const int row_off = ch * MCHUNK;
        if (IN(9 + 3 * ch)) { PH_BEGIN();
            pg8::Gemm g{XB + (size_t)row_off * D, (const bf16*)(ws + WS_WUP), MCHUNK, DFF, D, F.wave}; pg8::StaticOrder S; S.init(MCHUNK, DFF, F.G, (int)blockIdx.x);
            pg8::EpiUp E{(bf16*)(ws + WS_HBUF), rstd1, row_off};
            pg8::gemm_phase<pg8::EpiUp, pg8::StaticOrder, true, true>(F.lds, g, S, E);
        }
        SEAM(9 + 3 * ch);
        if (IN(10 + 3 * ch)) { PH_BEGIN();
            pg8::Gemm g{(const bf16*)(ws + WS_HBUF), (const bf16*)(ws + WS_WDOWN), MCHUNK, D, DFF, F.wave}; pg8::StaticOrder S; S.init(MCHUNK, D, F.G, (int)blockIdx.x);
            pg8::EpiDown E{(float*)(ws + WS_MCH), psm, row_off};
            pg8::gemm_phase<pg8::EpiDown, pg8::StaticOrder, true, true>(F.lds, g, S, E);
        }
        SEAM(10 + 3 * ch);
        if (IN(11 + 3 * ch)) { PH_BEGIN();
            const float* gpl = ARGP(31);
            for (int ml = F.gw; ml < MCHUNK; ml += F.NGW) { const int m = row_off + ml;
                row_pass(F, F.out + (size_t)m * D, (const float*)(ws + WS_MCH) + (size_t)ml * D, psm + (size_t)m * 64, gpl, F.out + (size_t)m * D, XB + (size_t)m * D, rstd2 + m); }
        }
        SEAM(11 + 3 * ch);
    }
    if (IN(18)) { PH_BEGIN();
        pg8::Gemm g{(const bf16*)(ws + WS_PEB), (const bf16*)(ws + WS_WPLE), T, D, PLE, F.wave}; pg8::StaticOrder S; S.init(T, D, F.G, (int)blockIdx.x);
        pg8::EpiPle E{(bf16*)(ws + WS_PP)};
        pg8::gemm_phase<pg8::EpiPle, pg8::StaticOrder, true, true>(F.lds, g, S, E);
    }
    SEAM(18);
    if (IN(19)) { PH_BEGIN();
        pg8::Gemm g{XB, (const bf16*)(ws + WS_WGATE), T, D, D, F.wave}; pg8::StaticOrder S; S.init(T, D, F.G, (int)blockIdx.x);
        pg8::EpiGate E{F.out, (const bf16*)(ws + WS_PP), rstd2};
        pg8::gemm_phase<pg8::EpiGate, pg8::StaticOrder, true, true>(F.lds, g, S, E);
    }
#undef IN
#undef SEAM
}

constexpr int N_PHASES = 20;
#ifndef MK_PER_PHASE
#define MK_PER_PHASE 0
#endif
extern "C" void kernel_launch(void* const* d_in, const int* in_sizes, int n_in, void* d_out, int out_size, void* d_ws, size_t ws_size, hipStream_t stream) {
    static int grid = 0;
    if (grid == 0) {
        if (n_in != 35 || out_size != T * D || ws_size < WS_END) { fprintf(stderr, "kernel_launch: unexpected problem (n_in %d, out %d, ws %zu)\n", n_in, out_size, ws_size); grid = -1; return; }
        int dev = 0, cus = 0;
        if (hipGetDevice(&dev) != hipSuccess || hipDeviceGetAttribute(&cus, hipDeviceAttributeMultiprocessorCount, dev) != hipSuccess) { grid = -1; return; }
        if (hipFuncSetAttribute((const void*)fwd_kernel, hipFuncAttributeMaxDynamicSharedMemorySize, LDS_BYTES) != hipSuccess) { fprintf(stderr, "kernel_launch: hipFuncSetAttribute failed\n"); grid = -1; return; }
        int per_cu = 0;
        if (hipOccupancyMaxActiveBlocksPerMultiprocessor(&per_cu, (const void*)fwd_kernel, NWAVES * 64, LDS_BYTES) != hipSuccess || per_cu < 1) fprintf(stderr, "kernel_launch: occupancy query reports %d\n", per_cu);
        (void)hipGetLastError();
        grid = cus;
    }
    if (grid < 0) return;
    (void)hipMemsetAsync((char*)d_ws + WS_CTL, 0, CTL_ZERO_BYTES, stream);
    Args a{};
    for (int i = 0; i < 35; ++i) a.in[i] = (const float*)d_in[i];
    a.out = (float*)d_out; a.ws = (unsigned char*)d_ws;
#if MK_PER_PHASE
    for (int p = 0; p < N_PHASES; ++p) { a.ph_lo = p; a.ph_hi = p + 1; hipLaunchKernelGGL(fwd_kernel, dim3(grid), dim3(NWAVES * 64), LDS_BYTES, stream, a); }
#else
    a.ph_lo = 0; a.ph_hi = N_PHASES;
    hipLaunchKernelGGL(fwd_kernel, dim3(grid), dim3(NWAVES * 64), LDS_BYTES, stream, a);
#endif
}
```

```cpp
#include <hip/hip_runtime.h>
#include <cstdio>
#include <cstdint>

#define GAS __attribute__((address_space(1)))
#define LAS __attribute__((address_space(3)))
typedef unsigned short bf16;
typedef short bf16x8 __attribute__((ext_vector_type(8)));
typedef float f32x4 __attribute__((ext_vector_type(4)));
typedef float f32x2 __attribute__((ext_vector_type(2)));
typedef unsigned u32x4 __attribute__((ext_vector_type(4)));
typedef unsigned u32x2 __attribute__((ext_vector_type(2)));

constexpr int T = 24576, TPR = 8192, D = 4096, AW = 2048, NH = 16, HD = 128, NG = 128, SP = 64, DFF = 16384, PLE = 256, NIN = 8192;
constexpr float RMS_EPS = 1e-6f;
constexpr float LOG2E = 1.4426950408889634f;
constexpr float QSCALE = 0.08838834764831845f * 1.4426950408889634f;

constexpr size_t MiB = 1u << 20;
constexpr size_t WS_CTL = 0, CTL_ZERO_BYTES = 1 * MiB;
constexpr size_t WS_RSTD0 = 1 * MiB, WS_RSTD1 = WS_RSTD0 + 128 * 1024, WS_RSTD2 = WS_RSTD1 + 128 * 1024, WS_RATIO = WS_RSTD2 + 128 * 1024, WS_RSSSM = WS_RATIO + 128 * 1024;
constexpr size_t WS_PSATT = 2 * MiB, WS_PSSSM = 4 * MiB, WS_PSMIX = 8 * MiB, WS_PSM = 8 * MiB;
constexpr size_t WS_PEB = 24 * MiB;
constexpr size_t WS_KTAB = 14 * MiB, WS_MC = 40 * MiB, WS_MB = 72 * MiB;
constexpr size_t WS_WIN = 104 * MiB, WS_WGLU = 168 * MiB, WS_WOUT = 176 * MiB;
constexpr size_t WS_XB = 208 * MiB;
constexpr size_t WS_Q = 400 * MiB, WS_K = 496 * MiB, WS_V = 592 * MiB, WS_UG = 688 * MiB, WS_Z = 784 * MiB, WS_S = 880 * MiB, WS_HB = 976 * MiB;
constexpr size_t WS_WUP = 400 * MiB, WS_WDOWN = 528 * MiB, WS_WGATE = 656 * MiB, WS_WPLE = 688 * MiB;
constexpr size_t WS_HBUF = 692 * MiB;
constexpr size_t WS_MCH = 36 * MiB;
constexpr size_t WS_PP = 692 * MiB;
constexpr size_t WS_MIX = 1024 * MiB;
constexpr size_t WS_END = 1216 * MiB;
constexpr int MCHUNK = 8192, NCHUNK = T / MCHUNK;

constexpr int CW_BAR = 4096;

constexpr int RING_BYTES = 131072;
constexpr int MISC_OFF = RING_BYTES + 320;
constexpr int LDS_BYTES = 147456;
constexpr int NWAVES = 8;

__device__ __forceinline__ unsigned cvt_pk_bf16(float lo, float hi) { unsigned r; asm volatile("v_cvt_pk_bf16_f32 %0, %1, %2" : "=v"(r) : "v"(lo), "v"(hi)); return r; }
__device__ __forceinline__ float bf_lo(unsigned v) { return __builtin_bit_cast(float, v << 16); }
__device__ __forceinline__ float bf_hi(unsigned v) { return __builtin_bit_cast(float, v & 0xffff0000u); }
__device__ __forceinline__ float wave_sum(float v) {
#pragma unroll
    for (int o = 1; o < 64; o <<= 1) v += __shfl_xor(v, o);
    return v;
}
__device__ __forceinline__ float wave_max(float v) {
#pragma unroll
    for (int o = 1; o < 64; o <<= 1) v = fmaxf(v, __shfl_xor(v, o));
    return v;
}
__device__ __forceinline__ int lane_id() { return (int)__builtin_amdgcn_mbcnt_hi(~0u, __builtin_amdgcn_mbcnt_lo(~0u, 0u)); }
__device__ __forceinline__ int lane_op() { int l = lane_id(); asm volatile("" : "+v"(l)); return l; }
__device__ __forceinline__ float sigmoidf_(float x) { return 1.0f / (1.0f + __expf(-x)); }
__device__ __forceinline__ float gelu_tanh(float x) { const float a = 1.5957691216057308f * (x + 0.044715f * x * x * x); return x / (1.0f + __expf(-a)); }

namespace pg8 {
#define PG8_LAS __attribute__((address_space(3)))
typedef unsigned short bf16_t;
constexpr int BM = 256, BK = 64, HALF = 128, HTB = HALF * BK * 2, STAGE_BYTES = 8 * HTB, NXCD = 8, WGM = 8;
__host__ __device__ __forceinline__ int lds_byte(int r, int c) { const int st = (r >> 4) * 2 + (c >> 5), rr = r & 15, cc = c & 31, ob = rr * 64 + cc * 2; return st * 1024 + (ob ^ (((ob >> 9) & 1) << 5)); }
__host__ __device__ __forceinline__ void stage_rc(int b, int& R, int& C) { const int st = b / 1024, sb = b % 1024, swz = sb ^ (((sb >> 9) & 1) << 5); R = (st >> 1) * 16 + swz / 64; C = (st & 1) * 32 + (swz % 64) / 2; }
__host__ __device__ __forceinline__ int perm32(int rho) { const int n = rho >> 4, i = rho & 15; return 8 * (i >> 2) + 4 * n + (i & 3); }
struct Unit { int pm, pn; };
struct Gemm { const bf16_t* A; const bf16_t* Bt; int M, N, K, wave; };
struct StaticOrder {
    int nM, nN, nwg, G, c;
    __host__ __device__ void init(int M, int N, int G_, int c_) { nM = M / BM; nN = N / BM; nwg = nM * nN; G = G_; c = c_; }
    __host__ __device__ bool next(int i, Unit& u) const {
        const long L = (long)i * G + c; if (L >= nwg) return false;
        int wgid = (int)L; { const int q = nwg / NXCD, r = nwg % NXCD, xcd = wgid % NXCD, off = wgid / NXCD; wgid = (xcd < r ? xcd * (q + 1) : r * (q + 1) + (xcd - r) * q) + off; }
        const int nig = WGM * nN, gid = wgid / nig, fm = gid * WGM, gsz = (nM - fm) < WGM ? (nM - fm) : WGM;
        u.pm = fm + ((wgid % nig) % gsz); u.pn = (wgid % nig) / gsz; return true;
    }
    __device__ __forceinline__ void a_ready(const Unit&) const {}
    __device__ __forceinline__ void done(const Unit&) const {}
};

template <class Epi, class Sched, bool ALIGN_EPI = false, bool SP2 = false>
__device__ __forceinline__ void gemm_phase(PG8_LAS unsigned char* lds, const Gemm g, const Sched& S, const Epi& E) {
    const int lane = lane_op(), wid = g.wave, tid = wid * 64 + lane, wr = wid >> 2, wc = wid & 3, fr = lane & 15, fq = lane >> 4;
    const int K = g.K, nt = K / BK;
    unsigned voffA[2], voffB[2];
#pragma unroll
    for (int i = 0; i < 2; ++i) { int R, C; stage_rc(tid * 16 + i * 8192, R, C); const int Rb = Epi::PERM ? ((R & ~31) + perm32(R & 31)) : R;
        voffA[i] = (unsigned)(R * K + C) * 2u; voffB[i] = (unsigned)(Rb * K + C) * 2u; }
    const size_t kstep = (size_t)(BK * 2);
    const size_t hstep = (size_t)HALF * K * 2;
    const size_t tstep = 2 * hstep;
    const unsigned ldsw = (unsigned)wid * 1024u;
    const int aoff = lds_byte(wr * 64 + fr, fq * 8), boff = lds_byte(wc * 32 + fr, fq * 8);
#define PG8_SA(b, h) (((b) * 2 + (h)) * HTB)
#define PG8_SB(b, h) ((4 + (b) * 2 + (h)) * HTB)
#define PG8_STAGE(bufoff, gbase, voff) do { _Pragma("unroll") for (int _i = 0; _i < 2; ++_i) \
        __builtin_amdgcn_global_load_lds((const unsigned*)((const char*)(gbase) + (voff)[_i]), (PG8_LAS unsigned*)(lds + (bufoff) + ldsw + _i * 8192), 16, 0, 0); } while (0)
#define PG8_LDA(dst, b, h) do { _Pragma("unroll") for (int m = 0; m < 4; ++m) _Pragma("unroll") for (int k = 0; k < 2; ++k) dst[m][k] = *(const PG8_LAS bf16x8*)(lds + PG8_SA(b, h) + aoff + m * 2048 + k * 1024); } while (0)
#define PG8_LDB(dst, b, h) do { _Pragma("unroll") for (int n = 0; n < 2; ++n) _Pragma("unroll") for (int k = 0; k < 2; ++k) dst[n][k] = *(const PG8_LAS bf16x8*)(lds + PG8_SB(b, h) + boff + n * 2048 + k * 1024); } while (0)
#define PG8_MMA(ai, bj, At, Bt) do { __builtin_amdgcn_s_setprio(1); _Pragma("unroll") for (int m = 0; m < 4; ++m) _Pragma("unroll") for (int n = 0; n < 2; ++n) _Pragma("unroll") for (int k = 0; k < 2; ++k) \
        acc[ai][bj][m][n] = __builtin_amdgcn_mfma_f32_16x16x32_bf16(Bt[n][k], At[m][k], acc[ai][bj][m][n], 0, 0, 0); __builtin_amdgcn_s_setprio(0); } while (0)
#define PG8_WAIT_V(n) asm volatile("s_waitcnt vmcnt(" #n ")" ::: "memory")
#define PG8_WAIT_L(n) asm volatile("s_waitcnt lgkmcnt(" #n ")" ::: "memory")
#define PG8_BAR __builtin_amdgcn_s_barrier()
#define PG8_SCHED __builtin_amdgcn_sched_barrier(0)
    Unit cur, nxt; int ui = 0;
    if (!S.next(0, cur)) return;
    f32x4 acc[2][2][4][2];
#pragma unroll
    for (int a = 0; a < 2; ++a)
#pragma unroll
        for (int b = 0; b < 2; ++b)
#pragma unroll
            for (int m = 0; m < 4; ++m)
#pragma unroll
                for (int n = 0; n < 2; ++n) acc[a][b][m][n] = (f32x4){0.f, 0.f, 0.f, 0.f};
    bf16x8 At[4][2], B0[2][2], B1[2][2];
    const char* cA = (const char*)g.A + (size_t)cur.pm * tstep; const char* cB = (const char*)g.Bt + (size_t)cur.pn * tstep;
    S.a_ready(cur);
    if constexpr (SP2) {
        PG8_STAGE(PG8_SB(0, 0), cB, voffB); PG8_STAGE(PG8_SB(0, 1), cB + hstep, voffB); PG8_STAGE(PG8_SA(0, 0), cA, voffA); PG8_STAGE(PG8_SA(0, 1), cA + hstep, voffA);
        if (wr == 1) PG8_BAR;
        PG8_WAIT_V(2); PG8_BAR;
        PG8_STAGE(PG8_SB(1, 0), cB + kstep, voffB); PG8_STAGE(PG8_SA(1, 0), cA + kstep, voffA); PG8_STAGE(PG8_SB(1, 1), cB + hstep + kstep, voffB);
        PG8_WAIT_V(6); PG8_BAR;
    } else {
        PG8_STAGE(PG8_SB(0, 0), cB, voffB); PG8_STAGE(PG8_SA(0, 0), cA, voffA); PG8_STAGE(PG8_SB(0, 1), cB + hstep, voffB); PG8_STAGE(PG8_SA(0, 1), cA + hstep, voffA);
        if (wr == 1) PG8_BAR;
        PG8_WAIT_V(4); PG8_BAR;
        PG8_STAGE(PG8_SB(1, 0), cB + kstep, voffB); PG8_STAGE(PG8_SA(1, 0), cA + kstep, voffA); PG8_STAGE(PG8_SB(1, 1), cB + hstep + kstep, voffB);
        PG8_WAIT_V(6); PG8_BAR;
    }
    for (;;) {
        const bool has_next = S.next(ui + 1, nxt);
        const char* nA = has_next ? (const char*)g.A + (size_t)nxt.pm * tstep : cA; const char* nB = has_next ? (const char*)g.Bt + (size_t)nxt.pn * tstep : cB;
#pragma nounroll
        for (int t = 0; t < nt; t += 2) {
            const bool last = (t == nt - 2);
            const char* a1 = cA + (size_t)(t + 1) * kstep;
            const char* a2 = last ? nA : cA + (size_t)(t + 2) * kstep; const char* b2 = last ? nB : cB + (size_t)(t + 2) * kstep;
            const char* a3 = a2 + kstep; const char* b3 = b2 + kstep;
            if (last && has_next) S.a_ready(nxt);
            if constexpr (Epi::MIDK) { if (t == (nt >> 1)) E.midk(acc, cur, wr, wc, fr, fq); }
            if constexpr (SP2) {
            PG8_LDB(B0, 0, 0); PG8_LDB(B1, 0, 1); PG8_SCHED; PG8_LDA(At, 0, 0); PG8_STAGE(PG8_SA(1, 1), a1 + hstep, voffA);
            PG8_WAIT_V(8); PG8_WAIT_L(0); PG8_BAR; PG8_MMA(0, 0, At, B0); PG8_MMA(0, 1, At, B1); PG8_BAR; PG8_SCHED;
            PG8_LDA(At, 0, 1); PG8_STAGE(PG8_SB(0, 0), b2, voffB); PG8_STAGE(PG8_SB(0, 1), b2 + hstep, voffB); PG8_STAGE(PG8_SA(0, 0), a2, voffA);
            PG8_WAIT_V(8); PG8_WAIT_L(0); PG8_BAR; PG8_MMA(1, 0, At, B0); PG8_MMA(1, 1, At, B1); PG8_BAR; PG8_SCHED;
            PG8_LDB(B0, 1, 0); PG8_LDB(B1, 1, 1); PG8_SCHED; PG8_LDA(At, 1, 0); PG8_STAGE(PG8_SA(0, 1), a2 + hstep, voffA);
            PG8_WAIT_V(8); PG8_WAIT_L(0); PG8_BAR; PG8_MMA(0, 0, At, B0); PG8_MMA(0, 1, At, B1); PG8_BAR; PG8_SCHED;
            PG8_LDA(At, 1, 1); PG8_STAGE(PG8_SB(1, 0), b3, voffB); PG8_STAGE(PG8_SB(1, 1), b3 + hstep, voffB); PG8_STAGE(PG8_SA(1, 0), a3, voffA);
            PG8_WAIT_V(8); PG8_WAIT_L(0); PG8_BAR; PG8_MMA(1, 0, At, B0); PG8_MMA(1, 1, At, B1); PG8_BAR; PG8_SCHED;
            } else {
            PG8_LDB(B0, 0, 0); PG8_SCHED; PG8_LDA(At, 0, 0); PG8_STAGE(PG8_SA(1, 1), a1 + hstep, voffA);
            PG8_WAIT_L(8); PG8_BAR; PG8_WAIT_L(0); PG8_MMA(0, 0, At, B0); PG8_BAR; PG8_SCHED;
            PG8_LDB(B1, 0, 1); PG8_STAGE(PG8_SB(0, 0), b2, voffB);
            PG8_BAR; PG8_WAIT_L(0); PG8_MMA(0, 1, At, B1); PG8_BAR;
            PG8_LDA(At, 0, 1); PG8_STAGE(PG8_SA(0, 0), a2, voffA);
            PG8_BAR; PG8_WAIT_L(0); PG8_MMA(1, 0, At, B0); PG8_BAR; PG8_SCHED;
            PG8_STAGE(PG8_SB(0, 1), b2 + hstep, voffB);
            PG8_WAIT_V(6); PG8_BAR; PG8_MMA(1, 1, At, B1); PG8_BAR;
            PG8_LDB(B0, 1, 0); PG8_SCHED; PG8_LDA(At, 1, 0); PG8_STAGE(PG8_SA(0, 1), a2 + hstep, voffA);
            PG8_WAIT_L(8); PG8_BAR; PG8_WAIT_L(0); PG8_MMA(0, 0, At, B0); PG8_BAR; PG8_SCHED;
            PG8_LDB(B1, 1, 1); PG8_STAGE(PG8_SB(1, 0), b3, voffB);
            PG8_BAR; PG8_WAIT_L(0); PG8_MMA(0, 1, At, B1); PG8_BAR;
            PG8_LDA(At, 1, 1); PG8_STAGE(PG8_SA(1, 0), a3, voffA);
            PG8_BAR; PG8_WAIT_L(0); PG8_MMA(1, 0, At, B0); PG8_BAR; PG8_SCHED;
            PG8_STAGE(PG8_SB(1, 1), b3 + hstep, voffB);
            PG8_WAIT_V(6); PG8_BAR; PG8_MMA(1, 1, At, B1); PG8_BAR;
            }
        }
        if constexpr (ALIGN_EPI) { if (wr == 0) PG8_BAR; }
        E(acc, cur, wr, wc, fr, fq); S.done(cur);
        if (!has_next) break;
#pragma unroll
        for (int a = 0; a < 2; ++a)
#pragma unroll
            for (int b = 0; b < 2; ++b)
#pragma unroll
                for (int m = 0; m < 4; ++m)
#pragma unroll
                    for (int n = 0; n < 2; ++n) acc[a][b][m][n] = (f32x4){0.f, 0.f, 0.f, 0.f};
        cur = nxt; cA = nA; cB = nB; ++ui;
        if constexpr (ALIGN_EPI) { if (wr == 1) PG8_BAR; }
    }
    PG8_WAIT_V(0);
    if constexpr (!ALIGN_EPI) { if (wr == 0) PG8_BAR; }
    PG8_BAR;
#undef PG8_SA
#undef PG8_SB
#undef PG8_STAGE
#undef PG8_LDA
#undef PG8_LDB
#undef PG8_MMA
#undef PG8_WAIT_V
#undef PG8_WAIT_L
#undef PG8_BAR
#undef PG8_SCHED
}

typedef f32x4 Acc[2][2][4][2];

struct EpiProj {
    static constexpr bool PERM = true, MIDK = false;
    bf16_t *Q, *Ug; const float* rstd;
    __device__ __forceinline__ void operator()(const Acc& acc, const Unit& u, int wr, int wc, int fr, int fq) const {
        const int row0 = u.pm * BM + wr * 64 + fr; const int t = u.pn >> 3;
        const int colt = (u.pn & 7) * BM + wc * 32 + 8 * fq;
        bf16_t* base = Q + (size_t)t * ((size_t)T * AW);
#pragma unroll
        for (int ai = 0; ai < 2; ++ai)
#pragma unroll
            for (int m = 0; m < 4; ++m) { const int row = row0 + ai * HALF + m * 16; const float rs = rstd[row];
#pragma unroll
                for (int bj = 0; bj < 2; ++bj) { const f32x4 v0 = acc[ai][bj][m][0] * rs, v1 = acc[ai][bj][m][1] * rs;
                    u32x4 w; w.x = cvt_pk_bf16(v0[0], v0[1]); w.y = cvt_pk_bf16(v0[2], v0[3]); w.z = cvt_pk_bf16(v1[0], v1[1]); w.w = cvt_pk_bf16(v1[2], v1[3]);
                    const int col = colt + bj * HALF;
                    if (t < 3) *(u32x4*)(base + (size_t)row * AW + col) = w;
                    else *(u32x4*)(Ug + ((size_t)(((col >> 4) * 24 + (row >> 10)) * 32 + (row & 31)) * 64 + ((row >> 5) & 31) + 4 * (col & 8)) * 8) = w; } }
    }
};
struct EpiGlu {
    static constexpr bool PERM = true, MIDK = false;
    const bf16_t* Z; bf16_t* cat; const float* bglu; float* ps;
    __device__ __forceinline__ void operator()(const Acc& acc, const Unit& u, int wr, int wc, int fr, int fq) const {
        const int row0 = u.pm * BM + wr * 64 + fr; const int col0 = u.pn * BM + wc * 32 + 8 * fq;
        f32x4 bv[2][2];
#pragma unroll
        for (int bj = 0; bj < 2; ++bj)
#pragma unroll
            for (int n = 0; n < 2; ++n) bv[bj][n] = *(const f32x4*)(bglu + col0 + bj * HALF + 4 * n);
#pragma unroll
        for (int ai = 0; ai < 2; ++ai)
#pragma unroll
            for (int m = 0; m < 4; ++m) { const int row = row0 + ai * HALF + m * 16; float ssq = 0.f;
#pragma unroll
                for (int bj = 0; bj < 2; ++bj) { const int col = col0 + bj * HALF;
                    const u32x4 zr = *(const u32x4*)(Z + (size_t)row * AW + col);
                    const f32x4 a0 = acc[ai][bj][m][0] + bv[bj][0], a1 = acc[ai][bj][m][1] + bv[bj][1];
                    f32x4 s0, s1;
                    s0[0] = bf_lo(zr.x) * sigmoidf_(a0[0]); s0[1] = bf_hi(zr.x) * sigmoidf_(a0[1]); s0[2] = bf_lo(zr.y) * sigmoidf_(a0[2]); s0[3] = bf_hi(zr.y) * sigmoidf_(a0[3]);
                    s1[0] = bf_lo(zr.z) * sigmoidf_(a1[0]); s1[1] = bf_hi(zr.z) * sigmoidf_(a1[1]); s1[2] = bf_lo(zr.w) * sigmoidf_(a1[2]); s1[3] = bf_hi(zr.w) * sigmoidf_(a1[3]);
                    ssq += (s0[0] * s0[0] + s0[1] * s0[1]) + (s0[2] * s0[2] + s0[3] * s0[3]) + (s1[0] * s1[0] + s1[1] * s1[1]) + (s1[2] * s1[2] + s1[3] * s1[3]);
                    u32x4 w; w.x = cvt_pk_bf16(s0[0], s0[1]); w.y = cvt_pk_bf16(s0[2], s0[3]); w.z = cvt_pk_bf16(s1[0], s1[1]); w.w = cvt_pk_bf16(s1[2], s1[3]);
                    *(u32x4*)(cat + (size_t)row * D + AW + col) = w; }
                ssq += __shfl_xor(ssq, 16); ssq += __shfl_xor(ssq, 32);
                if (fq == 0) ps[(size_t)row * 32 + u.pn * 4 + wc] = ssq;
                asm volatile("" ::: "memory"); }
    }
};
struct EpiOut {
    static constexpr bool PERM = true, MIDK = true;
    bf16_t* out; const float* ratio; const float* rsssm; float* ps;
    __device__ __forceinline__ void midk(Acc& acc, const Unit& u, int wr, int wc, int fr, int fq) const {
        const int row0 = u.pm * BM + wr * 64 + fr;
#pragma unroll
        for (int ai = 0; ai < 2; ++ai)
#pragma unroll
            for (int m = 0; m < 4; ++m) { const float r = ratio[row0 + ai * HALF + m * 16];
#pragma unroll
                for (int bj = 0; bj < 2; ++bj)
#pragma unroll
                    for (int n = 0; n < 2; ++n) acc[ai][bj][m][n] = acc[ai][bj][m][n] * r; }
    }
    __device__ __forceinline__ void operator()(const Acc& acc, const Unit& u, int wr, int wc, int fr, int fq) const {
        const int row0 = u.pm * BM + wr * 64 + fr; const int col0 = u.pn * BM + wc * 32 + 8 * fq;
#pragma unroll
        for (int ai = 0; ai < 2; ++ai)
#pragma unroll
            for (int m = 0; m < 4; ++m) { const int row = row0 + ai * HALF + m * 16; const float rs = rsssm[row]; float ssq = 0.f;
#pragma unroll
                for (int bj = 0; bj < 2; ++bj) { const f32x4 v0 = acc[ai][bj][m][0] * rs, v1 = acc[ai][bj][m][1] * rs;
                    ssq += (v0[0] * v0[0] + v0[1] * v0[1]) + (v0[2] * v0[2] + v0[3] * v0[3]) + (v1[0] * v1[0] + v1[1] * v1[1]) + (v1[2] * v1[2] + v1[3] * v1[3]);
                    u32x4 w; w.x = cvt_pk_bf16(v0[0], v0[1]); w.y = cvt_pk_bf16(v0[2], v0[3]); w.z = cvt_pk_bf16(v1[0], v1[1]); w.w = cvt_pk_bf16(v1[2], v1[3]);
                    *(u32x4*)(out + (size_t)row * D + col0 + bj * HALF) = w; }
                ssq += __shfl_xor(ssq, 16); ssq += __shfl_xor(ssq, 32);
                if (fq == 0) ps[(size_t)row * 64 + u.pn * 4 + wc] = ssq; }
    }
};
struct EpiUp {
    static constexpr bool PERM = true, MIDK = false;
    bf16_t* H; const float* rstd; int row_off;
    __device__ __forceinline__ void operator()(const Acc& acc, const Unit& u, int wr, int wc, int fr, int fq) const {
        const int row0 = u.pm * BM + wr * 64 + fr; const int col0 = u.pn * BM + wc * 32 + 8 * fq;
#pragma unroll
        for (int ai = 0; ai < 2; ++ai)
#pragma unroll
            for (int m = 0; m < 4; ++m) { const int row = row0 + ai * HALF + m * 16; const float rs = rstd[row_off + row];
#pragma unroll
                for (int bj = 0; bj < 2; ++bj) { f32x4 v0 = acc[ai][bj][m][0] * rs, v1 = acc[ai][bj][m][1] * rs;
#pragma unroll
                    for (int j = 0; j < 4; ++j) { const float a = fmaxf(v0[j], 0.f), b = fmaxf(v1[j], 0.f); v0[j] = a * a; v1[j] = b * b; }
                    u32x4 w; w.x = cvt_pk_bf16(v0[0], v0[1]); w.y = cvt_pk_bf16(v0[2], v0[3]); w.z = cvt_pk_bf16(v1[0], v1[1]); w.w = cvt_pk_bf16(v1[2], v1[3]);
                    *(u32x4*)(H + (size_t)row * DFF + col0 + bj * HALF) = w; } }
    }
};
struct EpiDown {
    static constexpr bool PERM = true, MIDK = false;
    bf16_t* Mo; float* ps; int row_off;
    __device__ __forceinline__ void operator()(const Acc& acc, const Unit& u, int wr, int wc, int fr, int fq) const {
        const int row0 = u.pm * BM + wr * 64 + fr; const int col0 = u.pn * BM + wc * 32 + 8 * fq;
#pragma unroll
        for (int ai = 0; ai < 2; ++ai)
#pragma unroll
            for (int m = 0; m < 4; ++m) { const int row = row0 + ai * HALF + m * 16; float ssq = 0.f;
#pragma unroll
                for (int bj = 0; bj < 2; ++bj) { const f32x4 v0 = acc[ai][bj][m][0], v1 = acc[ai][bj][m][1];
                    ssq += (v0[0] * v0[0] + v0[1] * v0[1]) + (v0[2] * v0[2] + v0[3] * v0[3]) + (v1[0] * v1[0] + v1[1] * v1[1]) + (v1[2] * v1[2] + v1[3] * v1[3]);
                    u32x4 w; w.x = cvt_pk_bf16(v0[0], v0[1]); w.y = cvt_pk_bf16(v0[2], v0[3]); w.z = cvt_pk_bf16(v1[0], v1[1]); w.w = cvt_pk_bf16(v1[2], v1[3]);
                    *(u32x4*)(Mo + (size_t)row * D + col0 + bj * HALF) = w; }
                ssq += __shfl_xor(ssq, 16); ssq += __shfl_xor(ssq, 32);
                if (fq == 0) ps[(size_t)(row_off + row) * 64 + u.pn * 4 + wc] = ssq; }
    }
};
struct EpiPle {
    static constexpr bool PERM = true, MIDK = false;
    bf16_t* P;
    __device__ __forceinline__ void operator()(const Acc& acc, const Unit& u, int wr, int wc, int fr, int fq) const {
        const int row0 = u.pm * BM + wr * 64 + fr; const int col0 = u.pn * BM + wc * 32 + 8 * fq;
#pragma unroll
        for (int ai = 0; ai < 2; ++ai)
#pragma unroll
            for (int m = 0; m < 4; ++m) { const int row = row0 + ai * HALF + m * 16;
#pragma unroll
                for (int bj = 0; bj < 2; ++bj) { const f32x4 v0 = acc[ai][bj][m][0], v1 = acc[ai][bj][m][1];
                    u32x4 w; w.x = cvt_pk_bf16(v0[0], v0[1]); w.y = cvt_pk_bf16(v0[2], v0[3]); w.z = cvt_pk_bf16(v1[0], v1[1]); w.w = cvt_pk_bf16(v1[2], v1[3]);
                    *(u32x4*)(P + (size_t)row * D + col0 + bj * HALF) = w; } }
    }
};
struct EpiGate {
    static constexpr bool PERM = false, MIDK = false;
    float* out; const bf16_t* P; const float* rstd;
    __device__ __forceinline__ void operator()(const Acc& acc, const Unit& u, int wr, int wc, int fr, int fq) const {
        const int row0 = u.pm * BM + wr * 64 + fr; const int col0 = u.pn * BM + wc * 32 + 4 * fq;
#pragma unroll
        for (int ai = 0; ai < 2; ++ai)
#pragma unroll
            for (int m = 0; m < 4; ++m) { const int row = row0 + ai * HALF + m * 16; const float rs = rstd[row];
#pragma unroll
                for (int bj = 0; bj < 2; ++bj)
#pragma unroll
                    for (int n = 0; n < 2; ++n) { const size_t off = (size_t)row * D + col0 + bj * HALF + n * 16;
                        const f32x4 h2 = *(const f32x4*)(out + off); const u32x2 pr = *(const u32x2*)(P + off); const f32x4 a = acc[ai][bj][m][n] * rs;
                        f32x4 o; o[0] = h2[0] + bf_lo(pr.x) * sigmoidf_(a[0]); o[1] = h2[1] + bf_hi(pr.x) * sigmoidf_(a[1]); o[2] = h2[2] + bf_lo(pr.y) * sigmoidf_(a[2]); o[3] = h2[3] + bf_hi(pr.y) * sigmoidf_(a[3]);
                        *(f32x4*)(out + off) = o; }
                asm volatile("" ::: "memory"); }
    }
};
}

#define XB_TMO      128
#define XB_XCNT(j)  (256  + 64 * (j))
#define XB_XSUB(j)  (1280 + 64 * (j))
#define XB_XGEN(j)  (2304 + 64 * (j))
#define XB_TOP      3328
#define XB_TOPGEN   3392
#define XCD_BAR_WORDS 3456
#define XB_SPIN_CAP (1u << 18)
__device__ __forceinline__ unsigned xb_ld(unsigned* p)              { return __hip_atomic_load(p, __ATOMIC_RELAXED, __HIP_MEMORY_SCOPE_AGENT); }
__device__ __forceinline__ unsigned xb_add(unsigned* p, unsigned v) { return __hip_atomic_fetch_add(p, v, __ATOMIC_RELAXED, __HIP_MEMORY_SCOPE_AGENT); }
__device__ __forceinline__ unsigned xb_xcc_id() { return (unsigned)__builtin_amdgcn_s_getreg((3 << 11) | 20) & 0xFu; }
#define XB_SPIN(cond, bar) do { unsigned _sp = 0; while (cond) { __builtin_amdgcn_s_sleep(1); \
    if ((++_sp & 255u) == 0u) { if (xb_ld(&(bar)[XB_TMO])) break; if (_sp > XB_SPIN_CAP) { atomicAdd(&(bar)[XB_TMO], 1u); break; } } } } while (0)
struct XcdBarrier { unsigned* bar; unsigned x; volatile LAS unsigned* st; int wave; };
__device__ __forceinline__ XcdBarrier xcd_barrier_post(unsigned* bar, volatile LAS unsigned* st, int wave) {
    XcdBarrier b; b.bar = bar; b.x = xb_xcc_id(); b.st = st; b.wave = wave;
    if (wave == 0 && lane_id() == 0) (void)xb_add(&bar[XB_XCNT(b.x)], 1u);
    return b;
}
__device__ __forceinline__ void xcd_barrier_complete(unsigned* bar, unsigned x, unsigned& nloc, unsigned& nx) {
    const unsigned G = gridDim.x * gridDim.y * gridDim.z;
    unsigned sum, cnt, mine, sp = 0u;
    for (;;) {
        sum = 0u; cnt = 0u; mine = 0u;
#pragma unroll
        for (unsigned j = 0; j < 16; ++j) { const unsigned c = xb_ld(&bar[XB_XCNT(j)]); sum += c; cnt += (c > 0u) ? 1u : 0u; mine = (j == x) ? c : mine; }
        if (sum == G) break;
        __builtin_amdgcn_s_sleep(1);
        if ((++sp & 255u) == 0u) { if (xb_ld(&bar[XB_TMO])) break; if (sp > XB_SPIN_CAP) { atomicAdd(&bar[XB_TMO], 1u); break; } }
    }
    nloc = mine > 0u ? mine : 1u; nx = cnt > 0u ? cnt : 1u;
}
__device__ __forceinline__ void xcd_barrier(const XcdBarrier& b) {
    asm volatile("s_waitcnt vmcnt(0)" ::: "memory");
    __syncthreads();
    if (b.wave == 0 && lane_id() == 0) {
        unsigned* bar = b.bar;
        __builtin_amdgcn_s_waitcnt(0);
        unsigned nloc = b.st[0], nx = b.st[1];
        if (nloc == 0u) { xcd_barrier_complete(bar, b.x, nloc, nx); b.st[0] = nloc; b.st[1] = nx; }
        const unsigned old = xb_add(&bar[XB_XSUB(b.x)], 1u);
        const unsigned gen = old / nloc;
        if (old + 1u == (gen + 1u) * nloc) {
            __builtin_amdgcn_fence(__ATOMIC_RELEASE, "agent");
            asm volatile("s_waitcnt vmcnt(0)" ::: "memory");
            const unsigned og = xb_add(&bar[XB_TOP], 1u);
            const unsigned tg = og / nx;
            if (og + 1u == (tg + 1u) * nx) xb_add(&bar[XB_TOPGEN], 1u);
            else XB_SPIN(xb_ld(&bar[XB_TOPGEN]) == tg, bar);
            __builtin_amdgcn_fence(__ATOMIC_ACQUIRE, "agent");
            xb_add(&bar[XB_XGEN(b.x)], 1u);
            asm volatile("s_waitcnt vmcnt(0)" ::: "memory");
        } else {
            XB_SPIN(xb_ld(&bar[XB_XGEN(b.x)]) == gen, bar);
            __builtin_amdgcn_fence(__ATOMIC_ACQUIRE, "agent");
            asm volatile("s_waitcnt vmcnt(0)" ::: "memory");
        }
    }
    __syncthreads();
}

struct Args { const float* in[35]; float* out; unsigned char* ws; int ph_lo, ph_hi; };
template <int I> __device__ __forceinline__ const float* argp() {
    const unsigned long long kp = (unsigned long long)__builtin_amdgcn_kernarg_segment_ptr(); unsigned long long v;
    asm volatile("s_load_dwordx2 %0, %1, %2\n\ts_waitcnt lgkmcnt(0)" : "=s"(v) : "s"(kp), "n"(I * 8) : "memory");
    return (const float*)v;
}
#define ARGP(i) argp<(i)>()
struct Frame {
    LAS unsigned char* lds;
    int tid, lane, wave, G, gw, NGW;
    float* out; unsigned char* ws;
};
#define LDS_WAIT() asm volatile("s_waitcnt lgkmcnt(0)" ::: "memory")

__device__ __forceinline__ const float* xrow(const float* xp, const float* xs, int m) { return m < TPR ? xp + (size_t)m * D : xs + (size_t)(m - TPR) * D; }
__device__ __forceinline__ const float* perow(const float* pp_, const float* ps_, int m) { return m < TPR ? pp_ + (size_t)m * PLE : ps_ + (size_t)(m - TPR) * PLE; }

__device__ __forceinline__ void transpose_item(const float* W, int K, int N, bf16* WT, const float* gk, int ncs, float cscale, LAS float* scr, int item, int lane) {
    const int nblk = N / 64, kb = item / nblk, nb = item % nblk, k0 = 64 * kb, n0 = 64 * nb;
    const float cs = (n0 < ncs) ? cscale : 1.0f;
    const int kl = lane >> 4, n4 = 4 * (lane & 15);
    f32x4 v[16];
#pragma unroll
    for (int i = 0; i < 16; ++i) v[i] = *(const f32x4*)(W + (size_t)(k0 + 4 * i + kl) * N + n0 + n4);
    float gs[16];
#pragma unroll
    for (int i = 0; i < 16; ++i) gs[i] = gk ? gk[k0 + 4 * i + kl] * cs : cs;
    const int rn = lane >> 2, rc = lane & 3;
#pragma unroll
    for (int hh = 0; hh < 2; ++hh) {
#pragma unroll
        for (int i8 = 0; i8 < 8; ++i8) { const int i = hh * 8 + i8, kk = 4 * i8 + kl, c = kk >> 3; *(LAS f32x4*)(scr + kk * 68 + (n4 ^ (8 * c))) = v[i] * gs[i]; }
        LDS_WAIT(); asm volatile("" ::: "memory");
#pragma unroll
        for (int j = 0; j < 4; ++j) { const int n = rn + 16 * j; const LAS float* sp = scr + (8 * rc) * 68 + (n ^ (8 * rc));
            u32x4 o; o.x = cvt_pk_bf16(sp[0 * 68], sp[1 * 68]); o.y = cvt_pk_bf16(sp[2 * 68], sp[3 * 68]); o.z = cvt_pk_bf16(sp[4 * 68], sp[5 * 68]); o.w = cvt_pk_bf16(sp[6 * 68], sp[7 * 68]);
            *(u32x4*)(WT + (size_t)(n0 + n) * K + k0 + 32 * hh + 8 * rc) = o; }
        LDS_WAIT(); asm volatile("" ::: "memory");
    }
}

__device__ __forceinline__ void xb_row(const Frame& F, const float* xp, const float* xs, int m) {
    const f32x4* xr = (const f32x4*)xrow(xp, xs, m) + F.lane;
    bf16* orow = (bf16*)(F.ws + WS_XB) + (size_t)m * D;
    float ssq = 0.f;
#pragma unroll
    for (int j = 0; j < 16; ++j) { const f32x4 v = xr[64 * j]; ssq += (v[0] * v[0] + v[1] * v[1]) + (v[2] * v[2] + v[3] * v[3]);
        u32x2 w; w.x = cvt_pk_bf16(v[0], v[1]); w.y = cvt_pk_bf16(v[2], v[3]); *((u32x2*)orow + F.lane + 64 * j) = w; }
    ssq = wave_sum(ssq);
    if (F.lane == 0) ((float*)(F.ws + WS_RSTD0))[m] = 1.0f / sqrtf(ssq * (1.0f / D) + RMS_EPS);
}
__device__ __forceinline__ void row_pass(const Frame& F, const float* base, const bf16* add, const float* ps, const float* g, float* out, bf16* outb, float* rstd_out) {
    const float rsa = 1.0f / sqrtf(wave_sum(ps[F.lane]) * (1.0f / D) + RMS_EPS);
    float ssq = 0.f;
#pragma unroll
    for (int j = 0; j < 16; ++j) { const int c4 = F.lane + 64 * j;
        const f32x4 b = ((const f32x4*)base)[c4], gg = ((const f32x4*)g)[c4]; const u32x2 ar = ((const u32x2*)add)[c4];
        f32x4 a; a[0] = bf_lo(ar.x); a[1] = bf_hi(ar.x); a[2] = bf_lo(ar.y); a[3] = bf_hi(ar.y);
        const f32x4 h = b + a * rsa * gg;
        ssq += (h[0] * h[0] + h[1] * h[1]) + (h[2] * h[2] + h[3] * h[3]);
        ((f32x4*)out)[c4] = h;
        u32x2 w; w.x = cvt_pk_bf16(h[0], h[1]); w.y = cvt_pk_bf16(h[2], h[3]); ((u32x2*)outb)[c4] = w;
        if ((j & 3) == 3) asm volatile("" ::: "memory"); }
    ssq = wave_sum(ssq);
    if (F.lane == 0) *rstd_out = 1.0f / sqrtf(ssq * (1.0f / D) + RMS_EPS);
}

__device__ __forceinline__ float dot8(const u32x4 a, const u32x4 b) {
    return (bf_lo(a.x) * bf_lo(b.x) + bf_hi(a.x) * bf_hi(b.x)) + (bf_lo(a.y) * bf_lo(b.y) + bf_hi(a.y) * bf_hi(b.y)) +
           (bf_lo(a.z) * bf_lo(b.z) + bf_hi(a.z) * bf_hi(b.z)) + (bf_lo(a.w) * bf_lo(b.w) + bf_hi(a.w) * bf_hi(b.w));
}
__device__ __forceinline__ void attn_slow_task(const Frame& F, const float* rpb, int tok, int h) {
    const int lane = F.lane;
    const bf16* Qb = (const bf16*)(F.ws + WS_Q); const bf16* Kb = (const bf16*)(F.ws + WS_K); const bf16* Vb = (const bf16*)(F.ws + WS_V);
    const int R = tok >> 6, c = tok & 63;
    int Rb, rows; if (R < 64) { Rb = 0; rows = 64; } else if (R < 128) { Rb = 64; rows = 64; } else { Rb = 128; rows = 256; }
    const int r = R - Rb;
    int rs = r - 4; rs = rs < 0 ? 0 : rs; rs = rs > rows - 8 ? rows - 8 : rs;
    int cs = c - 8; cs = cs < 0 ? 0 : cs; cs = cs > 48 ? 48 : cs;
    const u32x4* qp = (const u32x4*)(Qb + (size_t)tok * AW + h * HD);
    float sc[2];
#pragma unroll
    for (int j2 = 0; j2 < 2; ++j2) { const int kk = lane + 64 * j2, kr = kk >> 4, kc = cs + (kk & 15);
        const int ktok = (Rb + rs + kr) * 64 + kc;
        const u32x4* kp = (const u32x4*)(Kb + (size_t)ktok * AW + h * HD);
        float s = 0.f;
#pragma unroll
        for (int d8 = 0; d8 < 16; ++d8) s += dot8(qp[d8], kp[d8]);
        const int dr = (rs + kr) - r + 7; int dc = kc - c + 15; dc = dc < 0 ? 0 : dc; dc = dc > 30 ? 30 : dc;
        s += rpb[(h * 15 + dr) * 31 + dc] * LOG2E;
        sc[j2] = s; }
    const float mx = wave_max(fmaxf(sc[0], sc[1]));
    const float p0 = exp2f(sc[0] - mx), p1 = exp2f(sc[1] - mx);
    const float l = wave_sum(p0 + p1);
    float o0 = 0.f, o1 = 0.f;
    for (int kk = 0; kk < 128; ++kk) { const float pk = __shfl(kk < 64 ? p0 : p1, kk & 63);
        const int kr = kk >> 4, kc = cs + (kk & 15); const int ktok = (Rb + rs + kr) * 64 + kc;
        const unsigned vv = *(const unsigned*)(Vb + (size_t)ktok * AW + h * HD + 2 * lane);
        o0 += pk * bf_lo(vv); o1 += pk * bf_hi(vv); }
    const float inv = 1.0f / l; o0 *= inv; o1 *= inv;
    *(unsigned*)((bf16*)(F.ws + WS_XB) + (size_t)tok * D + h * HD + 2 * lane) = cvt_pk_bf16(o0, o1);
    const float ssq = wave_sum(o0 * o0 + o1 * o1);
    if (lane == 0) ((float*)(F.ws + WS_PSATT))[(size_t)tok * 16 + h] = ssq;
}

template <int dir> __device__ __forceinline__ void ssm_slow_task(const Frame& F, int task) {
    const int lane = F.lane, p = lane;
    const int g = (task >> 1) & 127, seq = task >> 8;
    const int t0 = seq == 0 ? 0 : (seq == 1 ? 4096 : 8192); const int L = seq == 2 ? 16384 : 4096;
    const float* lam_re = ARGP(dir ? 14 : 7); const float* lam_im = ARGP(dir ? 15 : 8); const float* log_dt = ARGP(dir ? 16 : 9);
    const float* b_re = ARGP(dir ? 17 : 10); const float* b_im = ARGP(dir ? 18 : 11); const float* c_re = ARGP(dir ? 19 : 12); const float* c_im = ARGP(dir ? 20 : 13);
    const float lr = fminf(lam_re[g * SP + p], -1e-4f), li = lam_im[g * SP + p], dt = expf(log_dt[g]);
    const float mag = expf(lr * dt); float sn, cs; sincosf(li * dt, &sn, &cs);
    const float lbr = mag * cs, lbi = mag * sn, den = lr * lr + li * li, nr = lbr - 1.0f;
    const float cr = (nr * lr + lbi * li) / den, ci = (lbi * lr - nr * li) / den;
    float bbr[16], bbi[16], ccr[16], cci[16];
#pragma unroll
    for (int h = 0; h < 16; ++h) { const float br = b_re[(size_t)(g * SP + p) * 16 + h], bi = b_im[(size_t)(g * SP + p) * 16 + h];
        bbr[h] = cr * br - ci * bi; bbi[h] = cr * bi + ci * br;
        ccr[h] = c_re[(size_t)(g * 16 + h) * SP + p]; cci[h] = c_im[(size_t)(g * 16 + h) * SP + p]; }
    const bf16* Ug = (const bf16*)(F.ws + WS_UG) + (size_t)g * T * 16;
    float* Y = F.out + (size_t)dir * T * AW;
    unsigned vz; asm volatile("v_mov_b32 %0, 0" : "=v"(vz));
    float sr = 0.f, si = 0.f;
    const int hsel = (lane >> 2) & 15; const bool b5 = lane & 32, b4 = lane & 16, b3 = lane & 8, b2 = lane & 4;
    for (int blk = 0; blk < L / 4; ++blk) {
        const int tb = dir ? (L - 4 - 4 * blk) : 4 * blk;
        const u32x4* up = (const u32x4*)(Ug + (size_t)(t0 + tb) * 16 + vz);
        u32x4 uu[8];
#pragma unroll
        for (int i = 0; i < 8; ++i) uu[i] = up[i];
#pragma unroll
        for (int s4 = 0; s4 < 4; ++s4) { const int ti = dir ? 3 - s4 : s4; const int tok = t0 + tb + ti;
            const u32x4 ua = dir ? uu[2 * (3 - s4)] : uu[2 * s4], ub = dir ? uu[2 * (3 - s4) + 1] : uu[2 * s4 + 1];
            float u[16];
            u[0] = bf_lo(ua.x); u[1] = bf_hi(ua.x); u[2] = bf_lo(ua.y); u[3] = bf_hi(ua.y); u[4] = bf_lo(ua.z); u[5] = bf_hi(ua.z); u[6] = bf_lo(ua.w); u[7] = bf_hi(ua.w);
            u[8] = bf_lo(ub.x); u[9] = bf_hi(ub.x); u[10] = bf_lo(ub.y); u[11] = bf_hi(ub.y); u[12] = bf_lo(ub.z); u[13] = bf_hi(ub.z); u[14] = bf_lo(ub.w); u[15] = bf_hi(ub.w);
            float bur = 0.f, bui = 0.f;
#pragma unroll
            for (int h = 0; h < 16; ++h) { bur += bbr[h] * u[h]; bui += bbi[h] * u[h]; }
            const float nsr = lbr * sr - lbi * si + bur, nsi = lbr * si + lbi * sr + bui; sr = nsr; si = nsi;
            float v[16];
#pragma unroll
            for (int h = 0; h < 16; ++h) v[h] = ccr[h] * sr - cci[h] * si;
            float w8[8], w4[4], w2[2];
#pragma unroll
            for (int i = 0; i < 8; ++i) { const float keep = b5 ? v[8 + i] : v[i], send = b5 ? v[i] : v[8 + i]; w8[i] = keep + __shfl_xor(send, 32); }
#pragma unroll
            for (int i = 0; i < 4; ++i) { const float keep = b4 ? w8[4 + i] : w8[i], send = b4 ? w8[i] : w8[4 + i]; w4[i] = keep + __shfl_xor(send, 16); }
#pragma unroll
            for (int i = 0; i < 2; ++i) { const float keep = b3 ? w4[2 + i] : w4[i], send = b3 ? w4[i] : w4[2 + i]; w2[i] = keep + __shfl_xor(send, 8); }
            float w1 = (b2 ? w2[1] : w2[0]) + __shfl_xor(b2 ? w2[0] : w2[1], 4);
            w1 += __shfl_xor(w1, 2); w1 += __shfl_xor(w1, 1);
            if ((lane & 3) == 0) Y[(size_t)tok * AW + g * 16 + hsel] = w1; }
    }
}


typedef float f32x16 __attribute__((ext_vector_type(16)));
typedef short s16x4 __attribute__((ext_vector_type(4)));
#define MFMA32(a, b, c) __builtin_amdgcn_mfma_f32_32x32x16_bf16((a), (b), (c), 0, 0, 0)
constexpr int NCH = T / 32;

__device__ __forceinline__ void ssm_tables(const Frame& F, int g) {
    LAS float* BBr = (LAS float*)F.lds; LAS float* BBi = BBr + 2048; LAS float* CCr = BBi + 2048; LAS float* CCi = CCr + 2048;
    LAS float* PWr = CCi + 2048; LAS float* PWi = PWr + 4224;
    const int tid = F.tid;
    const float* lamre[2] = {ARGP(7), ARGP(14)}; const float* lamim[2] = {ARGP(8), ARGP(15)}; const float* logdt[2] = {ARGP(9), ARGP(16)};
    {   const float* bre0 = ARGP(10); const float* bim0 = ARGP(11); const float* bre1 = ARGP(17); const float* bim1 = ARGP(18);
        const float* cre0 = ARGP(12); const float* cim0 = ARGP(13); const float* cre1 = ARGP(19); const float* cim1 = ARGP(20);
        for (int idx = tid; idx < 2048; idx += 512) {
            { const int dir = idx >> 10, p = (idx >> 4) & 63, h = idx & 15;
              const float lr = fminf((dir ? lamre[1] : lamre[0])[g * SP + p], -1e-4f), li = (dir ? lamim[1] : lamim[0])[g * SP + p], dt = expf((dir ? logdt[1] : logdt[0])[g]);
              const float mag = expf(lr * dt); float sn, cs; sincosf(li * dt, &sn, &cs);
              const float lbr = mag * cs, lbi = mag * sn, den = lr * lr + li * li, nr = lbr - 1.0f;
              const float cr = (nr * lr + lbi * li) / den, ci = (lbi * lr - nr * li) / den;
              const float br = (dir ? bre1 : bre0)[(size_t)(g * SP + p) * 16 + h], bi = (dir ? bim1 : bim0)[(size_t)(g * SP + p) * 16 + h];
              BBr[idx] = cr * br - ci * bi; BBi[idx] = cr * bi + ci * br; }
            { const int dir = idx >> 10, h = (idx >> 6) & 15, p = idx & 63;
              CCr[idx] = (dir ? cre1 : cre0)[(size_t)(g * 16 + h) * SP + p]; CCi[idx] = (dir ? cim1 : cim0)[(size_t)(g * 16 + h) * SP + p]; }
        }
        for (int idx = tid; idx < 4224; idx += 512) { const int dir = idx / 2112, n = (idx % 2112) >> 6, p = idx & 63;
            const float lr = fminf((dir ? lamre[1] : lamre[0])[g * SP + p], -1e-4f), li = (dir ? lamim[1] : lamim[0])[g * SP + p], dt = expf((dir ? logdt[1] : logdt[0])[g]);
            const float mag = expf(lr * dt * (float)n); float sn, cs; sincosf(li * dt * (float)n, &sn, &cs);
            PWr[idx] = mag * cs; PWi[idx] = mag * sn; }
    }
    __syncthreads();
    bf16* MBg = (bf16*)(F.ws + WS_MB) + (size_t)g * 256 * 512; bf16* MCg = (bf16*)(F.ws + WS_MC) + (size_t)g * 512 * 256; bf16* Kt = (bf16*)(F.ws + WS_KTAB) + (size_t)g * 32768;
    for (int task = tid; task < 8192; task += 512) { const int hb = task & 1, ip = (task >> 1) & 31, p = (task >> 6) & 63, dir = task >> 12;
        const int n = dir ? ip : 31 - ip; const float pr = PWr[dir * 2112 + n * 64 + p], pi = PWi[dir * 2112 + n * 64 + p];
        float vr[8], vi[8];
#pragma unroll
        for (int j = 0; j < 8; ++j) { const float br = BBr[(dir * 64 + p) * 16 + 8 * hb + j], bi = BBi[(dir * 64 + p) * 16 + 8 * hb + j]; vr[j] = pr * br - pi * bi; vi[j] = pr * bi + pi * br; }
        u32x4 wr_, wi_; wr_.x = cvt_pk_bf16(vr[0], vr[1]); wr_.y = cvt_pk_bf16(vr[2], vr[3]); wr_.z = cvt_pk_bf16(vr[4], vr[5]); wr_.w = cvt_pk_bf16(vr[6], vr[7]);
        wi_.x = cvt_pk_bf16(vi[0], vi[1]); wi_.y = cvt_pk_bf16(vi[2], vi[3]); wi_.z = cvt_pk_bf16(vi[4], vi[5]); wi_.w = cvt_pk_bf16(vi[6], vi[7]);
        { const int mtile = dir * 4 + (p >> 4), r0 = 2 * (p & 15); bf16* fb = MBg + ((size_t)(mtile * 32 + ip) * 64) * 8;
          *(u32x4*)(fb + (r0 + 32 * hb) * 8) = wr_; *(u32x4*)(fb + (r0 + 1 + 32 * hb) * 8) = wi_; } }
    for (int task = tid; task < 16384; task += 512) { const int pb = task & 15, dir = (task >> 4) & 1, h = (task >> 5) & 15, i = task >> 9;
        const int n = dir ? 32 - i : i + 1; float v[8];
#pragma unroll
        for (int j = 0; j < 4; ++j) { const int p = 4 * pb + j; const float cr = CCr[(dir * 16 + h) * 64 + p], ci = CCi[(dir * 16 + h) * 64 + p], pr = PWr[dir * 2112 + n * 64 + p], pi = PWi[dir * 2112 + n * 64 + p];
            v[2 * j] = cr * pr - ci * pi; v[2 * j + 1] = -(cr * pi + ci * pr); }
        u32x4 w; w.x = cvt_pk_bf16(v[0], v[1]); w.y = cvt_pk_bf16(v[2], v[3]); w.z = cvt_pk_bf16(v[4], v[5]); w.w = cvt_pk_bf16(v[6], v[7]);
        *(u32x4*)(MCg + ((size_t)(((i >> 1) * 16 + dir * 8 + (pb >> 1)) * 64) + ((i & 1) * 16 + h) + 32 * (pb & 1)) * 8) = w; }
    const float* dsk = ARGP(21);
    for (int task = tid; task < 2016; task += 512) { const int hb = task & 1, h = (task >> 1) & 15, di = task >> 5; const int d = di - 31;
        float acc[8];
#pragma unroll
        for (int j = 0; j < 8; ++j) acc[j] = 0.f;
        for (int dir = 0; dir < 2; ++dir) { if ((dir == 0 && d < 0) || (dir == 1 && d > 0)) continue; const int n = d < 0 ? -d : d;
            for (int p = 0; p < 64; ++p) { const float cr = CCr[(dir * 16 + h) * 64 + p], ci = CCi[(dir * 16 + h) * 64 + p], pr = PWr[dir * 2112 + n * 64 + p], pi = PWi[dir * 2112 + n * 64 + p];
                const float wr_ = cr * pr - ci * pi, wi_ = cr * pi + ci * pr;
#pragma unroll
                for (int j = 0; j < 8; ++j) acc[j] += wr_ * BBr[(dir * 64 + p) * 16 + 8 * hb + j] - wi_ * BBi[(dir * 64 + p) * 16 + 8 * hb + j]; } }
        if (d == 0) {
#pragma unroll
            for (int j = 0; j < 8; ++j) if (8 * hb + j == h) acc[j] += dsk[g * 16 + h]; }
        u32x4 w; w.x = cvt_pk_bf16(acc[0], acc[1]); w.y = cvt_pk_bf16(acc[2], acc[3]); w.z = cvt_pk_bf16(acc[4], acc[5]); w.w = cvt_pk_bf16(acc[6], acc[7]);
        if (di <= 61) *(u32x4*)(Kt + ((size_t)di * 64 + h + 32 * hb) * 8) = w;
        if (di >= 1) *(u32x4*)(Kt + ((size_t)(di - 1) * 64 + 16 + h + 32 * hb) * 8) = w; }
    __syncthreads();
}

__device__ __forceinline__ void ssm_stage_a(const Frame& F, int unit) {
    const int mh = unit & 1, ct = (unit >> 1) % 24, G8 = unit / 48;
    const int g = G8 * 8 + F.wave, c = F.lane & 31, hf = F.lane >> 5;
    const bf16* Up = (const bf16*)(F.ws + WS_UG) + ((size_t)(g * 24 + ct) * 32) * 512 + F.lane * 8;
    const bf16* Ap = (const bf16*)(F.ws + WS_MB) + ((size_t)(g * 8 + 4 * mh) * 32) * 512 + F.lane * 8;
    f32x16 acc[4];
#pragma unroll
    for (int m = 0; m < 4; ++m)
#pragma unroll
        for (int i = 0; i < 16; ++i) acc[m][i] = 0.f;
#pragma unroll 4
    for (int ks = 0; ks < 32; ++ks) { const bf16x8 b = *(const bf16x8*)(Up + ks * 512);
#pragma unroll
        for (int m = 0; m < 4; ++m) { const bf16x8 a = *(const bf16x8*)(Ap + (size_t)(m * 32 + ks) * 512); acc[m] = MFMA32(a, b, acc[m]); } }
    float* Sp = (float*)(F.ws + WS_S) + ((size_t)(g * 24 + ct) * 64 + 32 * mh + hf) * 128 + c * 4;
#pragma unroll
    for (int m = 0; m < 4; ++m)
#pragma unroll
        for (int q = 0; q < 4; ++q) *(f32x4*)(Sp + (size_t)(8 * m + 2 * q) * 128) = (f32x4){acc[m][4 * q], acc[m][4 * q + 1], acc[m][4 * q + 2], acc[m][4 * q + 3]};
}

template <int dir> __device__ __forceinline__ void ssm_scan_task(const Frame& F, int task) {
    const int p = F.lane, g = (task >> 1) & 127, seq = task >> 8;
    const int c0 = seq == 0 ? 0 : (seq == 1 ? 128 : 256), nc = seq == 2 ? 512 : 128;
    const float lr = fminf(ARGP(dir ? 14 : 7)[g * SP + p], -1e-4f), li = ARGP(dir ? 15 : 8)[g * SP + p], dt = expf(ARGP(dir ? 16 : 9)[g]);
    const float mag = expf(lr * dt * 32.0f); float sn, cs; sincosf(li * dt * 32.0f, &sn, &cs);
    const float qr = mag * cs, qi = mag * sn;
    const float* Sg = (const float*)(F.ws + WS_S) + ((size_t)g * 24 * 64 + dir * 32 + (p >> 1)) * 128 + 2 * (p & 1);
    bf16* Hg = (bf16*)(F.ws + WS_HB) + ((size_t)g * 24 * 16 + dir * 8 + (p >> 3)) * 512 + 32 * 8 * ((p & 7) >> 2) + 2 * (p & 3);
#define S_AT(cg) (Sg + (size_t)((cg) >> 5) * (64 * 128) + ((cg) & 31) * 4)
#define H_AT(cg) (Hg + (size_t)((cg) >> 5) * (16 * 512) + ((cg) & 31) * 8)
    float hr = 0.f, hi = 0.f;
    f32x2 cur[32];
#pragma unroll
    for (int j = 0; j < 32; ++j) { const int c = dir ? (c0 + nc - 1 - j) : (c0 + j); cur[j] = *(const f32x2*)S_AT(c); }
    for (int sb = 0; sb < nc / 32; ++sb) {
        f32x2 nxt[32];
        const int sbn = (sb + 1 < nc / 32) ? sb + 1 : sb;
#pragma unroll
        for (int j = 0; j < 32; ++j) { const int k = sbn * 32 + j; const int c = dir ? (c0 + nc - 1 - k) : (c0 + k); nxt[j] = *(const f32x2*)S_AT(c); }
#pragma unroll
        for (int j = 0; j < 32; ++j) { const int k = sb * 32 + j; const int c = dir ? (c0 + nc - 1 - k) : (c0 + k);
            *(unsigned*)H_AT(c) = cvt_pk_bf16(hr, hi);
            const float nr = qr * hr - qi * hi + cur[j].x, ni = qr * hi + qi * hr + cur[j].y; hr = nr; hi = ni; }
#pragma unroll
        for (int j = 0; j < 32; ++j) cur[j] = nxt[j];
    }
#undef S_AT
#undef H_AT
}

__device__ __forceinline__ void ssm_stage_c(const Frame& F, int unit) {
    const int mb = unit & 3, ct = (unit >> 2) % 24, G8 = unit / 96;
    const int g = G8 * 8 + F.wave, r = F.lane & 31, hf = F.lane >> 5;
    const bf16* Up = (const bf16*)(F.ws + WS_UG) + ((size_t)(g * 24 + ct) * 32) * 512 + F.lane * 8;
    const bf16* Kp = (const bf16*)(F.ws + WS_KTAB) + ((size_t)g * 64 + 8 * mb + 31) * 512 + F.lane * 8;
    const bf16* Hp = (const bf16*)(F.ws + WS_HB) + ((size_t)(g * 24 + ct) * 16) * 512 + F.lane * 8;
    const bf16* Cp = (const bf16*)(F.ws + WS_MC) + ((size_t)(g * 16 + 4 * mb) * 16) * 512 + F.lane * 8;
    f32x16 acc[4];
#pragma unroll
    for (int m = 0; m < 4; ++m)
#pragma unroll
        for (int i = 0; i < 16; ++i) acc[m][i] = 0.f;
#pragma unroll 4
    for (int ks = 0; ks < 32; ++ks) { const bf16x8 b = *(const bf16x8*)(Up + ks * 512);
#pragma unroll
        for (int m = 0; m < 4; ++m) { const bf16x8 a = *(const bf16x8*)(Kp + (2 * m - ks) * 512); acc[m] = MFMA32(a, b, acc[m]); } }
#pragma unroll 4
    for (int ks = 0; ks < 16; ++ks) { const bf16x8 b = *(const bf16x8*)(Hp + ks * 512);
#pragma unroll
        for (int m = 0; m < 4; ++m) { const bf16x8 a = *(const bf16x8*)(Cp + (size_t)(m * 16 + ks) * 512); acc[m] = MFMA32(a, b, acc[m]); } }
    bf16* Zp = (bf16*)(F.ws + WS_Z) + ((size_t)(ct * 32 + r) * 32 + 8 * mb) * AW + g * 16 + 4 * hf;
#pragma unroll
    for (int m = 0; m < 4; ++m)
#pragma unroll
        for (int q = 0; q < 4; ++q) { u32x2 w; w.x = cvt_pk_bf16(gelu_tanh(acc[m][4 * q]), gelu_tanh(acc[m][4 * q + 1])); w.y = cvt_pk_bf16(gelu_tanh(acc[m][4 * q + 2]), gelu_tanh(acc[m][4 * q + 3]));
            *(u32x2*)(Zp + (size_t)(2 * m + (q >> 1)) * AW + 8 * (q & 1)) = w; }
}

constexpr int BT_OFF = 132096;
__device__ __forceinline__ void attn_unit(const Frame& F, const float* rpb, int unit) {
    const int h = unit & 15, rg = unit >> 4;
    const int lane = F.lane, wave = F.wave, qrow = wave >> 1, qt = wave & 1;
    const int R = 4 * rg + qrow;
    int Rb, rows; if (R < 64) { Rb = 0; rows = 64; } else if (R < 128) { Rb = 64; rows = 64; } else { Rb = 128; rows = 256; }
    const int r = R - Rb; int rs = r - 4; rs = rs < 0 ? 0 : rs; rs = rs > rows - 8 ? rows - 8 : rs;
    const int j31 = lane & 31, hf = lane >> 5;
    const int c = 32 * qt + j31; int cs = c - 8; cs = cs < 0 ? 0 : cs; cs = cs > 48 ? 48 : cs;
    const int tokq = R * 64 + c;
    LAS float* bt = (LAS float*)(F.lds + BT_OFF);
    __syncthreads();
    for (int i = F.tid; i < 465; i += 512) bt[i] = rpb[h * 465 + i] * LOG2E;
    __syncthreads();
    const bf16* Qb = (const bf16*)(F.ws + WS_Q); const bf16* Kb = (const bf16*)(F.ws + WS_K); const bf16* Vb = (const bf16*)(F.ws + WS_V);
    bf16x8 qf[8];
    { const bf16* qp = Qb + (size_t)tokq * AW + h * HD + 8 * hf;
#pragma unroll
      for (int s_ = 0; s_ < 8; ++s_) qf[s_] = *(const bf16x8*)(qp + 16 * s_); }
    f32x16 O[4];
#pragma unroll
    for (int d = 0; d < 4; ++d)
#pragma unroll
        for (int i = 0; i < 16; ++i) O[d][i] = 0.f;
    float mrun = -1e30f, lrun = 0.f;
    LAS unsigned char* vl = F.lds + wave * 16384; const unsigned vbase = (unsigned)(uintptr_t)vl;
    const int i16 = lane & 15, q4 = i16 >> 2, pp = i16 & 3, g1 = (lane >> 4) & 1;
    unsigned tb[4][2];
#pragma unroll
    for (int d = 0; d < 4; ++d)
#pragma unroll
        for (int sec = 0; sec < 2; ++sec) { const int row_l = 4 * hf + 8 * sec + q4, swz = (q4 << 2) | ((hf + 2 * sec) & 3), ch = 4 * d + 2 * g1 + (pp >> 1);
            tb[d][sec] = vbase + 256 * row_l + 16 * (ch ^ swz) + 8 * (pp & 1); }
    const int vrow = lane >> 4, vch = lane & 15;
    for (int j = 0; j < 8; ++j) {
        const int Rk = Rb + rs + j;
        { const bf16* vp = Vb + (size_t)(Rk * 64 + vrow) * AW + h * HD + vch * 8;
#pragma unroll
          for (int hh = 0; hh < 2; ++hh) { u32x4 vv[8];
#pragma unroll
            for (int i8 = 0; i8 < 8; ++i8) vv[i8] = *(const u32x4*)(vp + (size_t)(4 * (hh * 8 + i8)) * AW);
#pragma unroll
            for (int i8 = 0; i8 < 8; ++i8) { const int i = hh * 8 + i8; *(LAS u32x4*)(vl + 256 * (vrow + 4 * i) + 16 * (vch ^ (((vrow & 3) << 2) | (i & 3)))) = vv[i8]; } } }
        f32x16 sacc[2];
        { const bf16* kp = Kb + (size_t)(Rk * 64 + j31) * AW + h * HD + 8 * hf;
#pragma unroll
          for (int kt = 0; kt < 2; ++kt) {
#pragma unroll
            for (int i = 0; i < 16; ++i) sacc[kt][i] = 0.f;
#pragma unroll
            for (int s_ = 0; s_ < 8; ++s_) { const bf16x8 a = *(const bf16x8*)(kp + (size_t)(32 * kt) * AW + 16 * s_); sacc[kt] = MFMA32(a, qf[s_], sacc[kt]); } } }
        const int dr = (rs + j) - r + 7;
        float mloc = -1e30f;
#pragma unroll
        for (int kt = 0; kt < 2; ++kt)
#pragma unroll
            for (int rg_ = 0; rg_ < 16; ++rg_) { const int kc = 32 * kt + (rg_ & 3) + 8 * (rg_ >> 2) + 4 * hf;
                int idx = kc - c + 15; idx = idx < 0 ? 0 : idx; idx = idx > 30 ? 30 : idx;
                const float sc = ((unsigned)(kc - cs) < 16u) ? sacc[kt][rg_] + bt[dr * 31 + idx] : -1e30f;
                sacc[kt][rg_] = sc; mloc = fmaxf(mloc, sc); }
        mloc = fmaxf(mloc, __shfl_xor(mloc, 32));
        const float mnew = fmaxf(mrun, mloc), alpha = __builtin_amdgcn_exp2f(mrun - mnew); mrun = mnew;
        float psum = 0.f;
#pragma unroll
        for (int kt = 0; kt < 2; ++kt)
#pragma unroll
            for (int rg_ = 0; rg_ < 16; ++rg_) { const float p = __builtin_amdgcn_exp2f(sacc[kt][rg_] - mnew); sacc[kt][rg_] = p; psum += p; }
        lrun = lrun * alpha + psum;
#pragma unroll
        for (int d = 0; d < 4; ++d)
#pragma unroll
            for (int i = 0; i < 16; ++i) O[d][i] *= alpha;
        bf16x8 pb[2][2];
#pragma unroll
        for (int kt = 0; kt < 2; ++kt)
#pragma unroll
            for (int s2 = 0; s2 < 2; ++s2) { u32x4 w; w.x = cvt_pk_bf16(sacc[kt][8 * s2], sacc[kt][8 * s2 + 1]); w.y = cvt_pk_bf16(sacc[kt][8 * s2 + 2], sacc[kt][8 * s2 + 3]);
                w.z = cvt_pk_bf16(sacc[kt][8 * s2 + 4], sacc[kt][8 * s2 + 5]); w.w = cvt_pk_bf16(sacc[kt][8 * s2 + 6], sacc[kt][8 * s2 + 7]); pb[kt][s2] = __builtin_bit_cast(bf16x8, w); }
#pragma unroll
        for (int d = 0; d < 4; ++d) { s16x4 f0, f1, f2, f3, f4, f5, f6, f7;
            asm volatile("ds_read_b64_tr_b16 %0, %8\n\tds_read_b64_tr_b16 %1, %9\n\tds_read_b64_tr_b16 %2, %8 offset:4096\n\tds_read_b64_tr_b16 %3, %9 offset:4096\n\t"
                         "ds_read_b64_tr_b16 %4, %8 offset:8192\n\tds_read_b64_tr_b16 %5, %9 offset:8192\n\tds_read_b64_tr_b16 %6, %8 offset:12288\n\tds_read_b64_tr_b16 %7, %9 offset:12288\n\ts_waitcnt lgkmcnt(0)"
                         : "=&v"(f0), "=&v"(f1), "=&v"(f2), "=&v"(f3), "=&v"(f4), "=&v"(f5), "=&v"(f6), "=&v"(f7) : "v"(tb[d][0]), "v"(tb[d][1]) : "memory");
            O[d] = MFMA32(__builtin_shufflevector(f0, f1, 0, 1, 2, 3, 4, 5, 6, 7), pb[0][0], O[d]);
            O[d] = MFMA32(__builtin_shufflevector(f2, f3, 0, 1, 2, 3, 4, 5, 6, 7), pb[0][1], O[d]);
            O[d] = MFMA32(__builtin_shufflevector(f4, f5, 0, 1, 2, 3, 4, 5, 6, 7), pb[1][0], O[d]);
            O[d] = MFMA32(__builtin_shufflevector(f6, f7, 0, 1, 2, 3, 4, 5, 6, 7), pb[1][1], O[d]); }
    }
    const float inv = 1.0f / (lrun + __shfl_xor(lrun, 32));
    bf16* op = (bf16*)(F.ws + WS_XB) + (size_t)tokq * D + h * HD + 4 * hf;
    float ssq = 0.f;
#pragma unroll
    for (int d = 0; d < 4; ++d)
#pragma unroll
        for (int q = 0; q < 4; ++q) { const float o0 = O[d][4 * q] * inv, o1 = O[d][4 * q + 1] * inv, o2 = O[d][4 * q + 2] * inv, o3 = O[d][4 * q + 3] * inv;
            ssq += (o0 * o0 + o1 * o1) + (o2 * o2 + o3 * o3);
            u32x2 w; w.x = cvt_pk_bf16(o0, o1); w.y = cvt_pk_bf16(o2, o3); *(u32x2*)(op + 32 * d + 8 * q) = w; }
    ssq += __shfl_xor(ssq, 32);
    if (hf == 0) ((float*)(F.ws + WS_PSATT))[(size_t)tokq * 16 + h] = ssq;
}

__device__ __forceinline__ void attn_unit2(const Frame& F, const float* rpb, int unit) {
    const int h = unit & 15, rg = unit >> 4;
    const int lane = F.lane, wave = F.wave, tid = F.tid, qrow = wave >> 1, qt = wave & 1;
    const int R0 = 4 * rg;
    int Rb, rows; if (R0 < 64) { Rb = 0; rows = 64; } else if (R0 < 128) { Rb = 64; rows = 64; } else { Rb = 128; rows = 256; }
    const int r0 = R0 - Rb, r = r0 + qrow;
    int rs = r - 4; rs = rs < 0 ? 0 : rs; rs = rs > rows - 8 ? rows - 8 : rs;
    int kr_lo = r0 - 4; kr_lo = kr_lo < 0 ? 0 : kr_lo; kr_lo = kr_lo > rows - 8 ? rows - 8 : kr_lo;
    int kr_hi = r0 + 3 - 4; kr_hi = kr_hi < 0 ? 0 : kr_hi; kr_hi = kr_hi > rows - 8 ? rows - 8 : kr_hi; kr_hi += 7;
    const int j31 = lane & 31, hf = lane >> 5;
    const int c = 32 * qt + j31; int cs = c - 8; cs = cs < 0 ? 0 : cs; cs = cs > 48 ? 48 : cs;
    const int tokq = (R0 + qrow) * 64 + c;
    LAS float* bt = (LAS float*)(F.lds + BT_OFF);
    __syncthreads();
    for (int i = tid; i < 465; i += 512) bt[i] = rpb[h * 465 + i] * LOG2E;
    const bf16* Qb = (const bf16*)(F.ws + WS_Q); const bf16* Kb = (const bf16*)(F.ws + WS_K); const bf16* Vb = (const bf16*)(F.ws + WS_V);
    bf16x8 qf[8];
    { const bf16* qp = Qb + (size_t)tokq * AW + h * HD + 8 * hf;
#pragma unroll
      for (int s_ = 0; s_ < 8; ++s_) qf[s_] = *(const bf16x8*)(qp + 16 * s_); }
    f32x16 O[4];
#pragma unroll
    for (int d = 0; d < 4; ++d)
#pragma unroll
        for (int i = 0; i < 16; ++i) O[d][i] = 0.f;
    float mrun = -1e30f, lrun = 0.f;
    const int srow = tid >> 4, sch = tid & 15;
    const unsigned soff0 = 256 * srow + 16 * (sch ^ (((srow & 3) << 2) | ((srow >> 2) & 3)));
    const size_t gofs = (size_t)srow * AW + h * HD + sch * 8;
    const unsigned ka = 256 * j31 + 16 * (hf ^ (((j31 & 3) << 2) | ((j31 >> 2) & 3)));
    const int i16 = lane & 15, q4 = i16 >> 2, pp = i16 & 3, g1 = (lane >> 4) & 1;
    unsigned tbo[4][2];
#pragma unroll
    for (int d = 0; d < 4; ++d)
#pragma unroll
        for (int sec = 0; sec < 2; ++sec) { const int row_l = 4 * hf + 8 * sec + q4, swz = (q4 << 2) | ((hf + 2 * sec) & 3), ch = 4 * d + 2 * g1 + (pp >> 1);
            tbo[d][sec] = 16384 + 256 * row_l + 16 * (ch ^ swz) + 8 * (pp & 1); }
    const unsigned lbase = (unsigned)(uintptr_t)F.lds;
    u32x4 st[4];
    { const size_t gro = (size_t)((Rb + kr_lo) * 64) * AW + gofs;
      st[0] = *(const u32x4*)(Kb + gro); st[1] = *(const u32x4*)(Kb + gro + (size_t)32 * AW); st[2] = *(const u32x4*)(Vb + gro); st[3] = *(const u32x4*)(Vb + gro + (size_t)32 * AW); }
    *(LAS u32x4*)(F.lds + soff0) = st[0]; *(LAS u32x4*)(F.lds + soff0 + 8192) = st[1]; *(LAS u32x4*)(F.lds + 16384 + soff0) = st[2]; *(LAS u32x4*)(F.lds + 16384 + soff0 + 8192) = st[3];
    __syncthreads();
    for (int kr = kr_lo; kr <= kr_hi; ++kr) {
        const unsigned bofs = ((kr - kr_lo) & 1) * 32768u;
        if (kr < kr_hi) { const size_t gro = (size_t)((Rb + kr + 1) * 64) * AW + gofs;
            st[0] = *(const u32x4*)(Kb + gro); st[1] = *(const u32x4*)(Kb + gro + (size_t)32 * AW); st[2] = *(const u32x4*)(Vb + gro); st[3] = *(const u32x4*)(Vb + gro + (size_t)32 * AW); }
        if (kr >= rs && kr < rs + 8) {
            f32x16 sacc[2];
#pragma unroll
            for (int kt = 0; kt < 2; ++kt) {
#pragma unroll
                for (int i = 0; i < 16; ++i) sacc[kt][i] = 0.f;
#pragma unroll
                for (int s_ = 0; s_ < 8; ++s_) { const bf16x8 a = *(const LAS bf16x8*)(F.lds + bofs + 8192 * kt + (ka ^ (32u * s_))); sacc[kt] = MFMA32(a, qf[s_], sacc[kt]); } }
            const int dr = kr - r + 7;
            const LAS float* brow = bt + (dr * 31 + 15 - c + 4 * hf);
            float bv[2][16];
#pragma unroll
            for (int kt = 0; kt < 2; ++kt)
#pragma unroll
                for (int rg_ = 0; rg_ < 16; ++rg_) bv[kt][rg_] = brow[32 * kt + (rg_ & 3) + 8 * (rg_ >> 2)];
            float mloc = -1e30f;
#pragma unroll
            for (int kt = 0; kt < 2; ++kt)
#pragma unroll
                for (int rg_ = 0; rg_ < 16; ++rg_) { const int kc = 32 * kt + (rg_ & 3) + 8 * (rg_ >> 2) + 4 * hf;
                    const float sb = sacc[kt][rg_] + bv[kt][rg_];
                    const float sc = ((unsigned)(kc - cs) < 16u) ? sb : -1e30f;
                    sacc[kt][rg_] = sc; mloc = fmaxf(mloc, sc); }
            mloc = fmaxf(mloc, __shfl_xor(mloc, 32));
            const float mnew = fmaxf(mrun, mloc), alpha = __builtin_amdgcn_exp2f(mrun - mnew); mrun = mnew;
            float psum = 0.f;
#pragma unroll
            for (int kt = 0; kt < 2; ++kt)
#pragma unroll
                for (int rg_ = 0; rg_ < 16; ++rg_) { const float p = __builtin_amdgcn_exp2f(sacc[kt][rg_] - mnew); sacc[kt][rg_] = p; psum += p; }
            lrun = lrun * alpha + psum;
#pragma unroll
            for (int d = 0; d < 4; ++d)
#pragma unroll
                for (int i = 0; i < 16; ++i) O[d][i] *= alpha;
            bf16x8 pb[2][2];
#pragma unroll
            for (int kt = 0; kt < 2; ++kt)
#pragma unroll
                for (int s2 = 0; s2 < 2; ++s2) { u32x4 w; w.x = cvt_pk_bf16(sacc[kt][8 * s2], sacc[kt][8 * s2 + 1]); w.y = cvt_pk_bf16(sacc[kt][8 * s2 + 2], sacc[kt][8 * s2 + 3]);
                    w.z = cvt_pk_bf16(sacc[kt][8 * s2 + 4], sacc[kt][8 * s2 + 5]); w.w = cvt_pk_bf16(sacc[kt][8 * s2 + 6], sacc[kt][8 * s2 + 7]); pb[kt][s2] = __builtin_bit_cast(bf16x8, w); }
#pragma unroll
            for (int d = 0; d < 4; ++d) { s16x4 f0, f1, f2, f3, f4, f5, f6, f7; const unsigned a0 = lbase + bofs + tbo[d][0], a1 = lbase + bofs + tbo[d][1];
                asm volatile("ds_read_b64_tr_b16 %0, %8\n\tds_read_b64_tr_b16 %1, %9\n\tds_read_b64_tr_b16 %2, %8 offset:4096\n\tds_read_b64_tr_b16 %3, %9 offset:4096\n\t"
                             "ds_read_b64_tr_b16 %4, %8 offset:8192\n\tds_read_b64_tr_b16 %5, %9 offset:8192\n\tds_read_b64_tr_b16 %6, %8 offset:12288\n\tds_read_b64_tr_b16 %7, %9 offset:12288\n\ts_waitcnt lgkmcnt(0)"
                             : "=&v"(f0), "=&v"(f1), "=&v"(f2), "=&v"(f3), "=&v"(f4), "=&v"(f5), "=&v"(f6), "=&v"(f7) : "v"(a0), "v"(a1) : "memory");
                O[d] = MFMA32(__builtin_shufflevector(f0, f1, 0, 1, 2, 3, 4, 5, 6, 7), pb[0][0], O[d]);
                O[d] = MFMA32(__builtin_shufflevector(f2, f3, 0, 1, 2, 3, 4, 5, 6, 7), pb[0][1], O[d]);
                O[d] = MFMA32(__builtin_shufflevector(f4, f5, 0, 1, 2, 3, 4, 5, 6, 7), pb[1][0], O[d]);
                O[d] = MFMA32(__builtin_shufflevector(f6, f7, 0, 1, 2, 3, 4, 5, 6, 7), pb[1][1], O[d]); }
        }
        if (kr < kr_hi) { const unsigned nb = bofs ^ 32768u;
            *(LAS u32x4*)(F.lds + nb + soff0) = st[0]; *(LAS u32x4*)(F.lds + nb + soff0 + 8192) = st[1]; *(LAS u32x4*)(F.lds + nb + 16384 + soff0) = st[2]; *(LAS u32x4*)(F.lds + nb + 16384 + soff0 + 8192) = st[3]; }
        __syncthreads();
    }
    const float inv = 1.0f / (lrun + __shfl_xor(lrun, 32));
    bf16* op = (bf16*)(F.ws + WS_XB) + (size_t)tokq * D + h * HD + 4 * hf;
    float ssq = 0.f;
#pragma unroll
    for (int d = 0; d < 4; ++d)
#pragma unroll
        for (int q = 0; q < 4; ++q) { const float o0 = O[d][4 * q] * inv, o1 = O[d][4 * q + 1] * inv, o2 = O[d][4 * q + 2] * inv, o3 = O[d][4 * q + 3] * inv;
            ssq += (o0 * o0 + o1 * o1) + (o2 * o2 + o3 * o3);
            u32x2 w; w.x = cvt_pk_bf16(o0, o1); w.y = cvt_pk_bf16(o2, o3); *(u32x2*)(op + 32 * d + 8 * q) = w; }
    ssq += __shfl_xor(ssq, 32);
    if (hf == 0) ((float*)(F.ws + WS_PSATT))[(size_t)tokq * 16 + h] = ssq;
}

__global__ void __launch_bounds__(NWAVES * 64, 2) fwd_kernel(Args args) {
    extern __shared__ __attribute__((aligned(16))) unsigned char lds_raw[];
    Frame F;
    F.lds = (LAS unsigned char*)lds_raw;
    F.wave = __builtin_amdgcn_readfirstlane((int)threadIdx.x >> 6); F.lane = lane_op(); F.tid = F.wave * 64 + F.lane;
    F.G = gridDim.x; F.gw = blockIdx.x * NWAVES + F.wave; F.NGW = F.G * NWAVES;
    F.out = args.out; F.ws = args.ws;
    unsigned char* ws = args.ws;
    volatile LAS unsigned* MISC = (volatile LAS unsigned*)(F.lds + MISC_OFF);
    for (int u = F.tid; u < (LDS_BYTES - RING_BYTES) / 4; u += NWAVES * 64) ((LAS unsigned*)(F.lds + RING_BYTES))[u] = 0u;
    __syncthreads();
    XcdBarrier bar = xcd_barrier_post((unsigned*)(ws + WS_CTL) + CW_BAR, MISC + 8, F.wave);
    const int lo = args.ph_lo, hi = args.ph_hi;
#define IN(k) (lo <= (k) && (k) < hi)
#define PH_BEGIN() do { F.lane = lane_op(); F.tid = F.wave * 64 + F.lane; } while (0)
#define SEAM(k) do { if (IN(k) && IN((k) + 1)) xcd_barrier(bar); } while (0)

    bf16* XB = (bf16*)(ws + WS_XB);
    float* rstd0 = (float*)(ws + WS_RSTD0); float* rstd1 = (float*)(ws + WS_RSTD1); float* rstd2 = (float*)(ws + WS_RSTD2);
    float* ratio = (float*)(ws + WS_RATIO); float* rsssm = (float*)(ws + WS_RSSSM);
    float* psatt = (float*)(ws + WS_PSATT); float* psssm = (float*)(ws + WS_PSSSM); float* psmix = (float*)(ws + WS_PSMIX); float* psm = (float*)(ws + WS_PSM);
    LAS float* scr = (LAS float*)(F.lds + F.wave * 16384);

    if (IN(0)) { PH_BEGIN();
        for (int g = blockIdx.x; g < NG; g += F.G) ssm_tables(F, g);
        constexpr int I_IN = (D / 64) * (NIN / 64), I_GLU = (AW / 64) * (AW / 64), I_OUT = (D / 64) * (D / 64);
        { const float* w_in = ARGP(5); const float* g_pre = ARGP(4); const float* w_glu = ARGP(22); const float* w_out = ARGP(26); const float* g_att = ARGP(24); const float* g_ssm = ARGP(25);
        for (int it = F.gw; it < I_IN + I_GLU + I_OUT; it += F.NGW) {
            int r = it;
            if (r < I_IN) { transpose_item(w_in, D, NIN, (bf16*)(ws + WS_WIN), g_pre, AW, QSCALE, scr, r, F.lane); continue; } r -= I_IN;
            if (r < I_GLU) { transpose_item(w_glu, AW, AW, (bf16*)(ws + WS_WGLU), nullptr, 0, 1.f, scr, r, F.lane); continue; } r -= I_GLU;
            {
                const int nblk = D / 64, kb = r / nblk; const int k0 = 64 * kb;
                const float* gk = k0 < AW ? g_att : g_ssm - AW;
                transpose_item(w_out, D, D, (bf16*)(ws + WS_WOUT), gk, 0, 1.f, scr, r, F.lane); }
        } }
        { const float* xp = ARGP(0); const float* xs = ARGP(1);
        for (int m = F.gw; m < T; m += F.NGW) xb_row(F, xp, xs, m); }
        const float* pep = ARGP(2); const float* pes = ARGP(3);
        for (int i = F.gw * 64 + F.lane; i < T * PLE / 4; i += F.NGW * 64) { const int m = i / (PLE / 4), c4 = i % (PLE / 4);
            const f32x4 v = ((const f32x4*)perow(pep, pes, m))[c4]; u32x2 w; w.x = cvt_pk_bf16(v[0], v[1]); w.y = cvt_pk_bf16(v[2], v[3]);
            ((u32x2*)(ws + WS_PEB))[i] = w; }
    }
    SEAM(0);
    if (IN(1)) { PH_BEGIN();
        pg8::Gemm g{XB, (const bf16*)(ws + WS_WIN), T, NIN, D, F.wave}; pg8::StaticOrder S; S.init(T, NIN, F.G, (int)blockIdx.x);
        pg8::EpiProj E{(bf16*)(ws + WS_Q), (bf16*)(ws + WS_UG), rstd0};
        pg8::gemm_phase<pg8::EpiProj, pg8::StaticOrder, true, true>(F.lds, g, S, E);
    }
    SEAM(1);
    if (IN(2)) { PH_BEGIN();
        for (int unit = blockIdx.x; unit < 768; unit += F.G) ssm_stage_a(F, unit);
        const float* rpb = ARGP(6);
        for (int unit = blockIdx.x; unit < 1536; unit += F.G) attn_unit2(F, rpb, unit);
    }
    SEAM(2);
    if (IN(3)) { PH_BEGIN();
        for (int task = F.wave * F.G + blockIdx.x; task < 768; task += F.NGW) { if (task & 1) ssm_scan_task<1>(F, task); else ssm_scan_task<0>(F, task); }
    }
    SEAM(3);
    if (IN(4)) { PH_BEGIN();
        for (int unit = blockIdx.x; unit < 1536; unit += F.G) ssm_stage_c(F, unit);
    }
    SEAM(4);
    if (IN(5)) { PH_BEGIN();
        pg8::Gemm g{(const bf16*)(ws + WS_Z), (const bf16*)(ws + WS_WGLU), T, AW, AW, F.wave}; pg8::StaticOrder S; S.init(T, AW, F.G, (int)blockIdx.x);
        pg8::EpiGlu E{(const bf16*)(ws + WS_Z), XB, ARGP(23), psssm};
        pg8::gemm_phase<pg8::EpiGlu, pg8::StaticOrder, true, true>(F.lds, g, S, E);
    }
    SEAM(5);
    if (IN(6)) { PH_BEGIN();
        for (int m = blockIdx.x * 512 + F.tid; m < T; m += F.G * 512) {
            float sa = 0.f, ss = 0.f;
#pragma unroll
            for (int j = 0; j < 4; ++j) { const f32x4 v = ((const f32x4*)(psatt + (size_t)m * 16))[j]; sa += (v[0] + v[1]) + (v[2] + v[3]); }
#pragma unroll
            for (int j = 0; j < 8; ++j) { const f32x4 v = ((const f32x4*)(psssm + (size_t)m * 32))[j]; ss += (v[0] + v[1]) + (v[2] + v[3]); }
            const float ra = 1.0f / sqrtf(sa * (1.0f / AW) + RMS_EPS), rs = 1.0f / sqrtf(ss * (1.0f / AW) + RMS_EPS);
            ratio[m] = ra / rs; rsssm[m] = rs; }
    }
    SEAM(6);
    if (IN(7)) { PH_BEGIN();
        pg8::Gemm g{XB, (const bf16*)(ws + WS_WOUT), T, D, D, F.wave}; pg8::StaticOrder S; S.init(T, D, F.G, (int)blockIdx.x);
        pg8::EpiOut E{(bf16*)(ws + WS_MIX), ratio, rsssm, psmix};
        pg8::gemm_phase<pg8::EpiOut, pg8::StaticOrder, true, true>(F.lds, g, S, E);
    }
    SEAM(7);
    if (IN(8)) { PH_BEGIN();
        { const float* xp = ARGP(0); const float* xs = ARGP(1); const float* gpm = ARGP(27);
        for (int m = F.gw; m < T; m += F.NGW)
            row_pass(F, xrow(xp, xs, m), (const bf16*)(ws + WS_MIX) + (size_t)m * D, psmix + (size_t)m * 64, gpm, F.out + (size_t)m * D, XB + (size_t)m * D, rstd1 + m); }
        constexpr int I_UP = (D / 64) * (DFF / 64), I_DN = (DFF / 64) * (D / 64), I_GT = (D / 64) * (D / 64), I_PL = (PLE / 64) * (D / 64);
        const float* w_up = ARGP(29); const float* g_mlp = ARGP(28); const float* w_dn = ARGP(30); const float* w_gt = ARGP(33); const float* g_pl = ARGP(32); const float* w_pl = ARGP(34);
        for (int it = F.gw; it < I_UP + I_DN + I_GT + I_PL; it += F.NGW) {
            int r = it;
            if (r < I_UP) { transpose_item(w_up, D, DFF, (bf16*)(ws + WS_WUP), g_mlp, 0, 1.f, scr, r, F.lane); continue; } r -= I_UP;
            if (r < I_DN) { transpose_item(w_dn, DFF, D, (bf16*)(ws + WS_WDOWN), nullptr, 0, 1.f, scr, r, F.lane); continue; } r -= I_DN;
            if (r < I_GT) { transpose_item(w_gt, D, D, (bf16*)(ws + WS_WGATE), g_pl, 0, 1.f, scr, r, F.lane); continue; } r -= I_GT;
            transpose_item(w_pl, PLE, D, (bf16*)(ws + WS_WPLE), nullptr, 0, 1.f, scr, r, F.lane);
        }
    }
    SEAM(8);
    for (int ch = 0; ch < NCHUNK; ++ch) {
        const int row_off = ch * MCHUNK;
        if (IN(9 + 3 * ch)) { PH_BEGIN();
            pg8::Gemm g{XB + (size_t)row_off * D, (const bf16*)(ws + WS_WUP), MCHUNK, DFF, D, F.wave}; pg8::StaticOrder S; S.init(MCHUNK, DFF, F.G, (int)blockIdx.x);
            pg8::EpiUp E{(bf16*)(ws + WS_HBUF), rstd1, row_off};
            pg8::gemm_phase<pg8::EpiUp, pg8::StaticOrder, true, true>(F.lds, g, S, E);
        }
        SEAM(9 + 3 * ch);
        if (IN(10 + 3 * ch)) { PH_BEGIN();
            pg8::Gemm g{(const bf16*)(ws + WS_HBUF), (const bf16*)(ws + WS_WDOWN), MCHUNK, D, DFF, F.wave}; pg8::StaticOrder S; S.init(MCHUNK, D, F.G, (int)blockIdx.x);
            pg8::EpiDown E{(bf16*)(ws + WS_MCH), psm, row_off};
            pg8::gemm_phase<pg8::EpiDown, pg8::StaticOrder, true, true>(F.lds, g, S, E);
        }
        SEAM(10 + 3 * ch);
        if (IN(11 + 3 * ch)) { PH_BEGIN();
            const float* gpl = ARGP(31);
            for (int ml = F.gw; ml < MCHUNK; ml += F.NGW) { const int m = row_off + ml;
                row_pass(F, F.out + (size_t)m * D, (const bf16*)(ws + WS_MCH) + (size_t)ml * D, psm + (size_t)m * 64, gpl, F.out + (size_t)m * D, XB + (size_t)m * D, rstd2 + m); }
        }
        SEAM(11 + 3 * ch);
    }
    if (IN(18)) { PH_BEGIN();
        pg8::Gemm g{(const bf16*)(ws + WS_PEB), (const bf16*)(ws + WS_WPLE), T, D, PLE, F.wave}; pg8::StaticOrder S; S.init(T, D, F.G, (int)blockIdx.x);
        pg8::EpiPle E{(bf16*)(ws + WS_PP)};
        pg8::gemm_phase<pg8::EpiPle, pg8::StaticOrder, true, true>(F.lds, g, S, E);
    }
    SEAM(18);
    if (IN(19)) { PH_BEGIN();
        pg8::Gemm g{XB, (const bf16*)(ws + WS_WGATE), T, D, D, F.wave}; pg8::StaticOrder S; S.init(T, D, F.G, (int)blockIdx.x);
        pg8::EpiGate E{F.out, (const bf16*)(ws + WS_PP), rstd2};
        pg8::gemm_phase<pg8::EpiGate, pg8::StaticOrder, true, true>(F.lds, g, S, E);
    }
#undef IN
#undef SEAM
}

constexpr int N_PHASES = 20;
#ifndef MK_PER_PHASE
#define MK_PER_PHASE 0
#endif
extern "C" void kernel_launch(void* const* d_in, const int* in_sizes, int n_in, void* d_out, int out_size, void* d_ws, size_t ws_size, hipStream_t stream) {
    static int grid = 0;
    if (grid == 0) {
        if (n_in != 35 || out_size != T * D || ws_size < WS_END) { fprintf(stderr, "kernel_launch: unexpected problem (n_in %d, out %d, ws %zu)\n", n_in, out_size, ws_size); grid = -1; return; }
        int dev = 0, cus = 0;
        if (hipGetDevice(&dev) != hipSuccess || hipDeviceGetAttribute(&cus, hipDeviceAttributeMultiprocessorCount, dev) != hipSuccess) { grid = -1; return; }
        if (hipFuncSetAttribute((const void*)fwd_kernel, hipFuncAttributeMaxDynamicSharedMemorySize, LDS_BYTES) != hipSuccess) { fprintf(stderr, "kernel_launch: hipFuncSetAttribute failed\n"); grid = -1; return; }
        int per_cu = 0;
        if (hipOccupancyMaxActiveBlocksPerMultiprocessor(&per_cu, (const void*)fwd_kernel, NWAVES * 64, LDS_BYTES) != hipSuccess || per_cu < 1) fprintf(stderr, "kernel_launch: occupancy query reports %d\n", per_cu);
        (void)hipGetLastError();
        grid = cus;
    }
    if (grid < 0) return;
    (void)hipMemsetAsync((char*)d_ws + WS_CTL, 0, CTL_ZERO_BYTES, stream);
    Args a{};
    for (int i = 0; i < 35; ++i) a.in[i] = (const float*)d_in[i];
    a.out = (float*)d_out; a.ws = (unsigned char*)d_ws;
#if MK_PER_PHASE
    for (int p = 0; p < N_PHASES; ++p) { a.ph_lo = p; a.ph_hi = p + 1; hipLaunchKernelGGL(fwd_kernel, dim3(grid), dim3(NWAVES * 64), LDS_BYTES, stream, a); }
#else
    a.ph_lo = 0; a.ph_hi = N_PHASES;
    hipLaunchKernelGGL(fwd_kernel, dim3(grid), dim3(NWAVES * 64), LDS_BYTES, stream, a);
#endif
}
```

```cpp
#include <hip/hip_runtime.h>
#include <cstdio>
#include <cstdint>

#define GAS __attribute__((address_space(1)))
#define LAS __attribute__((address_space(3)))
typedef unsigned short bf16;
typedef short bf16x8 __attribute__((ext_vector_type(8)));
typedef float f32x4 __attribute__((ext_vector_type(4)));
typedef float f32x2 __attribute__((ext_vector_type(2)));
typedef unsigned u32x4 __attribute__((ext_vector_type(4)));
typedef unsigned u32x2 __attribute__((ext_vector_type(2)));

constexpr int T = 24576, TPR = 8192, D = 4096, AW = 2048, NH = 16, HD = 128, NG = 128, SP = 64, DFF = 16384, PLE = 256, NIN = 8192;
constexpr float RMS_EPS = 1e-6f;
constexpr float LOG2E = 1.4426950408889634f;
constexpr float QSCALE = 0.08838834764831845f * 1.4426950408889634f;

constexpr size_t MiB = 1u << 20;
constexpr size_t WS_CTL = 0, CTL_ZERO_BYTES = 1 * MiB;
constexpr size_t WS_RSTD0 = 1 * MiB, WS_RSTD1 = WS_RSTD0 + 128 * 1024, WS_RSTD2 = WS_RSTD1 + 128 * 1024, WS_RATIO = WS_RSTD2 + 128 * 1024, WS_RSSSM = WS_RATIO + 128 * 1024;
constexpr size_t WS_PSATT = 2 * MiB, WS_PSSSM = 4 * MiB, WS_PSMIX = 8 * MiB, WS_PSM = 8 * MiB;
constexpr size_t WS_PEB = 24 * MiB;
constexpr size_t WS_KTAB = 14 * MiB, WS_MC = 40 * MiB, WS_MB = 72 * MiB;
constexpr size_t WS_WIN = 104 * MiB, WS_WGLU = 168 * MiB, WS_WOUT = 176 * MiB;
constexpr size_t WS_XB = 208 * MiB;
constexpr size_t WS_Q = 400 * MiB, WS_K = 496 * MiB, WS_V = 592 * MiB, WS_UG = 688 * MiB, WS_Z = 784 * MiB, WS_S = 880 * MiB, WS_HB = 976 * MiB;
constexpr size_t WS_WUP = 400 * MiB, WS_WDOWN = 528 * MiB, WS_WGATE = 656 * MiB, WS_WPLE = 688 * MiB;
constexpr size_t WS_HBUF = 692 * MiB;
constexpr size_t WS_MCH = 36 * MiB;
constexpr size_t WS_PP = 692 * MiB;
constexpr size_t WS_MIX = 692 * MiB;
constexpr size_t WS_ZF8 = 880 * MiB;
constexpr size_t WS_HQ = 104 * MiB;
constexpr float WGLU_SCALE = 64.f;
constexpr size_t WS_END = 1024 * MiB;
constexpr int MCHUNK = 8192, NCHUNK = T / MCHUNK;

constexpr int CW_BAR = 4096;
constexpr int N_PHASES_K = 20;
constexpr int CW_CMAXD = 53248, CW_CSUMD = 57344, CW_RMAXH = 65536;
constexpr int CW_CMAXU = 32768, CW_CMAXG = 49152;
constexpr int CW_RANK = 8192;

constexpr int RING_BYTES = 131072;
constexpr int MISC_OFF = RING_BYTES + 320;
constexpr int LDS_BYTES = 147456;
constexpr int NWAVES = 8;

__device__ __forceinline__ unsigned cvt_pk_bf16(float lo, float hi) { unsigned r; asm volatile("v_cvt_pk_bf16_f32 %0, %1, %2" : "=v"(r) : "v"(lo), "v"(hi)); return r; }
__device__ __forceinline__ float bf_lo(unsigned v) { return __builtin_bit_cast(float, v << 16); }
__device__ __forceinline__ float bf_hi(unsigned v) { return __builtin_bit_cast(float, v & 0xffff0000u); }
__device__ __forceinline__ float wave_sum(float v) {
#pragma unroll
    for (int o = 1; o < 64; o <<= 1) v += __shfl_xor(v, o);
    return v;
}
__device__ __forceinline__ float wave_max(float v) {
#pragma unroll
    for (int o = 1; o < 64; o <<= 1) v = fmaxf(v, __shfl_xor(v, o));
    return v;
}
__device__ __forceinline__ int lane_id() { return (int)__builtin_amdgcn_mbcnt_hi(~0u, __builtin_amdgcn_mbcnt_lo(~0u, 0u)); }
__device__ __forceinline__ int lane_op() { int l = lane_id(); asm volatile("" : "+v"(l)); return l; }
__device__ __forceinline__ unsigned pack4_i8(float a, float b, float c, float d) {
    const int q0 = (int)__builtin_rintf(a), q1 = (int)__builtin_rintf(b), q2 = (int)__builtin_rintf(c), q3 = (int)__builtin_rintf(d);
    return ((unsigned)q0 & 0xFFu) | (((unsigned)q1 & 0xFFu) << 8) | (((unsigned)q2 & 0xFFu) << 16) | ((unsigned)q3 << 24);
}
__device__ __forceinline__ unsigned pack4_i8s(float a, float b, float c, float d, int& sum) {
    const int q0 = (int)__builtin_rintf(a), q1 = (int)__builtin_rintf(b), q2 = (int)__builtin_rintf(c), q3 = (int)__builtin_rintf(d); sum += (q0 + q1) + (q2 + q3);
    return ((unsigned)q0 & 0xFFu) | (((unsigned)q1 & 0xFFu) << 8) | (((unsigned)q2 & 0xFFu) << 16) | ((unsigned)q3 << 24);
}
__device__ __forceinline__ unsigned pack4_fp8(float a, float b, float c, float d) { int p = 0; p = __builtin_amdgcn_cvt_pk_fp8_f32(a, b, p, false); p = __builtin_amdgcn_cvt_pk_fp8_f32(c, d, p, true); return (unsigned)p; }
__device__ __forceinline__ float sigmoidf_(float x) { return __builtin_amdgcn_rcpf(1.0f + __builtin_amdgcn_exp2f(x * -1.4426950408889634f)); }
__device__ __forceinline__ float gelu_tanh(float x) { const float a = (1.5957691216057308f * -1.4426950408889634f) * (x + 0.044715f * x * x * x); return x * __builtin_amdgcn_rcpf(1.0f + __builtin_amdgcn_exp2f(a)); }

namespace pg8 {
#define PG8_LAS __attribute__((address_space(3)))
typedef unsigned short bf16_t;
typedef int v4i_t __attribute__((ext_vector_type(4)));
constexpr int BM = 256, BK = 64, HALF = 128, HTB = HALF * BK * 2, STAGE_BYTES = 8 * HTB, NXCD = 8, WGM = 8;
__host__ __device__ __forceinline__ int lds_byte(int r, int c) { const int st = (r >> 4) * 2 + (c >> 5), rr = r & 15, cc = c & 31, ob = rr * 64 + cc * 2; return st * 1024 + (ob ^ (((ob >> 9) & 1) << 5)); }
__host__ __device__ __forceinline__ void stage_rc(int b, int& R, int& C) { const int st = b / 1024, sb = b % 1024, swz = sb ^ (((sb >> 9) & 1) << 5); R = (st >> 1) * 16 + swz / 64; C = (st & 1) * 32 + (swz % 64) / 2; }
__host__ __device__ __forceinline__ int perm32(int rho) { const int n = rho >> 4, i = rho & 15; return 8 * (i >> 2) + 4 * n + (i & 3); }
struct Unit { int pm, pn; };
struct Gemm { const bf16_t* A; const bf16_t* Bt; int M, N, K, wave, lda; };
struct StaticOrder {
    int nM, nN, nwg, G, c;
    __host__ __device__ void init(int M, int N, int G_, int c_) { nM = M / BM; nN = N / BM; nwg = nM * nN; G = G_; c = c_; }
    __host__ __device__ bool next(int i, Unit& u) const {
        const long L = (long)i * G + c; if (L >= nwg) return false;
        int wgid = (int)L; { const int q = nwg / NXCD, r = nwg % NXCD, xcd = wgid % NXCD, off = wgid / NXCD; wgid = (xcd < r ? xcd * (q + 1) : r * (q + 1) + (xcd - r) * q) + off; }
        const int nig = WGM * nN, gid = wgid / nig, fm = gid * WGM, gsz = (nM - fm) < WGM ? (nM - fm) : WGM;
        u.pm = fm + ((wgid % nig) % gsz); u.pn = (wgid % nig) / gsz; return true;
    }
    __device__ __forceinline__ void a_ready(const Unit&) const {}
    __device__ __forceinline__ void done(const Unit&) const {}
};

template <class Epi, class Sched, bool ALIGN_EPI = false, bool SP2 = false, int MODE = 0  >
__device__ __forceinline__ void gemm_phase(PG8_LAS unsigned char* lds, const Gemm g, const Sched& S, const Epi& E) {
    const int lane = lane_op(), wid = g.wave, tid = wid * 64 + lane, wr = wid >> 2, wc = wid & 3, fr = lane & 15, fq = lane >> 4;
    const int K = g.K, nt = K / BK, LDA = g.lda ? g.lda : g.K;
    unsigned voffA[2], voffB[2];
#pragma unroll
    for (int i = 0; i < 2; ++i) { int R, C; stage_rc(tid * 16 + i * 8192, R, C); const int Rb = Epi::PERM ? ((R & ~31) + perm32(R & 31)) : R;
        voffA[i] = (unsigned)(R * LDA + C) * 2u; voffB[i] = (unsigned)(Rb * K + C) * 2u; }
    const size_t kstep = (size_t)(BK * 2);
    const size_t hstep = (size_t)HALF * K * 2, hstepA = (size_t)HALF * LDA * 2;
    const size_t tstep = 2 * hstep, tstepA = 2 * hstepA;
    const unsigned ldsw = (unsigned)wid * 1024u;
    const int aoff = lds_byte(wr * 64 + fr, fq * 8), boff = lds_byte(wc * 32 + fr, fq * 8);
#define PG8_SA(b, h) (((b) * 2 + (h)) * HTB)
#define PG8_SB(b, h) ((4 + (b) * 2 + (h)) * HTB)
#define PG8_STAGE(bufoff, gbase, voff) do { _Pragma("unroll") for (int _i = 0; _i < 2; ++_i) \
        __builtin_amdgcn_global_load_lds((const unsigned*)((const char*)(gbase) + (voff)[_i]), (PG8_LAS unsigned*)(lds + (bufoff) + ldsw + _i * 8192), 16, 0, 0); } while (0)
#define PG8_LDA(dst, b, h) do { _Pragma("unroll") for (int m = 0; m < 4; ++m) _Pragma("unroll") for (int k = 0; k < 2; ++k) dst[m][k] = *(const PG8_LAS bf16x8*)(lds + PG8_SA(b, h) + aoff + m * 2048 + k * 1024); } while (0)
#define PG8_LDB(dst, b, h) do { _Pragma("unroll") for (int n = 0; n < 2; ++n) _Pragma("unroll") for (int k = 0; k < 2; ++k) dst[n][k] = *(const PG8_LAS bf16x8*)(lds + PG8_SB(b, h) + boff + n * 2048 + k * 1024); } while (0)
#define PG8_CAT(x0, x1) __builtin_shufflevector(__builtin_bit_cast(v4i_t, x0), __builtin_bit_cast(v4i_t, x1), 0, 1, 2, 3, 4, 5, 6, 7)
#define PG8_MMA(ai, bj, At, Bt) do { __builtin_amdgcn_s_setprio(1); \
        if constexpr (MODE == 2) { _Pragma("unroll") for (int m = 0; m < 4; ++m) _Pragma("unroll") for (int n = 0; n < 2; ++n) _Pragma("unroll") for (int k = 0; k < 2; ++k) \
            acc[ai][bj][m][n] = __builtin_bit_cast(f32x4, __builtin_amdgcn_mfma_i32_16x16x64_i8(__builtin_bit_cast(v4i_t, Bt[n][k]), __builtin_bit_cast(v4i_t, At[m][k]), __builtin_bit_cast(v4i_t, acc[ai][bj][m][n]), 0, 0, 0)); } \
        else if constexpr (MODE == 1) { _Pragma("unroll") for (int m = 0; m < 4; ++m) _Pragma("unroll") for (int n = 0; n < 2; ++n) \
            asm volatile("v_mfma_scale_f32_16x16x128_f8f6f4 %0, %1, %2, %0, %3, %3 op_sel_hi:[0,0,0]" : "+v"(acc[ai][bj][m][n]) : "v"(PG8_CAT(Bt[n][0], Bt[n][1])), "v"(PG8_CAT(At[m][0], At[m][1])), "v"(f8scale)); } \
        else { _Pragma("unroll") for (int m = 0; m < 4; ++m) _Pragma("unroll") for (int n = 0; n < 2; ++n) _Pragma("unroll") for (int k = 0; k < 2; ++k) \
            acc[ai][bj][m][n] = __builtin_amdgcn_mfma_f32_16x16x32_bf16(Bt[n][k], At[m][k], acc[ai][bj][m][n], 0, 0, 0); } \
        __builtin_amdgcn_s_setprio(0); } while (0)
#define PG8_WAIT_V(n) asm volatile("s_waitcnt vmcnt(" #n ")" ::: "memory")
#define PG8_WAIT_L(n) asm volatile("s_waitcnt lgkmcnt(" #n ")" ::: "memory")
#define PG8_BAR __builtin_amdgcn_s_barrier()
#define PG8_SCHED __builtin_amdgcn_sched_barrier(0)
    Unit cur, nxt; int ui = 0;
    if (!S.next(0, cur)) return;
    f32x4 acc[2][2][4][2];
#pragma unroll
    for (int a = 0; a < 2; ++a)
#pragma unroll
        for (int b = 0; b < 2; ++b)
#pragma unroll
            for (int m = 0; m < 4; ++m)
#pragma unroll
                for (int n = 0; n < 2; ++n) acc[a][b][m][n] = (f32x4){0.f, 0.f, 0.f, 0.f};
    bf16x8 At[4][2], B0[2][2], B1[2][2];
    const int f8scale = 0x7F7F7F7F;
    const char* cA = (const char*)g.A + (size_t)cur.pm * tstepA; const char* cB = (const char*)g.Bt + (size_t)cur.pn * tstep;
    S.a_ready(cur);
    if constexpr (SP2) {
        PG8_STAGE(PG8_SB(0, 0), cB, voffB); PG8_STAGE(PG8_SB(0, 1), cB + hstep, voffB); PG8_STAGE(PG8_SA(0, 0), cA, voffA); PG8_STAGE(PG8_SA(0, 1), cA + hstepA, voffA);
        if (wr == 1) PG8_BAR;
        PG8_WAIT_V(2); PG8_BAR;
        PG8_STAGE(PG8_SB(1, 0), cB + kstep, voffB); PG8_STAGE(PG8_SA(1, 0), cA + kstep, voffA); PG8_STAGE(PG8_SB(1, 1), cB + hstep + kstep, voffB);
        PG8_WAIT_V(6); PG8_BAR;
    } else {
        PG8_STAGE(PG8_SB(0, 0), cB, voffB); PG8_STAGE(PG8_SA(0, 0), cA, voffA); PG8_STAGE(PG8_SB(0, 1), cB + hstep, voffB); PG8_STAGE(PG8_SA(0, 1), cA + hstepA, voffA);
        if (wr == 1) PG8_BAR;
        PG8_WAIT_V(4); PG8_BAR;
        PG8_STAGE(PG8_SB(1, 0), cB + kstep, voffB); PG8_STAGE(PG8_SA(1, 0), cA + kstep, voffA); PG8_STAGE(PG8_SB(1, 1), cB + hstep + kstep, voffB);
        PG8_WAIT_V(6); PG8_BAR;
    }
    for (;;) {
        const bool has_next = S.next(ui + 1, nxt);
        const char* nA = has_next ? (const char*)g.A + (size_t)nxt.pm * tstepA : cA; const char* nB = has_next ? (const char*)g.Bt + (size_t)nxt.pn * tstep : cB;
#pragma nounroll
        for (int t = 0; t < nt; t += 2) {
            const bool last = (t == nt - 2);
            const char* a1 = cA + (size_t)(t + 1) * kstep;
            const char* a2 = last ? nA : cA + (size_t)(t + 2) * kstep; const char* b2 = last ? nB : cB + (size_t)(t + 2) * kstep;
            const char* a3 = a2 + kstep; const char* b3 = b2 + kstep;
            if (last && has_next) S.a_ready(nxt);
            if constexpr (Epi::MIDK) { if (t == (nt >> 1)) E.midk(acc, cur, wr, wc, fr, fq); }
            if constexpr (SP2) {
            PG8_LDB(B0, 0, 0); PG8_LDB(B1, 0, 1); PG8_SCHED; PG8_LDA(At, 0, 0); PG8_STAGE(PG8_SA(1, 1), a1 + hstepA, voffA);
            PG8_WAIT_V(8); PG8_WAIT_L(0); PG8_BAR; PG8_MMA(0, 0, At, B0); PG8_MMA(0, 1, At, B1); PG8_BAR; PG8_SCHED;
            PG8_LDA(At, 0, 1); PG8_STAGE(PG8_SB(0, 0), b2, voffB); PG8_STAGE(PG8_SB(0, 1), b2 + hstep, voffB); PG8_STAGE(PG8_SA(0, 0), a2, voffA);
            PG8_WAIT_V(8); PG8_WAIT_L(0); PG8_BAR; PG8_MMA(1, 0, At, B0); PG8_MMA(1, 1, At, B1); PG8_BAR; PG8_SCHED;
            PG8_LDB(B0, 1, 0); PG8_LDB(B1, 1, 1); PG8_SCHED; PG8_LDA(At, 1, 0); PG8_STAGE(PG8_SA(0, 1), a2 + hstepA, voffA);
            PG8_WAIT_V(8); PG8_WAIT_L(0); PG8_BAR; PG8_MMA(0, 0, At, B0); PG8_MMA(0, 1, At, B1); PG8_BAR; PG8_SCHED;
            PG8_LDA(At, 1, 1); PG8_STAGE(PG8_SB(1, 0), b3, voffB); PG8_STAGE(PG8_SB(1, 1), b3 + hstep, voffB); PG8_STAGE(PG8_SA(1, 0), a3, voffA);
            PG8_WAIT_V(8); PG8_WAIT_L(0); PG8_BAR; PG8_MMA(1, 0, At, B0); PG8_MMA(1, 1, At, B1); PG8_BAR; PG8_SCHED;
            } else {
            PG8_LDB(B0, 0, 0); PG8_SCHED; PG8_LDA(At, 0, 0); PG8_STAGE(PG8_SA(1, 1), a1 + hstepA, voffA);
            PG8_WAIT_L(8); PG8_BAR; PG8_WAIT_L(0); PG8_MMA(0, 0, At, B0); PG8_BAR; PG8_SCHED;
            PG8_LDB(B1, 0, 1); PG8_STAGE(PG8_SB(0, 0), b2, voffB);
            PG8_BAR; PG8_WAIT_L(0); PG8_MMA(0, 1, At, B1); PG8_BAR;
            PG8_LDA(At, 0, 1); PG8_STAGE(PG8_SA(0, 0), a2, voffA);
            PG8_BAR; PG8_WAIT_L(0); PG8_MMA(1, 0, At, B0); PG8_BAR; PG8_SCHED;
            PG8_STAGE(PG8_SB(0, 1), b2 + hstep, voffB);
            PG8_WAIT_V(6); PG8_BAR; PG8_MMA(1, 1, At, B1); PG8_BAR;
            PG8_LDB(B0, 1, 0); PG8_SCHED; PG8_LDA(At, 1, 0); PG8_STAGE(PG8_SA(0, 1), a2 + hstepA, voffA);
            PG8_WAIT_L(8); PG8_BAR; PG8_WAIT_L(0); PG8_MMA(0, 0, At, B0); PG8_BAR; PG8_SCHED;
            PG8_LDB(B1, 1, 1); PG8_STAGE(PG8_SB(1, 0), b3, voffB);
            PG8_BAR; PG8_WAIT_L(0); PG8_MMA(0, 1, At, B1); PG8_BAR;
            PG8_LDA(At, 1, 1); PG8_STAGE(PG8_SA(1, 0), a3, voffA);
            PG8_BAR; PG8_WAIT_L(0); PG8_MMA(1, 0, At, B0); PG8_BAR; PG8_SCHED;
            PG8_STAGE(PG8_SB(1, 1), b3 + hstep, voffB);
            PG8_WAIT_V(6); PG8_BAR; PG8_MMA(1, 1, At, B1); PG8_BAR;
            }
        }
        if constexpr (MODE == 1) asm volatile("s_nop 15\n\ts_nop 15" ::: "memory");
        if constexpr (ALIGN_EPI) { if (wr == 0) PG8_BAR; }
        E(acc, cur, wr, wc, fr, fq); S.done(cur);
        if (!has_next) break;
#pragma unroll
        for (int a = 0; a < 2; ++a)
#pragma unroll
            for (int b = 0; b < 2; ++b)
#pragma unroll
                for (int m = 0; m < 4; ++m)
#pragma unroll
                    for (int n = 0; n < 2; ++n) acc[a][b][m][n] = (f32x4){0.f, 0.f, 0.f, 0.f};
        cur = nxt; cA = nA; cB = nB; ++ui;
        if constexpr (ALIGN_EPI) { if (wr == 1) PG8_BAR; }
    }
    PG8_WAIT_V(0);
    if constexpr (!ALIGN_EPI) { if (wr == 0) PG8_BAR; }
    PG8_BAR;
#undef PG8_SA
#undef PG8_SB
#undef PG8_STAGE
#undef PG8_LDA
#undef PG8_LDB
#undef PG8_MMA
#undef PG8_CAT
#undef PG8_WAIT_V
#undef PG8_WAIT_L
#undef PG8_BAR
#undef PG8_SCHED
}

typedef f32x4 Acc[2][2][4][2];

struct EpiProj {
    static constexpr bool PERM = true, MIDK = false;
    bf16_t *Q, *Ug; const float* rstd;
    __device__ __forceinline__ void operator()(const Acc& acc, const Unit& u, int wr, int wc, int fr, int fq) const {
        const int row0 = u.pm * BM + wr * 64 + fr; const int t = u.pn >> 3;
        const int colt = (u.pn & 7) * BM + wc * 32 + 8 * fq;
        bf16_t* base = Q + (size_t)t * ((size_t)T * AW);
#pragma unroll
        for (int ai = 0; ai < 2; ++ai)
#pragma unroll
            for (int m = 0; m < 4; ++m) { const int row = row0 + ai * HALF + m * 16; const float rs = rstd[row];
#pragma unroll
                for (int bj = 0; bj < 2; ++bj) { const f32x4 v0 = acc[ai][bj][m][0] * rs, v1 = acc[ai][bj][m][1] * rs;
                    u32x4 w; w.x = cvt_pk_bf16(v0[0], v0[1]); w.y = cvt_pk_bf16(v0[2], v0[3]); w.z = cvt_pk_bf16(v1[0], v1[1]); w.w = cvt_pk_bf16(v1[2], v1[3]);
                    const int col = colt + bj * HALF;
                    if (t == 0) *(u32x4*)(base + (size_t)row * AW + col) = w;
                    else if (t < 3) *(u32x4*)(base + ((size_t)(col >> 7) * T + row) * HD + (col & 127)) = w;
                    else *(u32x4*)(Ug + ((size_t)(((col >> 4) * 24 + (row >> 10)) * 32 + (row & 31)) * 64 + ((row >> 5) & 31) + 4 * (col & 8)) * 8) = w; } }
    }
};
struct EpiGlu {
    static constexpr bool PERM = true, MIDK = false;
    const bf16_t* Z; bf16_t* cat; const float* bglu; float* ps; float ws_;
    __device__ __forceinline__ void operator()(const Acc& acc, const Unit& u, int wr, int wc, int fr, int fq) const {
        const int row0 = u.pm * BM + wr * 64 + fr; const int col0 = u.pn * BM + wc * 32 + 8 * fq;
        f32x4 bv[2][2];
#pragma unroll
        for (int bj = 0; bj < 2; ++bj)
#pragma unroll
            for (int n = 0; n < 2; ++n) bv[bj][n] = *(const f32x4*)(bglu + col0 + bj * HALF + 4 * n);
#pragma unroll
        for (int ai = 0; ai < 2; ++ai)
#pragma unroll
            for (int m = 0; m < 4; ++m) { const int row = row0 + ai * HALF + m * 16; float ssq = 0.f;
#pragma unroll
                for (int bj = 0; bj < 2; ++bj) { const int col = col0 + bj * HALF;
                    const u32x4 zr = *(const u32x4*)(Z + (size_t)row * AW + col);
                    const f32x4 a0 = acc[ai][bj][m][0] * ws_ + bv[bj][0], a1 = acc[ai][bj][m][1] * ws_ + bv[bj][1];
                    f32x4 s0, s1;
                    s0[0] = bf_lo(zr.x) * sigmoidf_(a0[0]); s0[1] = bf_hi(zr.x) * sigmoidf_(a0[1]); s0[2] = bf_lo(zr.y) * sigmoidf_(a0[2]); s0[3] = bf_hi(zr.y) * sigmoidf_(a0[3]);
                    s1[0] = bf_lo(zr.z) * sigmoidf_(a1[0]); s1[1] = bf_hi(zr.z) * sigmoidf_(a1[1]); s1[2] = bf_lo(zr.w) * sigmoidf_(a1[2]); s1[3] = bf_hi(zr.w) * sigmoidf_(a1[3]);
                    ssq += (s0[0] * s0[0] + s0[1] * s0[1]) + (s0[2] * s0[2] + s0[3] * s0[3]) + (s1[0] * s1[0] + s1[1] * s1[1]) + (s1[2] * s1[2] + s1[3] * s1[3]);
                    u32x4 w; w.x = cvt_pk_bf16(s0[0], s0[1]); w.y = cvt_pk_bf16(s0[2], s0[3]); w.z = cvt_pk_bf16(s1[0], s1[1]); w.w = cvt_pk_bf16(s1[2], s1[3]);
                    *(u32x4*)(cat + (size_t)row * D + AW + col) = w; }
                ssq += __shfl_xor(ssq, 16); ssq += __shfl_xor(ssq, 32);
                if (fq == 0) ps[(size_t)row * 32 + u.pn * 4 + wc] = ssq;
                asm volatile("" ::: "memory"); }
    }
};
struct EpiOut {
    static constexpr bool PERM = true, MIDK = true;
    bf16_t* out; const float* ratio; const float* rsssm; float* ps;
    __device__ __forceinline__ void midk(Acc& acc, const Unit& u, int wr, int wc, int fr, int fq) const {
        const int row0 = u.pm * BM + wr * 64 + fr;
#pragma unroll
        for (int ai = 0; ai < 2; ++ai)
#pragma unroll
            for (int m = 0; m < 4; ++m) { const float r = ratio[row0 + ai * HALF + m * 16];
#pragma unroll
                for (int bj = 0; bj < 2; ++bj)
#pragma unroll
                    for (int n = 0; n < 2; ++n) acc[ai][bj][m][n] = acc[ai][bj][m][n] * r; }
    }
    __device__ __forceinline__ void operator()(const Acc& acc, const Unit& u, int wr, int wc, int fr, int fq) const {
        const int row0 = u.pm * BM + wr * 64 + fr; const int col0 = u.pn * BM + wc * 32 + 8 * fq;
#pragma unroll
        for (int ai = 0; ai < 2; ++ai)
#pragma unroll
            for (int m = 0; m < 4; ++m) { const int row = row0 + ai * HALF + m * 16; const float rs = rsssm[row]; float ssq = 0.f;
#pragma unroll
                for (int bj = 0; bj < 2; ++bj) { const f32x4 v0 = acc[ai][bj][m][0] * rs, v1 = acc[ai][bj][m][1] * rs;
                    ssq += (v0[0] * v0[0] + v0[1] * v0[1]) + (v0[2] * v0[2] + v0[3] * v0[3]) + (v1[0] * v1[0] + v1[1] * v1[1]) + (v1[2] * v1[2] + v1[3] * v1[3]);
                    u32x4 w; w.x = cvt_pk_bf16(v0[0], v0[1]); w.y = cvt_pk_bf16(v0[2], v0[3]); w.z = cvt_pk_bf16(v1[0], v1[1]); w.w = cvt_pk_bf16(v1[2], v1[3]);
                    *(u32x4*)(out + (size_t)row * D + col0 + bj * HALF) = w; }
                ssq += __shfl_xor(ssq, 16); ssq += __shfl_xor(ssq, 32);
                if (fq == 0) ps[(size_t)row * 64 + u.pn * 4 + wc] = ssq; }
    }
};
struct EpiUp {
    static constexpr bool PERM = true, MIDK = false;
    bf16_t* H; const float* cmax; int row_off; unsigned* rmax;
    __device__ __forceinline__ void operator()(const Acc& acc, const Unit& u, int wr, int wc, int fr, int fq) const {
        const int row0 = u.pm * BM + wr * 64 + fr; const int col0 = u.pn * BM + wc * 32 + 8 * fq;
        f32x2 c2[2][4];
#pragma unroll
        for (int bj = 0; bj < 2; ++bj) { const f32x4 ca = *(const f32x4*)(cmax + col0 + bj * HALF), cb = *(const f32x4*)(cmax + col0 + bj * HALF + 4);
            c2[bj][0] = (f32x2){ca[0] * ca[0], ca[1] * ca[1]}; c2[bj][1] = (f32x2){ca[2] * ca[2], ca[3] * ca[3]}; c2[bj][2] = (f32x2){cb[0] * cb[0], cb[1] * cb[1]}; c2[bj][3] = (f32x2){cb[2] * cb[2], cb[3] * cb[3]}; }
#pragma unroll
        for (int ai = 0; ai < 2; ++ai)
#pragma unroll
            for (int m = 0; m < 4; ++m) { const int row = row0 + ai * HALF + m * 16; unsigned hm = 0u;
#pragma unroll
                for (int bj = 0; bj < 2; ++bj) { const v4i_t i0 = __builtin_bit_cast(v4i_t, acc[ai][bj][m][0]), i1 = __builtin_bit_cast(v4i_t, acc[ai][bj][m][1]);
                    f32x2 p0 = (f32x2){(float)max(i0[0], 0), (float)max(i0[1], 0)}, p1 = (f32x2){(float)max(i0[2], 0), (float)max(i0[3], 0)};
                    f32x2 p2 = (f32x2){(float)max(i1[0], 0), (float)max(i1[1], 0)}, p3 = (f32x2){(float)max(i1[2], 0), (float)max(i1[3], 0)};
                    p0 = (p0 * p0) * c2[bj][0]; p1 = (p1 * p1) * c2[bj][1]; p2 = (p2 * p2) * c2[bj][2]; p3 = (p3 * p3) * c2[bj][3];
                    u32x4 w; w.x = cvt_pk_bf16(p0.x, p0.y); w.y = cvt_pk_bf16(p1.x, p1.y); w.z = cvt_pk_bf16(p2.x, p2.y); w.w = cvt_pk_bf16(p3.x, p3.y);
                    const unsigned hi4 = max(max(w.x >> 16, w.y >> 16), max(w.z >> 16, w.w >> 16)), lo4 = max(max(w.x & 0xffffu, w.y & 0xffffu), max(w.z & 0xffffu, w.w & 0xffffu));
                    hm = max(hm, max(hi4, lo4));
                    *(u32x4*)(H + (size_t)row * DFF + col0 + bj * HALF) = w; }
                unsigned hx = (unsigned)__shfl_xor((int)hm, 16); hm = max(hm, hx); hx = (unsigned)__shfl_xor((int)hm, 32); hm = max(hm, hx);
                if (fq == 0) atomicMax(rmax + row_off + row, hm << 16); }
    }
};
struct EpiDown {
    static constexpr bool PERM = true, MIDK = false;
    bf16_t* Mo; float* ps; int row_off; const unsigned* rmax; const float* cmax; const int* csum; const float* rs1;
    __device__ __forceinline__ void operator()(const Acc& acc, const Unit& u, int wr, int wc, int fr, int fq) const {
        const int row0 = u.pm * BM + wr * 64 + fr; const int col0 = u.pn * BM + wc * 32 + 8 * fq;
        f32x2 cw[2][4]; v4i_t cz[2][2];
#pragma unroll
        for (int bj = 0; bj < 2; ++bj) { const f32x4 ca = *(const f32x4*)(cmax + col0 + bj * HALF) * (1.0f / 127.0f), cb = *(const f32x4*)(cmax + col0 + bj * HALF + 4) * (1.0f / 127.0f);
            cw[bj][0] = (f32x2){ca[0], ca[1]}; cw[bj][1] = (f32x2){ca[2], ca[3]}; cw[bj][2] = (f32x2){cb[0], cb[1]}; cw[bj][3] = (f32x2){cb[2], cb[3]};
            cz[bj][0] = *(const v4i_t*)(csum + col0 + bj * HALF) * 128; cz[bj][1] = *(const v4i_t*)(csum + col0 + bj * HALF + 4) * 128; }
#pragma unroll
        for (int ai = 0; ai < 2; ++ai)
#pragma unroll
            for (int m = 0; m < 4; ++m) { const int row = row0 + ai * HALF + m * 16; const float r1 = rs1[row_off + row];
                const float sa = __uint_as_float(rmax[row_off + row]) * (1.0f / 255.0f) * r1 * r1; const f32x2 sa2 = (f32x2){sa, sa}; f32x2 sq = (f32x2){0.f, 0.f};
#pragma unroll
                for (int bj = 0; bj < 2; ++bj) { const v4i_t i0 = __builtin_bit_cast(v4i_t, acc[ai][bj][m][0]) + cz[bj][0], i1 = __builtin_bit_cast(v4i_t, acc[ai][bj][m][1]) + cz[bj][1];
                    f32x2 p0 = (f32x2){(float)i0[0], (float)i0[1]}, p1 = (f32x2){(float)i0[2], (float)i0[3]}, p2 = (f32x2){(float)i1[0], (float)i1[1]}, p3 = (f32x2){(float)i1[2], (float)i1[3]};
                    p0 = (p0 * cw[bj][0]) * sa2; p1 = (p1 * cw[bj][1]) * sa2; p2 = (p2 * cw[bj][2]) * sa2; p3 = (p3 * cw[bj][3]) * sa2;
                    sq = p0 * p0 + sq; sq = p1 * p1 + sq; sq = p2 * p2 + sq; sq = p3 * p3 + sq;
                    u32x4 w; w.x = cvt_pk_bf16(p0.x, p0.y); w.y = cvt_pk_bf16(p1.x, p1.y); w.z = cvt_pk_bf16(p2.x, p2.y); w.w = cvt_pk_bf16(p3.x, p3.y);
                    *(u32x4*)(Mo + (size_t)row * D + col0 + bj * HALF) = w; }
                float ssq = sq.x + sq.y; ssq += __shfl_xor(ssq, 16); ssq += __shfl_xor(ssq, 32);
                if (fq == 0) ps[(size_t)(row_off + row) * 64 + u.pn * 4 + wc] = ssq; }
    }
};
struct EpiPle {
    static constexpr bool PERM = true, MIDK = false;
    bf16_t* P;
    __device__ __forceinline__ void operator()(const Acc& acc, const Unit& u, int wr, int wc, int fr, int fq) const {
        const int row0 = u.pm * BM + wr * 64 + fr; const int col0 = u.pn * BM + wc * 32 + 8 * fq;
#pragma unroll
        for (int ai = 0; ai < 2; ++ai)
#pragma unroll
            for (int m = 0; m < 4; ++m) { const int row = row0 + ai * HALF + m * 16;
#pragma unroll
                for (int bj = 0; bj < 2; ++bj) { const f32x4 v0 = acc[ai][bj][m][0], v1 = acc[ai][bj][m][1];
                    u32x4 w; w.x = cvt_pk_bf16(v0[0], v0[1]); w.y = cvt_pk_bf16(v0[2], v0[3]); w.z = cvt_pk_bf16(v1[0], v1[1]); w.w = cvt_pk_bf16(v1[2], v1[3]);
                    *(u32x4*)(P + (size_t)row * D + col0 + bj * HALF) = w; } }
    }
};
struct EpiGate {
    static constexpr bool PERM = false, MIDK = false;
    float* out; const bf16_t* P; const bf16_t* H2; const float* rstd; const float* cmax;
    __device__ __forceinline__ void operator()(const Acc& acc, const Unit& u, int wr, int wc, int fr, int fq) const {
        const int row0 = u.pm * BM + wr * 64 + fr; const int col0 = u.pn * BM + wc * 32 + 4 * fq;
#pragma unroll
        for (int ai = 0; ai < 2; ++ai)
#pragma unroll
            for (int m = 0; m < 4; ++m) { const int row = row0 + ai * HALF + m * 16; const float rs = rstd[row];
#pragma unroll
                for (int bj = 0; bj < 2; ++bj)
#pragma unroll
                    for (int n = 0; n < 2; ++n) { const size_t off = (size_t)row * D + col0 + bj * HALF + n * 16;
                        const u32x2 hr = *(const u32x2*)(H2 + off); const u32x2 pr = *(const u32x2*)(P + off); const v4i_t ia = __builtin_bit_cast(v4i_t, acc[ai][bj][m][n]); const f32x4 cw = *(const f32x4*)(cmax + col0 + bj * HALF + n * 16);
                        f32x4 a; a[0] = (float)ia[0] * rs * cw[0]; a[1] = (float)ia[1] * rs * cw[1]; a[2] = (float)ia[2] * rs * cw[2]; a[3] = (float)ia[3] * rs * cw[3];
                        f32x4 o; o[0] = bf_lo(hr.x) + bf_lo(pr.x) * sigmoidf_(a[0]); o[1] = bf_hi(hr.x) + bf_hi(pr.x) * sigmoidf_(a[1]); o[2] = bf_lo(hr.y) + bf_lo(pr.y) * sigmoidf_(a[2]); o[3] = bf_hi(hr.y) + bf_hi(pr.y) * sigmoidf_(a[3]);
                        *(f32x4*)(out + off) = o; }
                asm volatile("" ::: "memory"); }
    }
};
}

#define XB_TMO      128
#define XB_XCNT(j)  (256  + 64 * (j))
#define XB_XSUB(j)  (1280 + 64 * (j))
#define XB_XGEN(j)  (2304 + 64 * (j))
#define XB_TOP      3328
#define XB_TOPGEN   3392
#define XCD_BAR_WORDS 3456
#define XB_SPIN_CAP (1u << 18)
__device__ __forceinline__ unsigned xb_ld(unsigned* p)              { return __hip_atomic_load(p, __ATOMIC_RELAXED, __HIP_MEMORY_SCOPE_AGENT); }
__device__ __forceinline__ unsigned xb_add(unsigned* p, unsigned v) { return __hip_atomic_fetch_add(p, v, __ATOMIC_RELAXED, __HIP_MEMORY_SCOPE_AGENT); }
__device__ __forceinline__ unsigned xb_xcc_id() { return (unsigned)__builtin_amdgcn_s_getreg((3 << 11) | 20) & 0xFu; }
#define XB_SPIN(cond, bar) do { unsigned _sp = 0; while (cond) { __builtin_amdgcn_s_sleep(1); \
    if ((++_sp & 255u) == 0u) { if (xb_ld(&(bar)[XB_TMO])) break; if (_sp > XB_SPIN_CAP) { atomicAdd(&(bar)[XB_TMO], 1u); break; } } } } while (0)
struct XcdBarrier { unsigned* bar; unsigned x; volatile LAS unsigned* st; int wave; };
__device__ __forceinline__ XcdBarrier xcd_barrier_post(unsigned* bar, volatile LAS unsigned* st, int wave) {
    XcdBarrier b; b.bar = bar; b.x = xb_xcc_id(); b.st = st; b.wave = wave;
    if (wave == 0 && lane_id() == 0) (void)xb_add(&bar[XB_XCNT(b.x)], 1u);
    return b;
}
__device__ __forceinline__ void xcd_barrier_complete(unsigned* bar, unsigned x, unsigned& nloc, unsigned& nx) {
    const unsigned G = gridDim.x * gridDim.y * gridDim.z;
    unsigned sum, cnt, mine, sp = 0u;
    for (;;) {
        sum = 0u; cnt = 0u; mine = 0u;
#pragma unroll
        for (unsigned j = 0; j < 16; ++j) { const unsigned c = xb_ld(&bar[XB_XCNT(j)]); sum += c; cnt += (c > 0u) ? 1u : 0u; mine = (j == x) ? c : mine; }
        if (sum == G) break;
        __builtin_amdgcn_s_sleep(1);
        if ((++sp & 255u) == 0u) { if (xb_ld(&bar[XB_TMO])) break; if (sp > XB_SPIN_CAP) { atomicAdd(&bar[XB_TMO], 1u); break; } }
    }
    nloc = mine > 0u ? mine : 1u; nx = cnt > 0u ? cnt : 1u;
}
__device__ __forceinline__ void xcd_barrier(const XcdBarrier& b) {
    asm volatile("s_waitcnt vmcnt(0)" ::: "memory");
    __syncthreads();
    if (b.wave == 0 && lane_id() == 0) {
        unsigned* bar = b.bar;
        __builtin_amdgcn_s_waitcnt(0);
        unsigned nloc = b.st[0], nx = b.st[1];
        if (nloc == 0u) { xcd_barrier_complete(bar, b.x, nloc, nx); b.st[0] = nloc; b.st[1] = nx; }
        const unsigned old = xb_add(&bar[XB_XSUB(b.x)], 1u);
        const unsigned gen = old / nloc;
        if (old + 1u == (gen + 1u) * nloc) {
            __builtin_amdgcn_fence(__ATOMIC_RELEASE, "agent");
            asm volatile("s_waitcnt vmcnt(0)" ::: "memory");
            const unsigned og = xb_add(&bar[XB_TOP], 1u);
            const unsigned tg = og / nx;
            if (og + 1u == (tg + 1u) * nx) xb_add(&bar[XB_TOPGEN], 1u);
            else XB_SPIN(xb_ld(&bar[XB_TOPGEN]) == tg, bar);
            __builtin_amdgcn_fence(__ATOMIC_ACQUIRE, "agent");
            xb_add(&bar[XB_XGEN(b.x)], 1u);
            asm volatile("s_waitcnt vmcnt(0)" ::: "memory");
        } else {
            XB_SPIN(xb_ld(&bar[XB_XGEN(b.x)]) == gen, bar);
            __builtin_amdgcn_fence(__ATOMIC_ACQUIRE, "agent");
            asm volatile("s_waitcnt vmcnt(0)" ::: "memory");
        }
    }
    __syncthreads();
}

struct Args { const float* in[35]; float* out; unsigned char* ws; int ph_lo, ph_hi; };
template <int I> __device__ __forceinline__ const float* argp() {
    const unsigned long long kp = (unsigned long long)__builtin_amdgcn_kernarg_segment_ptr(); unsigned long long v;
    asm volatile("s_load_dwordx2 %0, %1, %2\n\ts_waitcnt lgkmcnt(0)" : "=s"(v) : "s"(kp), "n"(I * 8) : "memory");
    return (const float*)v;
}
#define ARGP(i) argp<(i)>()
struct Frame {
    LAS unsigned char* lds;
    int tid, lane, wave, G, gw, NGW;
    float* out; unsigned char* ws;
};
#define LDS_WAIT() asm volatile("s_waitcnt lgkmcnt(0)" ::: "memory")

__device__ __forceinline__ const float* xrow(const float* xp, const float* xs, int m) { return m < TPR ? xp + (size_t)m * D : xs + (size_t)(m - TPR) * D; }
__device__ __forceinline__ const float* perow(const float* pp_, const float* ps_, int m) { return m < TPR ? pp_ + (size_t)m * PLE : ps_ + (size_t)(m - TPR) * PLE; }

template <int OUT = 0> __device__ __forceinline__ void transpose_item(const float* W, int K, int N, bf16* WT, const float* gk, int ncs, float cscale, LAS float* scr, int item, int lane, const float* cmax = nullptr, int* csum = nullptr) {
    const int nblk = N / 64, kb = item / nblk, nb = item % nblk, k0 = 64 * kb, n0 = 64 * nb;
    const float cs = (n0 < ncs) ? cscale : 1.0f;
    const int kl = lane >> 4, n4 = 4 * (lane & 15);
    f32x4 v[16];
#pragma unroll
    for (int i = 0; i < 16; ++i) v[i] = *(const f32x4*)(W + (size_t)(k0 + 4 * i + kl) * N + n0 + n4);
    float gs[16];
#pragma unroll
    for (int i = 0; i < 16; ++i) gs[i] = gk ? gk[k0 + 4 * i + kl] * cs : cs;
    const int rn = lane >> 2, rc = lane & 3;
    f32x4 cinv = (f32x4){1.f, 1.f, 1.f, 1.f}; int cs0 = 0, cs1 = 0, cs2 = 0, cs3 = 0;
    if constexpr (OUT == 2) { const f32x4 cm = *(const f32x4*)(cmax + n0 + n4);
#pragma unroll
        for (int e = 0; e < 4; ++e) cinv[e] = cm[e] > 0.f ? 127.0f / cm[e] : 0.f; }
#pragma unroll
    for (int hh = 0; hh < 2; ++hh) {
#pragma unroll
        for (int i8 = 0; i8 < 8; ++i8) { const int i = hh * 8 + i8, kk = 4 * i8 + kl, c = kk >> 3; *(LAS f32x4*)(scr + kk * 68 + (n4 ^ (8 * c))) = v[i] * gs[i] * cinv; }
        LDS_WAIT(); asm volatile("" ::: "memory");
#pragma unroll
        for (int j = 0; j < 4; ++j) { const int n = rn + 16 * j; const LAS float* sp = scr + (8 * rc) * 68 + (n ^ (8 * rc));
            if constexpr (OUT == 2) { int sm = 0; u32x2 o; o.x = pack4_i8s(sp[0 * 68], sp[1 * 68], sp[2 * 68], sp[3 * 68], sm); o.y = pack4_i8s(sp[4 * 68], sp[5 * 68], sp[6 * 68], sp[7 * 68], sm);
                if (j == 0) cs0 += sm; else if (j == 1) cs1 += sm; else if (j == 2) cs2 += sm; else cs3 += sm;
                *(u32x2*)((unsigned char*)WT + (size_t)(n0 + n) * K + k0 + 32 * hh + 8 * rc) = o; }
            else if constexpr (OUT == 1) { u32x2 o; o.x = pack4_fp8(sp[0 * 68], sp[1 * 68], sp[2 * 68], sp[3 * 68]); o.y = pack4_fp8(sp[4 * 68], sp[5 * 68], sp[6 * 68], sp[7 * 68]);
                *(u32x2*)((unsigned char*)WT + (size_t)(n0 + n) * K + k0 + 32 * hh + 8 * rc) = o; }
            else { u32x4 o; o.x = cvt_pk_bf16(sp[0 * 68], sp[1 * 68]); o.y = cvt_pk_bf16(sp[2 * 68], sp[3 * 68]); o.z = cvt_pk_bf16(sp[4 * 68], sp[5 * 68]); o.w = cvt_pk_bf16(sp[6 * 68], sp[7 * 68]);
                *(u32x4*)(WT + (size_t)(n0 + n) * K + k0 + 32 * hh + 8 * rc) = o; } }
        LDS_WAIT(); asm volatile("" ::: "memory");
    }
    if constexpr (OUT == 2) { if (csum) {
        cs0 += __shfl_xor(cs0, 1); cs0 += __shfl_xor(cs0, 2); cs1 += __shfl_xor(cs1, 1); cs1 += __shfl_xor(cs1, 2); cs2 += __shfl_xor(cs2, 1); cs2 += __shfl_xor(cs2, 2); cs3 += __shfl_xor(cs3, 1); cs3 += __shfl_xor(cs3, 2);
        if (rc == 0) { atomicAdd(csum + n0 + rn, cs0); atomicAdd(csum + n0 + rn + 16, cs1); atomicAdd(csum + n0 + rn + 32, cs2); atomicAdd(csum + n0 + rn + 48, cs3); } } }
}

__device__ __forceinline__ void colmax_item(const float* W, int N, const float* gk, unsigned* cmax, int item, int lane) {
    const int nblk = N / 64, kb = item / nblk, nb = item % nblk, k0 = 64 * kb, n0 = 64 * nb;
    const int kl = lane >> 4, n4 = 4 * (lane & 15);
    f32x4 v[16];
#pragma unroll
    for (int i = 0; i < 16; ++i) v[i] = *(const f32x4*)(W + (size_t)(k0 + 4 * i + kl) * N + n0 + n4);
    float m0 = 0.f, m1 = 0.f, m2 = 0.f, m3 = 0.f;
#pragma unroll
    for (int i = 0; i < 16; ++i) { const float gs = gk ? gk[k0 + 4 * i + kl] : 1.0f; const f32x4 t = v[i] * gs;
        m0 = fmaxf(m0, fabsf(t.x)); m1 = fmaxf(m1, fabsf(t.y)); m2 = fmaxf(m2, fabsf(t.z)); m3 = fmaxf(m3, fabsf(t.w)); }
    m0 = fmaxf(m0, __shfl_xor(m0, 16)); m0 = fmaxf(m0, __shfl_xor(m0, 32));
    m1 = fmaxf(m1, __shfl_xor(m1, 16)); m1 = fmaxf(m1, __shfl_xor(m1, 32));
    m2 = fmaxf(m2, __shfl_xor(m2, 16)); m2 = fmaxf(m2, __shfl_xor(m2, 32));
    m3 = fmaxf(m3, __shfl_xor(m3, 16)); m3 = fmaxf(m3, __shfl_xor(m3, 32));
    if (kl == 0) { unsigned* cp = cmax + n0 + n4;
        atomicMax(cp + 0, __builtin_bit_cast(unsigned, m0)); atomicMax(cp + 1, __builtin_bit_cast(unsigned, m1)); atomicMax(cp + 2, __builtin_bit_cast(unsigned, m2)); atomicMax(cp + 3, __builtin_bit_cast(unsigned, m3)); }
}
__device__ __forceinline__ void xb_row(const Frame& F, const float* xp, const float* xs, int m) {
    const f32x4* xr = (const f32x4*)xrow(xp, xs, m) + F.lane;
    bf16* orow = (bf16*)(F.ws + WS_XB) + (size_t)m * D;
    float ssq = 0.f;
#pragma unroll
    for (int j = 0; j < 16; ++j) { const f32x4 v = xr[64 * j]; ssq += (v[0] * v[0] + v[1] * v[1]) + (v[2] * v[2] + v[3] * v[3]);
        u32x2 w; w.x = cvt_pk_bf16(v[0], v[1]); w.y = cvt_pk_bf16(v[2], v[3]); *((u32x2*)orow + F.lane + 64 * j) = w; }
    ssq = wave_sum(ssq);
    if (F.lane == 0) ((float*)(F.ws + WS_RSTD0))[m] = 1.0f / sqrtf(ssq * (1.0f / D) + RMS_EPS);
}
__device__ __forceinline__ void requant_row(const Frame& F, bf16* hrow, float rowmax) {
    const float sc = rowmax > 0.f ? 255.0f / rowmax : 0.f;
#pragma unroll 1
    for (int half = 0; half < 2; ++half) {
        u32x4 v[16];
#pragma unroll
        for (int i = 0; i < 16; ++i) v[i] = ((const u32x4*)(hrow + 8192 * half))[F.lane + 64 * i];
        asm volatile("s_waitcnt vmcnt(0)" ::: "memory");
#pragma unroll
        for (int i = 0; i < 16; ++i) { u32x2 o;
            o.x = pack4_i8(bf_lo(v[i].x) * sc - 128.f, bf_hi(v[i].x) * sc - 128.f, bf_lo(v[i].y) * sc - 128.f, bf_hi(v[i].y) * sc - 128.f);
            o.y = pack4_i8(bf_lo(v[i].z) * sc - 128.f, bf_hi(v[i].z) * sc - 128.f, bf_lo(v[i].w) * sc - 128.f, bf_hi(v[i].w) * sc - 128.f);
            ((u32x2*)((unsigned char*)hrow + 8192 * half))[F.lane + 64 * i] = o; }
        asm volatile("s_waitcnt vmcnt(0)" ::: "memory"); }
}
template <bool BASE_BF16> __device__ __forceinline__ void row_pass(const Frame& F, const void* base, const bf16* add, const float* ps, const f32x4 (&gg)[16], bf16* outb, float* rs_out, unsigned char* outq) {
    u32x2 ar[16]; u32x2 br[16]; f32x4 bf[16];
#pragma unroll
    for (int j = 0; j < 16; ++j) { const int c4 = F.lane + 64 * j; ar[j] = ((const u32x2*)add)[c4];
        if constexpr (BASE_BF16) br[j] = ((const u32x2*)base)[c4]; else bf[j] = ((const f32x4*)base)[c4]; }
    const float rsa = 1.0f / sqrtf(wave_sum(ps[F.lane]) * (1.0f / D) + RMS_EPS);
    float ssq = 0.f, amax = 0.f; f32x4 hv[16];
#pragma unroll
    for (int j = 0; j < 16; ++j) { const int c4 = F.lane + 64 * j;
        f32x4 b;
        if constexpr (BASE_BF16) { b[0] = bf_lo(br[j].x); b[1] = bf_hi(br[j].x); b[2] = bf_lo(br[j].y); b[3] = bf_hi(br[j].y); } else b = bf[j];
        f32x4 a; a[0] = bf_lo(ar[j].x); a[1] = bf_hi(ar[j].x); a[2] = bf_lo(ar[j].y); a[3] = bf_hi(ar[j].y);
        const f32x4 h = b + a * rsa * gg[j]; hv[j] = h;
        ssq += (h[0] * h[0] + h[1] * h[1]) + (h[2] * h[2] + h[3] * h[3]);
        amax = fmaxf(fmaxf(amax, fmaxf(fabsf(h[0]), fabsf(h[1]))), fmaxf(fabsf(h[2]), fabsf(h[3])));
        u32x2 w; w.x = cvt_pk_bf16(h[0], h[1]); w.y = cvt_pk_bf16(h[2], h[3]); ((u32x2*)outb)[c4] = w; }
    ssq = wave_sum(ssq); amax = wave_max(amax);
    const float inv = amax > 0.f ? 127.0f / amax : 0.f;
#pragma unroll
    for (int j = 0; j < 16; ++j) ((unsigned*)outq)[F.lane + 64 * j] = pack4_i8(hv[j][0] * inv, hv[j][1] * inv, hv[j][2] * inv, hv[j][3] * inv);
    if (F.lane == 0) *rs_out = amax * (1.0f / (127.0f * 127.0f)) / sqrtf(ssq * (1.0f / D) + RMS_EPS);
}

typedef float f32x16 __attribute__((ext_vector_type(16)));
typedef short s16x4 __attribute__((ext_vector_type(4)));
#define MFMA32(a, b, c) __builtin_amdgcn_mfma_f32_32x32x16_bf16((a), (b), (c), 0, 0, 0)
constexpr int NCH = T / 32;

__device__ __forceinline__ void ssm_tables(const Frame& F, int g) {
    LAS float* BBr = (LAS float*)F.lds; LAS float* BBi = BBr + 2048; LAS float* CCr = BBi + 2048; LAS float* CCi = CCr + 2048;
    LAS float* PWr = CCi + 2048; LAS float* PWi = PWr + 4224;
    const int tid = F.tid;
    const float* lamre[2] = {ARGP(7), ARGP(14)}; const float* lamim[2] = {ARGP(8), ARGP(15)}; const float* logdt[2] = {ARGP(9), ARGP(16)};
    {   const float* bre0 = ARGP(10); const float* bim0 = ARGP(11); const float* bre1 = ARGP(17); const float* bim1 = ARGP(18);
        const float* cre0 = ARGP(12); const float* cim0 = ARGP(13); const float* cre1 = ARGP(19); const float* cim1 = ARGP(20);
        for (int idx = tid; idx < 2048; idx += 512) {
            { const int dir = idx >> 10, p = (idx >> 4) & 63, h = idx & 15;
              const float lr = fminf((dir ? lamre[1] : lamre[0])[g * SP + p], -1e-4f), li = (dir ? lamim[1] : lamim[0])[g * SP + p], dt = expf((dir ? logdt[1] : logdt[0])[g]);
              const float mag = expf(lr * dt); float sn, cs; sincosf(li * dt, &sn, &cs);
              const float lbr = mag * cs, lbi = mag * sn, den = lr * lr + li * li, nr = lbr - 1.0f;
              const float cr = (nr * lr + lbi * li) / den, ci = (lbi * lr - nr * li) / den;
              const float br = (dir ? bre1 : bre0)[(size_t)(g * SP + p) * 16 + h], bi = (dir ? bim1 : bim0)[(size_t)(g * SP + p) * 16 + h];
              BBr[idx] = cr * br - ci * bi; BBi[idx] = cr * bi + ci * br; }
            { const int dir = idx >> 10, h = (idx >> 6) & 15, p = idx & 63;
              CCr[idx] = (dir ? cre1 : cre0)[(size_t)(g * 16 + h) * SP + p]; CCi[idx] = (dir ? cim1 : cim0)[(size_t)(g * 16 + h) * SP + p]; }
        }
        for (int idx = tid; idx < 4224; idx += 512) { const int dir = idx / 2112, n = (idx % 2112) >> 6, p = idx & 63;
            const float lr = fminf((dir ? lamre[1] : lamre[0])[g * SP + p], -1e-4f), li = (dir ? lamim[1] : lamim[0])[g * SP + p], dt = expf((dir ? logdt[1] : logdt[0])[g]);
            const float mag = expf(lr * dt * (float)n); float sn, cs; sincosf(li * dt * (float)n, &sn, &cs);
            PWr[idx] = mag * cs; PWi[idx] = mag * sn; }
    }
    __syncthreads();
    bf16* MBg = (bf16*)(F.ws + WS_MB) + (size_t)g * 256 * 512; bf16* MCg = (bf16*)(F.ws + WS_MC) + (size_t)g * 512 * 256; bf16* Kt = (bf16*)(F.ws + WS_KTAB) + (size_t)g * 32768;
    for (int task = tid; task < 8192; task += 512) { const int hb = task & 1, ip = (task >> 1) & 31, p = (task >> 6) & 63, dir = task >> 12;
        const int n = dir ? ip : 31 - ip; const float pr = PWr[dir * 2112 + n * 64 + p], pi = PWi[dir * 2112 + n * 64 + p];
        float vr[8], vi[8];
#pragma unroll
        for (int j = 0; j < 8; ++j) { const float br = BBr[(dir * 64 + p) * 16 + 8 * hb + j], bi = BBi[(dir * 64 + p) * 16 + 8 * hb + j]; vr[j] = pr * br - pi * bi; vi[j] = pr * bi + pi * br; }
        u32x4 wr_, wi_; wr_.x = cvt_pk_bf16(vr[0], vr[1]); wr_.y = cvt_pk_bf16(vr[2], vr[3]); wr_.z = cvt_pk_bf16(vr[4], vr[5]); wr_.w = cvt_pk_bf16(vr[6], vr[7]);
        wi_.x = cvt_pk_bf16(vi[0], vi[1]); wi_.y = cvt_pk_bf16(vi[2], vi[3]); wi_.z = cvt_pk_bf16(vi[4], vi[5]); wi_.w = cvt_pk_bf16(vi[6], vi[7]);
        { const int mtile = dir * 4 + (p >> 4), r0 = 2 * (p & 15); bf16* fb = MBg + ((size_t)(mtile * 32 + ip) * 64) * 8;
          *(u32x4*)(fb + (r0 + 32 * hb) * 8) = wr_; *(u32x4*)(fb + (r0 + 1 + 32 * hb) * 8) = wi_; } }
    for (int task = tid; task < 16384; task += 512) { const int pb = task & 15, dir = (task >> 4) & 1, h = (task >> 5) & 15, i = task >> 9;
        const int n = dir ? 32 - i : i + 1; float v[8];
#pragma unroll
        for (int j = 0; j < 4; ++j) { const int p = 4 * pb + j; const float cr = CCr[(dir * 16 + h) * 64 + p], ci = CCi[(dir * 16 + h) * 64 + p], pr = PWr[dir * 2112 + n * 64 + p], pi = PWi[dir * 2112 + n * 64 + p];
            v[2 * j] = cr * pr - ci * pi; v[2 * j + 1] = -(cr * pi + ci * pr); }
        u32x4 w; w.x = cvt_pk_bf16(v[0], v[1]); w.y = cvt_pk_bf16(v[2], v[3]); w.z = cvt_pk_bf16(v[4], v[5]); w.w = cvt_pk_bf16(v[6], v[7]);
        *(u32x4*)(MCg + ((size_t)(((i >> 1) * 16 + dir * 8 + (pb >> 1)) * 64) + ((i & 1) * 16 + h) + 32 * (pb & 1)) * 8) = w; }
    const float* dsk = ARGP(21);
    for (int task = tid; task < 2016; task += 512) { const int hb = task & 1, h = (task >> 1) & 15, di = task >> 5; const int d = di - 31;
        float acc[8];
#pragma unroll
        for (int j = 0; j < 8; ++j) acc[j] = 0.f;
        for (int dir = 0; dir < 2; ++dir) { if ((dir == 0 && d < 0) || (dir == 1 && d > 0)) continue; const int n = d < 0 ? -d : d;
            for (int p = 0; p < 64; ++p) { const float cr = CCr[(dir * 16 + h) * 64 + p], ci = CCi[(dir * 16 + h) * 64 + p], pr = PWr[dir * 2112 + n * 64 + p], pi = PWi[dir * 2112 + n * 64 + p];
                const float wr_ = cr * pr - ci * pi, wi_ = cr * pi + ci * pr;
#pragma unroll
                for (int j = 0; j < 8; ++j) acc[j] += wr_ * BBr[(dir * 64 + p) * 16 + 8 * hb + j] - wi_ * BBi[(dir * 64 + p) * 16 + 8 * hb + j]; } }
        if (d == 0) {
#pragma unroll
            for (int j = 0; j < 8; ++j) if (8 * hb + j == h) acc[j] += dsk[g * 16 + h]; }
        u32x4 w; w.x = cvt_pk_bf16(acc[0], acc[1]); w.y = cvt_pk_bf16(acc[2], acc[3]); w.z = cvt_pk_bf16(acc[4], acc[5]); w.w = cvt_pk_bf16(acc[6], acc[7]);
        if (di <= 61) *(u32x4*)(Kt + ((size_t)di * 64 + h + 32 * hb) * 8) = w;
        if (di >= 1) *(u32x4*)(Kt + ((size_t)(di - 1) * 64 + 16 + h + 32 * hb) * 8) = w; }
    __syncthreads();
}

__device__ __forceinline__ void ssm_stage_a(const Frame& F, int unit) {
    const int mq = unit & 3, cp = (unit >> 2) % 12, G8 = unit / 48;
    const int g = G8 * 8 + F.wave, c = F.lane & 31, hf = F.lane >> 5;
    const bf16* Up = (const bf16*)(F.ws + WS_UG) + ((size_t)(g * 24 + 2 * cp) * 32) * 512 + F.lane * 8;
    const bf16* Ap = (const bf16*)(F.ws + WS_MB) + ((size_t)(g * 8 + 2 * mq) * 32) * 512 + F.lane * 8;
    f32x16 acc[2][2];
#pragma unroll
    for (int t = 0; t < 2; ++t)
#pragma unroll
        for (int m = 0; m < 2; ++m)
#pragma unroll
            for (int i = 0; i < 16; ++i) acc[t][m][i] = 0.f;
#pragma unroll 4
    for (int ks = 0; ks < 32; ++ks) { const bf16x8 b0 = *(const bf16x8*)(Up + ks * 512), b1 = *(const bf16x8*)(Up + (32 + ks) * 512);
#pragma unroll
        for (int m = 0; m < 2; ++m) { const bf16x8 a = *(const bf16x8*)(Ap + (size_t)(m * 32 + ks) * 512); acc[0][m] = MFMA32(a, b0, acc[0][m]); acc[1][m] = MFMA32(a, b1, acc[1][m]); } }
#pragma unroll
    for (int t = 0; t < 2; ++t) { float* Sp = (float*)(F.ws + WS_S) + ((size_t)(g * 24 + 2 * cp + t) * 64 + 16 * mq + hf) * 128 + c * 4;
#pragma unroll
        for (int m = 0; m < 2; ++m)
#pragma unroll
            for (int q = 0; q < 4; ++q) *(f32x4*)(Sp + (size_t)(8 * m + 2 * q) * 128) = (f32x4){acc[t][m][4 * q], acc[t][m][4 * q + 1], acc[t][m][4 * q + 2], acc[t][m][4 * q + 3]}; }
}

template <int dir> __device__ __forceinline__ void ssm_scan_task(const Frame& F, int task) {
    const int p = F.lane, g = (task >> 1) & 127, seq = task >> 8;
    const int c0 = seq == 0 ? 0 : (seq == 1 ? 128 : 256), nc = seq == 2 ? 512 : 128;
    const float lr = fminf(ARGP(dir ? 14 : 7)[g * SP + p], -1e-4f), li = ARGP(dir ? 15 : 8)[g * SP + p], dt = expf(ARGP(dir ? 16 : 9)[g]);
    const float mag = expf(lr * dt * 32.0f); float sn, cs; sincosf(li * dt * 32.0f, &sn, &cs);
    const float qr = mag * cs, qi = mag * sn;
    const float* Sg = (const float*)(F.ws + WS_S) + ((size_t)g * 24 * 64 + dir * 32 + (p >> 1)) * 128 + 2 * (p & 1);
    bf16* Hg = (bf16*)(F.ws + WS_HB) + ((size_t)g * 24 * 16 + dir * 8 + (p >> 3)) * 512 + 32 * 8 * ((p & 7) >> 2) + 2 * (p & 3);
#define S_AT(cg) (Sg + (size_t)((cg) >> 5) * (64 * 128) + ((cg) & 31) * 4)
#define H_AT(cg) (Hg + (size_t)((cg) >> 5) * (16 * 512) + ((cg) & 31) * 8)
    float hr = 0.f, hi = 0.f;
    f32x2 cur[32];
#pragma unroll
    for (int j = 0; j < 32; ++j) { const int c = dir ? (c0 + nc - 1 - j) : (c0 + j); cur[j] = *(const f32x2*)S_AT(c); }
    for (int sb = 0; sb < nc / 32; ++sb) {
        f32x2 nxt[32];
        const int sbn = (sb + 1 < nc / 32) ? sb + 1 : sb;
#pragma unroll
        for (int j = 0; j < 32; ++j) { const int k = sbn * 32 + j; const int c = dir ? (c0 + nc - 1 - k) : (c0 + k); nxt[j] = *(const f32x2*)S_AT(c); }
#pragma unroll
        for (int j = 0; j < 32; ++j) { const int k = sb * 32 + j; const int c = dir ? (c0 + nc - 1 - k) : (c0 + k);
            *(unsigned*)H_AT(c) = cvt_pk_bf16(hr, hi);
            const float nr = qr * hr - qi * hi + cur[j].x, ni = qr * hi + qi * hr + cur[j].y; hr = nr; hi = ni; }
#pragma unroll
        for (int j = 0; j < 32; ++j) cur[j] = nxt[j];
    }
#undef S_AT
#undef H_AT
}

__device__ __forceinline__ void ssm_stage_c(const Frame& F, int unit) {
    const int mb = unit & 3, cp = (unit >> 2) % 12, G8 = unit / 48;
    const int g = G8 * 8 + F.wave, r = F.lane & 31, hf = F.lane >> 5;
    const bf16* Up = (const bf16*)(F.ws + WS_UG) + ((size_t)(g * 24 + 2 * cp) * 32) * 512 + F.lane * 8;
    const bf16* Kp = (const bf16*)(F.ws + WS_KTAB) + ((size_t)g * 64 + 8 * mb + 31) * 512 + F.lane * 8;
    const bf16* Hp = (const bf16*)(F.ws + WS_HB) + ((size_t)(g * 24 + 2 * cp) * 16) * 512 + F.lane * 8;
    const bf16* Cp = (const bf16*)(F.ws + WS_MC) + ((size_t)(g * 16 + 4 * mb) * 16) * 512 + F.lane * 8;
    f32x16 acc[2][4];
#pragma unroll
    for (int t = 0; t < 2; ++t)
#pragma unroll
        for (int m = 0; m < 4; ++m)
#pragma unroll
            for (int i = 0; i < 16; ++i) acc[t][m][i] = 0.f;
#pragma unroll 4
    for (int ks = 0; ks < 32; ++ks) { const bf16x8 b0 = *(const bf16x8*)(Up + ks * 512), b1 = *(const bf16x8*)(Up + (32 + ks) * 512);
#pragma unroll
        for (int m = 0; m < 4; ++m) { const bf16x8 a = *(const bf16x8*)(Kp + (2 * m - ks) * 512); acc[0][m] = MFMA32(a, b0, acc[0][m]); acc[1][m] = MFMA32(a, b1, acc[1][m]); } }
#pragma unroll 4
    for (int ks = 0; ks < 16; ++ks) { const bf16x8 b0 = *(const bf16x8*)(Hp + ks * 512), b1 = *(const bf16x8*)(Hp + (16 + ks) * 512);
#pragma unroll
        for (int m = 0; m < 4; ++m) { const bf16x8 a = *(const bf16x8*)(Cp + (size_t)(m * 16 + ks) * 512); acc[0][m] = MFMA32(a, b0, acc[0][m]); acc[1][m] = MFMA32(a, b1, acc[1][m]); } }
#pragma unroll
    for (int t = 0; t < 2; ++t) {
        __syncthreads();
        { LAS unsigned char* wb = F.lds + (unsigned)(r * 8) * 256u + (unsigned)((F.wave ^ (r & 7)) * 32 + 8 * hf);
          LAS unsigned char* w8 = F.lds + 65536 + (unsigned)(r * 8) * 128u + (unsigned)((F.wave ^ (r & 7)) * 16 + 4 * hf);
#pragma unroll
          for (int m = 0; m < 4; ++m)
#pragma unroll
            for (int q = 0; q < 4; ++q) { u32x2 w; w.x = cvt_pk_bf16(gelu_tanh(acc[t][m][4 * q]), gelu_tanh(acc[t][m][4 * q + 1])); w.y = cvt_pk_bf16(gelu_tanh(acc[t][m][4 * q + 2]), gelu_tanh(acc[t][m][4 * q + 3]));
                *(LAS u32x2*)(wb + (2 * m + (q >> 1)) * 256 + 16 * (q & 1)) = w;
                *(LAS unsigned*)(w8 + (2 * m + (q >> 1)) * 128 + 8 * (q & 1)) = pack4_fp8(bf_lo(w.x), bf_hi(w.x), bf_lo(w.y), bf_hi(w.y)); } }
        __syncthreads();
        const size_t tok0 = (size_t)((2 * cp + t) * 32) * 32 + 8 * mb;
#pragma unroll
        for (int i = 0; i < 8; ++i) { const int idx = F.tid + 512 * i, row = idx >> 4, seg = idx & 15;
            const u32x4 v = *(const LAS u32x4*)(F.lds + row * 256 + (((seg >> 1) ^ ((row >> 3) & 7)) * 32) + (seg & 1) * 16);
            *(u32x4*)((bf16*)(F.ws + WS_Z) + (tok0 + 32 * (row >> 3) + (row & 7)) * AW + G8 * 128 + seg * 8) = v; }
#pragma unroll
        for (int i = 0; i < 4; ++i) { const int idx = F.tid + 512 * i, row = idx >> 3, seg = idx & 7;
            const u32x4 v = *(const LAS u32x4*)(F.lds + 65536 + row * 128 + ((seg ^ ((row >> 3) & 7)) * 16));
            *(u32x4*)((unsigned char*)(F.ws + WS_ZF8) + (tok0 + 32 * (row >> 3) + (row & 7)) * AW + G8 * 128 + seg * 16) = v; }
    }
}

constexpr int BT_OFF = 132096;
#define KRD(o, a, off) "ds_read_b128 %" #o ", %" #a " offset:" #off "\n\t"
#define TRD(o, a, off) "ds_read_b64_tr_b16 %" #o ", %" #a " offset:" #off "\n\t"
template <int CT>
__device__ __forceinline__ void attn_unit6(const Frame& F, const float* rpb, int unit) {
    constexpr int KB = CT == 0 ? 0 : CT == 1 ? 8 : CT == 2 ? 24 : 32;
    const int h = unit & 15, rg = unit >> 4;
    const int lane = F.lane, wave = F.wave, tid = F.tid, rp = wave >> 2;
    const int R0 = 4 * rg;
    int Rb, rows; if (R0 < 64) { Rb = 0; rows = 64; } else if (R0 < 128) { Rb = 64; rows = 64; } else { Rb = 128; rows = 256; }
    const int r0 = R0 - Rb;
    const int j31 = lane & 31, hf = lane >> 5;
    const int qrow = 2 * rp + (j31 >> 4), r = r0 + qrow;
    int rs = r - 4; rs = rs < 0 ? 0 : rs; rs = rs > rows - 8 ? rows - 8 : rs;
    int rsA = r0 + 2 * rp - 4; rsA = rsA < 0 ? 0 : rsA; rsA = rsA > rows - 8 ? rows - 8 : rsA;
    int rsB = r0 + 2 * rp + 1 - 4; rsB = rsB < 0 ? 0 : rsB; rsB = rsB > rows - 8 ? rows - 8 : rsB;
    int kr_lo = r0 - 4; kr_lo = kr_lo < 0 ? 0 : kr_lo; kr_lo = kr_lo > rows - 8 ? rows - 8 : kr_lo;
    int kr_hi = r0 + 3 - 4; kr_hi = kr_hi < 0 ? 0 : kr_hi; kr_hi = kr_hi > rows - 8 ? rows - 8 : kr_hi; kr_hi += 7;
    const int c = 16 * CT + (j31 & 15); int cs = c - 8; cs = cs < 0 ? 0 : cs; cs = cs > 48 ? 48 : cs;
    const int tokq = (R0 + qrow) * 64 + c;
    LAS float* bt = (LAS float*)(F.lds + BT_OFF);
    __syncthreads();
    const bf16* Qb = (const bf16*)(F.ws + WS_Q); const bf16* Kb = (const bf16*)(F.ws + WS_K); const bf16* Vb = (const bf16*)(F.ws + WS_V);
    unsigned goff[2];
#pragma unroll
    for (int i = 0; i < 2; ++i) { const int row = 8 * wave + 4 * i + (lane >> 4); goff[i] = (unsigned)(row * HD + 8 * ((lane & 15) ^ (((row & 3) << 2) | ((row >> 2) & 3)))) * 2u; }
#define ATT_DMA(kr_, buf_) do { const char* kg_ = (const char*)(Kb + ((size_t)h * T + (Rb + (kr_)) * 64) * HD); const char* vg_ = (const char*)(Vb + ((size_t)h * T + (Rb + (kr_)) * 64) * HD); \
        _Pragma("unroll") for (int i_ = 0; i_ < 2; ++i_) { \
            __builtin_amdgcn_global_load_lds((const unsigned*)(kg_ + goff[i_]), (LAS unsigned*)(F.lds + (buf_) * 32768 + 2048 * wave + 1024 * i_), 16, 0, 0); \
            __builtin_amdgcn_global_load_lds((const unsigned*)(vg_ + goff[i_]), (LAS unsigned*)(F.lds + (buf_) * 32768 + 16384 + 2048 * wave + 1024 * i_), 16, 0, 0); } } while (0)
    ATT_DMA(kr_lo, 0); ATT_DMA(kr_lo + 1, 1); ATT_DMA(kr_lo + 2, 2);
    for (int i = tid; i < 1024; i += 512) { const int dr_ = i >> 6, dc = (i & 63) - 32; const bool in = dr_ < 15 && dc >= -15 && dc <= 15;
        float v = -__builtin_inff(); if (in) v = rpb[h * 465 + dr_ * 31 + dc + 15] * LOG2E;
        bt[1024 + i] = v; bt[i] = (dc >= -8 && dc <= 7) ? v : -__builtin_inff(); }
    bf16x8 qf[8];
    { const bf16* qp = Qb + (size_t)tokq * AW + h * HD + 8 * hf;
#pragma unroll
      for (int s_ = 0; s_ < 8; ++s_) qf[s_] = *(const bf16x8*)(qp + 16 * s_); }
    f32x16 O[4];
#pragma unroll
    for (int d = 0; d < 4; ++d)
#pragma unroll
        for (int i = 0; i < 16; ++i) O[d][i] = 0.f;
    float mrun = -1e30f, lrun = 0.f;
    const unsigned lbase = (unsigned)(uintptr_t)F.lds;
    const int krow = KB + j31;
    const unsigned ka = lbase + 256 * krow + 16 * (hf ^ (((krow & 3) << 2) | ((krow >> 2) & 3)));
    const int i16 = lane & 15, q4 = i16 >> 2, pp = i16 & 3, g1 = (lane >> 4) & 1;
    unsigned tbo[4][2];
#pragma unroll
    for (int d = 0; d < 4; ++d)
#pragma unroll
        for (int sec = 0; sec < 2; ++sec) { const int row_l = 4 * hf + 8 * sec + q4, swz = (q4 << 2) | ((hf + 2 * sec + KB / 4) & 3), ch = 4 * d + 2 * g1 + (pp >> 1);
            tbo[d][sec] = lbase + 16384 + 256 * (KB + row_l) + 16 * (ch ^ swz) + 8 * (pp & 1); }
    asm volatile("" :: "v"(qf[0]), "v"(qf[1]), "v"(qf[2]), "v"(qf[3]), "v"(qf[4]), "v"(qf[5]), "v"(qf[6]), "v"(qf[7]));
    asm volatile("s_waitcnt vmcnt(0) lgkmcnt(0)" ::: "memory");
    int bi = 0;
    for (int kr = kr_lo; kr <= kr_hi; ++kr) {
        const unsigned bofs = (unsigned)bi * 32768u;
        asm volatile("s_waitcnt vmcnt(8)" ::: "memory");
        __builtin_amdgcn_s_barrier();
        asm volatile("" ::: "memory");
        { const int krn = kr + 3 <= kr_hi ? kr + 3 : kr_hi; const int bn = (bi + 3) & 3; ATT_DMA(krn, bn); }
        if (kr >= rsA && kr < rsB + 8) {
            constexpr bool INTERIOR = (CT == 1 || CT == 2);
            const int dr = kr - r + 7;
            const bool rowok = (unsigned)(kr - rs) < 8u;
            const LAS float* brow = bt + (INTERIOR ? 0 : 1024) + (rowok ? dr : 15) * 64 + (32 - c + KB + 4 * hf);
            f32x16 sacc;
#pragma unroll
            for (int i = 0; i < 16; ++i) sacc[i] = brow[(i & 3) + 8 * (i >> 2)];
            {   bf16x8 k0, k1, k2, k3, k4, k5, k6, k7;
                const unsigned a0 = (ka + bofs), a1 = (ka + bofs) ^ 32u, a2 = (ka + bofs) ^ 64u, a3 = (ka + bofs) ^ 96u, a4 = (ka + bofs) ^ 128u, a5 = (ka + bofs) ^ 160u, a6 = (ka + bofs) ^ 192u, a7 = (ka + bofs) ^ 224u;
                asm volatile(KRD(0, 8, 0) KRD(1, 9, 0) KRD(2, 10, 0) KRD(3, 11, 0) KRD(4, 12, 0) KRD(5, 13, 0) KRD(6, 14, 0) KRD(7, 15, 0) "s_waitcnt lgkmcnt(0)"
                             : "=&v"(k0), "=&v"(k1), "=&v"(k2), "=&v"(k3), "=&v"(k4), "=&v"(k5), "=&v"(k6), "=&v"(k7)
                             : "v"(a0), "v"(a1), "v"(a2), "v"(a3), "v"(a4), "v"(a5), "v"(a6), "v"(a7) : "memory");
                sacc = MFMA32(k0, qf[0], sacc); sacc = MFMA32(k1, qf[1], sacc); sacc = MFMA32(k2, qf[2], sacc); sacc = MFMA32(k3, qf[3], sacc);
                sacc = MFMA32(k4, qf[4], sacc); sacc = MFMA32(k5, qf[5], sacc); sacc = MFMA32(k6, qf[6], sacc); sacc = MFMA32(k7, qf[7], sacc); }
            float mloc = -1e30f;
#pragma unroll
            for (int rg_ = 0; rg_ < 16; ++rg_) { const int kc = KB + (rg_ & 3) + 8 * (rg_ >> 2) + 4 * hf;
                float sc = sacc[rg_];
                if (!INTERIOR) { sc = ((unsigned)(kc - cs) < 16u) ? sc : -__builtin_inff(); sacc[rg_] = sc; }
                mloc = fmaxf(mloc, sc); }
            mloc = fmaxf(mloc, __shfl_xor(mloc, 32));
            const float mnew = fmaxf(mrun, mloc), alpha = __builtin_amdgcn_exp2f(mrun - mnew); mrun = mnew;
            float psum = 0.f;
#pragma unroll
            for (int rg_ = 0; rg_ < 16; ++rg_) { const float p = __builtin_amdgcn_exp2f(sacc[rg_] - mnew); sacc[rg_] = p; psum += p; }
            lrun = lrun * alpha + psum;
            if (!__all(alpha == 1.0f)) {
#pragma unroll
            for (int d = 0; d < 4; ++d)
#pragma unroll
                for (int i = 0; i < 16; ++i) O[d][i] *= alpha; }
            bf16x8 pb[2];
#pragma unroll
            for (int s2 = 0; s2 < 2; ++s2) { u32x4 w; w.x = cvt_pk_bf16(sacc[8 * s2], sacc[8 * s2 + 1]); w.y = cvt_pk_bf16(sacc[8 * s2 + 2], sacc[8 * s2 + 3]);
                w.z = cvt_pk_bf16(sacc[8 * s2 + 4], sacc[8 * s2 + 5]); w.w = cvt_pk_bf16(sacc[8 * s2 + 6], sacc[8 * s2 + 7]); pb[s2] = __builtin_bit_cast(bf16x8, w); }
#pragma unroll
            for (int dp = 0; dp < 2; ++dp) { s16x4 f0, f1, f2, f3, f4, f5, f6, f7;
                const unsigned a0 = bofs + tbo[2 * dp][0], a1 = bofs + tbo[2 * dp][1], a2 = bofs + tbo[2 * dp + 1][0], a3 = bofs + tbo[2 * dp + 1][1];
                asm volatile(TRD(0, 8, 0) TRD(1, 9, 0) TRD(2, 8, 4096) TRD(3, 9, 4096) TRD(4, 10, 0) TRD(5, 11, 0) TRD(6, 10, 4096) TRD(7, 11, 4096) "s_waitcnt lgkmcnt(0)"
                             : "=&v"(f0), "=&v"(f1), "=&v"(f2), "=&v"(f3), "=&v"(f4), "=&v"(f5), "=&v"(f6), "=&v"(f7)
                             : "v"(a0), "v"(a1), "v"(a2), "v"(a3) : "memory");
#define SV(x, y) __builtin_shufflevector(x, y, 0, 1, 2, 3, 4, 5, 6, 7)
                O[2 * dp] = MFMA32(SV(f0, f1), pb[0], O[2 * dp]); O[2 * dp + 1] = MFMA32(SV(f4, f5), pb[0], O[2 * dp + 1]);
                O[2 * dp] = MFMA32(SV(f2, f3), pb[1], O[2 * dp]); O[2 * dp + 1] = MFMA32(SV(f6, f7), pb[1], O[2 * dp + 1]);
#undef SV
            }
        }
        bi = (bi + 1) & 3;
    }
    asm volatile("s_waitcnt vmcnt(0)" ::: "memory");
#undef ATT_DMA
    const float inv = 1.0f / (lrun + __shfl_xor(lrun, 32));
    __syncthreads();
    LAS unsigned char* ot = F.lds + wave * 8704;
    float ssq = 0.f;
#pragma unroll
    for (int d = 0; d < 4; ++d)
#pragma unroll
        for (int q = 0; q < 4; ++q) { const float o0 = O[d][4 * q] * inv, o1 = O[d][4 * q + 1] * inv, o2 = O[d][4 * q + 2] * inv, o3 = O[d][4 * q + 3] * inv;
            ssq += (o0 * o0 + o1 * o1) + (o2 * o2 + o3 * o3);
            u32x2 w; w.x = cvt_pk_bf16(o0, o1); w.y = cvt_pk_bf16(o2, o3); *(LAS u32x2*)(ot + j31 * 272 + 8 * hf + 16 * (4 * d + q)) = w; }
    ssq += __shfl_xor(ssq, 32);
    if (hf == 0) ((float*)(F.ws + WS_PSATT))[(size_t)tokq * 16 + h] = ssq;
    { const int seg = lane & 15;
      bf16* og = (bf16*)(F.ws + WS_XB) + (size_t)((R0 + 2 * rp) * 64 + 16 * CT + (lane >> 4)) * D + h * HD + seg * 8;
#pragma unroll
      for (int i = 0; i < 8; ++i) { const int row = 4 * i + (lane >> 4);
          const u32x4 v = *(const LAS u32x4*)(ot + row * 272 + seg * 16);
          *(u32x4*)(og + (size_t)((i >> 2) * 64 + 4 * (i & 3)) * D) = v; } }
}
#undef KRD
#undef TRD

__global__ void __launch_bounds__(NWAVES * 64, 2) fwd_kernel(Args args) {
    extern __shared__ __attribute__((aligned(16))) unsigned char lds_raw[];
    Frame F;
    F.lds = (LAS unsigned char*)lds_raw;
    F.wave = __builtin_amdgcn_readfirstlane((int)threadIdx.x >> 6); F.lane = lane_op(); F.tid = F.wave * 64 + F.lane;
    F.G = gridDim.x; F.gw = blockIdx.x * NWAVES + F.wave; F.NGW = F.G * NWAVES;
    F.out = args.out; F.ws = args.ws;
    unsigned char* ws = args.ws;
    volatile LAS unsigned* MISC = (volatile LAS unsigned*)(F.lds + MISC_OFF);
    for (int u = F.tid; u < (LDS_BYTES - RING_BYTES) / 4; u += NWAVES * 64) ((LAS unsigned*)(F.lds + RING_BYTES))[u] = 0u;
    __syncthreads();
    XcdBarrier bar = xcd_barrier_post((unsigned*)(ws + WS_CTL) + CW_BAR, MISC + 8, F.wave);
    if (F.wave == 0 && lane_id() == 0) { const unsigned x_ = xb_xcc_id(); MISC[12] = xb_add((unsigned*)(ws + WS_CTL) + CW_RANK + 64 * (x_ & 7u), 1u); MISC[13] = x_; }
    __syncthreads();
    const int lo = args.ph_lo, hi = args.ph_hi;
#define IN(k) (lo <= (k) && (k) < hi)
#define PH_BEGIN() do { F.lane = lane_op(); F.tid = F.wave * 64 + F.lane; } while (0)
#ifndef PROBE_MASK
#define PROBE_MASK 0u
#endif
#define STAMP(k) do { if (PROBE_MASK != 0u && blockIdx.x == 0 && F.wave == 0 && lane_id() == 0) ((volatile LAS unsigned long long*)(F.lds + RING_BYTES + 4096))[(k)] = __builtin_amdgcn_s_memrealtime(); } while (0)
#define SEAM(k) do { if (IN(k) && IN((k) + 1)) xcd_barrier(bar); STAMP((k) + 1); } while (0)
    STAMP(0);

    bf16* XB = (bf16*)(ws + WS_XB);
    float* rstd0 = (float*)(ws + WS_RSTD0); float* rstd1 = (float*)(ws + WS_RSTD1); float* rstd2 = (float*)(ws + WS_RSTD2);
    float* ratio = (float*)(ws + WS_RATIO); float* rsssm = (float*)(ws + WS_RSSSM);
    float* psatt = (float*)(ws + WS_PSATT); float* psssm = (float*)(ws + WS_PSSSM); float* psmix = (float*)(ws + WS_PSMIX); float* psm = (float*)(ws + WS_PSM);
    LAS float* scr = (LAS float*)(F.lds + F.wave * 16384);

    if (IN(0)) { PH_BEGIN();
        for (int g = blockIdx.x; g < NG; g += F.G) ssm_tables(F, g);
        constexpr int I_IN = (D / 64) * (NIN / 64), I_GLU = (AW / 64) * (AW / 64), I_OUT = (D / 64) * (D / 64);
        {
            const float* w_in = ARGP(5); const float* g_pre = ARGP(4); const float* w_glu = ARGP(22); const float* w_out = ARGP(26); const float* g_att = ARGP(24); const float* g_ssm = ARGP(25);
            const float* xp = ARGP(0); const float* xs = ARGP(1);
            const float* w_up0 = ARGP(29); const float* g_mlp0 = ARGP(28); const float* w_gt0 = ARGP(33); const float* g_pl0 = ARGP(32);
            unsigned* cmaxU = (unsigned*)(ws + WS_CTL) + CW_CMAXU; unsigned* cmaxG = (unsigned*)(ws + WS_CTL) + CW_CMAXG;
            const float* w_dn0 = ARGP(30); unsigned* cmaxD = (unsigned*)(ws + WS_CTL) + CW_CMAXD; constexpr int I_CD = (DFF / 64) * (D / 64);
            constexpr int I_CU = (D / 64) * (DFF / 64), I_CG = (D / 64) * (D / 64);
            constexpr int NW = I_IN + I_GLU + I_OUT, NIT = NW + T + I_CU + I_CG + I_CD, PRE = 4;
            const int nfree = (F.G > NG ? F.G - NG : 0) * NWAVES, npre = nfree * PRE < NIT ? nfree * PRE : 0;
            auto do_item = [&](int it) {
                int r = it;
                if (r < I_IN) { transpose_item(w_in, D, NIN, (bf16*)(ws + WS_WIN), g_pre, AW, QSCALE, scr, r, F.lane); return; } r -= I_IN;
                if (r < I_GLU) { transpose_item<1>(w_glu, AW, AW, (bf16*)(ws + WS_WGLU), nullptr, AW, WGLU_SCALE, scr, r, F.lane); return; } r -= I_GLU;
                if (r < I_OUT) {
                    const int nblk = D / 64, kb = r / nblk; const int k0 = 64 * kb;
                    const float* gk = k0 < AW ? g_att : g_ssm - AW;
                    transpose_item(w_out, D, D, (bf16*)(ws + WS_WOUT), gk, 0, 1.f, scr, r, F.lane); return; } r -= I_OUT;
                if (r < T) { xb_row(F, xp, xs, r); return; } r -= T;
                if (r < I_CU) { colmax_item(w_up0, DFF, g_mlp0, cmaxU, r, F.lane); return; } r -= I_CU;
                if (r < I_CG) { colmax_item(w_gt0, D, g_pl0, cmaxG, r, F.lane); return; } r -= I_CG;
                colmax_item(w_dn0, D, nullptr, cmaxD, r, F.lane); };
            if ((int)blockIdx.x >= NG) for (int it = ((int)blockIdx.x - NG) * NWAVES + F.wave; it < npre; it += nfree) do_item(it);
            for (int it = npre + F.gw; it < NIT; it += F.NGW) do_item(it);
        }
        const float* pep = ARGP(2); const float* pes = ARGP(3);
        for (int i = F.gw * 64 + F.lane; i < T * PLE / 4; i += F.NGW * 64) { const int m = i / (PLE / 4), c4 = i % (PLE / 4);
            const f32x4 v = ((const f32x4*)perow(pep, pes, m))[c4]; u32x2 w; w.x = cvt_pk_bf16(v[0], v[1]); w.y = cvt_pk_bf16(v[2], v[3]);
            ((u32x2*)(ws + WS_PEB))[i] = w; }
    }
    SEAM(0);
    int vcu = (int)blockIdx.x;
    if (IN(0) && IN(1) && (F.G & 7) == 0) { bool ok = MISC[13] < 8u;
#pragma unroll
        for (int j = 0; j < 8; ++j) ok = ok && (xb_ld((unsigned*)(ws + WS_CTL) + CW_RANK + 64 * j) == (unsigned)(F.G >> 3));
        if (ok) vcu = (int)(MISC[12] * 8u + MISC[13]); }
    vcu = __builtin_amdgcn_readfirstlane(vcu);
    if (IN(1)) { PH_BEGIN();
        pg8::Gemm g{XB, (const bf16*)(ws + WS_WIN), T, NIN, D, F.wave}; pg8::StaticOrder S; S.init(T, NIN, F.G, vcu);
        pg8::EpiProj E{(bf16*)(ws + WS_Q), (bf16*)(ws + WS_UG), rstd0};
        pg8::gemm_phase<pg8::EpiProj, pg8::StaticOrder, true, true>(F.lds, g, S, E);
    }
    SEAM(1);
    if (IN(2)) { PH_BEGIN();
        if (F.G == 256) {
            for (int it = 0; it < 3; ++it) { const int j = it * 32 + (vcu >> 3), blk = 8 * (vcu & 7) + j / 12, cp_ = j - 12 * (j / 12); ssm_stage_a(F, (blk & 3) + 4 * (cp_ + 12 * (blk >> 2))); }
        } else
            for (int unit = vcu; unit < 768; unit += F.G) ssm_stage_a(F, unit);
        const float* rpb = ARGP(6);
        for (int unit = vcu; unit < 1536; unit += F.G) { switch (F.wave & 3) { case 0: attn_unit6<0>(F, rpb, unit); break; case 1: attn_unit6<1>(F, rpb, unit); break; case 2: attn_unit6<2>(F, rpb, unit); break; default: attn_unit6<3>(F, rpb, unit); break; } }
    }
    SEAM(2);
    if (IN(3)) { PH_BEGIN();
        for (int task = F.wave * F.G + blockIdx.x; task < 768; task += F.NGW) { if (task & 1) ssm_scan_task<1>(F, task); else ssm_scan_task<0>(F, task); }
        {
            constexpr int I_UP = (D / 64) * (DFF / 64), I_DN = (DFF / 64) * (D / 64), I_GT = (D / 64) * (D / 64), NITC = I_UP + I_DN + I_GT, PRE = 5;
            const float* w_up = ARGP(29); const float* g_mlp = ARGP(28); const float* w_dn = ARGP(30); const float* w_gt = ARGP(33); const float* g_pl = ARGP(32);
            auto cv_item = [&](int r) {
                if (r < I_UP) { transpose_item<2>(w_up, D, DFF, (bf16*)(ws + WS_WUP), g_mlp, 0, 1.f, scr, r, F.lane, (const float*)(ws + WS_CTL) + CW_CMAXU); return; } r -= I_UP;
                if (r < I_DN) { transpose_item<2>(w_dn, DFF, D, (bf16*)(ws + WS_WDOWN), nullptr, 0, 1.f, scr, r, F.lane, (const float*)(ws + WS_CTL) + CW_CMAXD, (int*)(ws + WS_CTL) + CW_CSUMD); return; } r -= I_DN;
                transpose_item<2>(w_gt, D, D, (bf16*)(ws + WS_WGATE), g_pl, 0, 1.f, scr, r, F.lane, (const float*)(ws + WS_CTL) + CW_CMAXG); };
            const int widx = F.wave * F.G + (int)blockIdx.x, nfree = F.NGW > 768 ? F.NGW - 768 : 0, npre = nfree * PRE < NITC ? nfree * PRE : 0;
            if (widx >= 768) for (int it = widx - 768; it < npre; it += nfree) cv_item(it);
            for (int it = npre + widx; it < NITC; it += F.NGW) cv_item(it);
        }
    }
    SEAM(3);
    if (IN(4)) { PH_BEGIN();
        if (F.G == 256) {
            for (int it = 0; it < 3; ++it) { const int j = it * 32 + (vcu >> 3), blk = 8 * (vcu & 7) + j / 12, cp_ = j - 12 * (j / 12); ssm_stage_c(F, (blk & 3) + 4 * (cp_ + 12 * (blk >> 2))); }
        } else
            for (int unit = vcu; unit < 768; unit += F.G) ssm_stage_c(F, unit);
    }
    SEAM(4);
    if (IN(5)) { PH_BEGIN();
        pg8::Gemm g{(const bf16*)(ws + WS_ZF8), (const bf16*)(ws + WS_WGLU), T, AW, AW / 2, F.wave};   pg8::StaticOrder S; S.init(T, AW, F.G, vcu);
        pg8::EpiGlu E{(const bf16*)(ws + WS_Z), XB, ARGP(23), psssm, 1.0f / WGLU_SCALE};
        pg8::gemm_phase<pg8::EpiGlu, pg8::StaticOrder, true, true, 1>(F.lds, g, S, E);
    }
    SEAM(5);
    if (IN(6)) { PH_BEGIN();
        for (int m = blockIdx.x * 512 + F.tid; m < T; m += F.G * 512) {
            float sa = 0.f, ss = 0.f;
#pragma unroll
            for (int j = 0; j < 4; ++j) { const f32x4 v = ((const f32x4*)(psatt + (size_t)m * 16))[j]; sa += (v[0] + v[1]) + (v[2] + v[3]); }
#pragma unroll
            for (int j = 0; j < 8; ++j) { const f32x4 v = ((const f32x4*)(psssm + (size_t)m * 32))[j]; ss += (v[0] + v[1]) + (v[2] + v[3]); }
            const float ra = 1.0f / sqrtf(sa * (1.0f / AW) + RMS_EPS), rs = 1.0f / sqrtf(ss * (1.0f / AW) + RMS_EPS);
            ratio[m] = ra / rs; rsssm[m] = rs; }
    }
    SEAM(6);
    if (IN(7)) { PH_BEGIN();
        pg8::Gemm g{XB, (const bf16*)(ws + WS_WOUT), T, D, D, F.wave}; pg8::StaticOrder S; S.init(T, D, F.G, vcu);
        pg8::EpiOut E{(bf16*)(ws + WS_MIX), ratio, rsssm, psmix};
        pg8::gemm_phase<pg8::EpiOut, pg8::StaticOrder, true, true>(F.lds, g, S, E);
    }
    SEAM(7);
    if (IN(8)) { PH_BEGIN();
        { const float* xp = ARGP(0); const float* xs = ARGP(1); const float* gpm = ARGP(27);
        f32x4 gg[16];
#pragma unroll
        for (int j = 0; j < 16; ++j) gg[j] = ((const f32x4*)gpm)[F.lane + 64 * j];
        for (int m = F.gw; m < T; m += F.NGW)
            row_pass<false>(F, xrow(xp, xs, m), (const bf16*)(ws + WS_MIX) + (size_t)m * D, psmix + (size_t)m * 64, gg, XB + (size_t)m * D, rstd1 + m, (unsigned char*)(ws + WS_HQ) + (size_t)m * D); }
        { constexpr int I_PL = (PLE / 64) * (D / 64); const float* w_pl = ARGP(34);
          for (int it = F.gw; it < I_PL; it += F.NGW) transpose_item(w_pl, PLE, D, (bf16*)(ws + WS_WPLE), nullptr, 0, 1.f, scr, it, F.lane); }
    }
    SEAM(8);
    auto h2_pass = [&](int chp) {
        const float* gpl = ARGP(31); const int roff = chp * MCHUNK;
        f32x4 gg[16];
#pragma unroll
        for (int j = 0; j < 16; ++j) gg[j] = ((const f32x4*)gpl)[F.lane + 64 * j];
        for (int ml = F.gw; ml < MCHUNK; ml += F.NGW) { const int m = roff + ml;
            row_pass<true>(F, XB + (size_t)m * D, (const bf16*)(ws + WS_MCH) + (size_t)ml * D, psm + (size_t)m * 64, gg, XB + (size_t)m * D, rstd2 + m, (unsigned char*)(ws + WS_HQ) + (size_t)m * D); } };
    for (int ch = 0; ch < NCHUNK; ++ch) {
        const int row_off = ch * MCHUNK;
        if (IN(9 + 3 * ch)) { PH_BEGIN();
            pg8::Gemm g{(const bf16*)(ws + WS_HQ) + (size_t)row_off * (D / 2), (const bf16*)(ws + WS_WUP), MCHUNK, DFF, D / 2, F.wave};   pg8::StaticOrder S; S.init(MCHUNK, DFF, F.G, vcu);
            pg8::EpiUp E{(bf16*)(ws + WS_HBUF), (const float*)(ws + WS_CTL) + CW_CMAXU, row_off, (unsigned*)(ws + WS_CTL) + CW_RMAXH};
            pg8::gemm_phase<pg8::EpiUp, pg8::StaticOrder, true, true, 2>(F.lds, g, S, E);
        }
        SEAM(9 + 3 * ch);
        if (IN(10 + 3 * ch)) { PH_BEGIN();
            const unsigned* rmx = (const unsigned*)(ws + WS_CTL) + CW_RMAXH;
            for (int ml = F.gw; ml < MCHUNK; ml += F.NGW) requant_row(F, (bf16*)(ws + WS_HBUF) + (size_t)ml * DFF, __uint_as_float(rmx[row_off + ml]));
            if (ch > 0) h2_pass(ch - 1);
        }
        SEAM(10 + 3 * ch);
        if (IN(11 + 3 * ch)) { PH_BEGIN();
            pg8::Gemm g{(const bf16*)(ws + WS_HBUF), (const bf16*)(ws + WS_WDOWN), MCHUNK, D, DFF / 2, F.wave, DFF};   pg8::StaticOrder S; S.init(MCHUNK, D, F.G, vcu);
            pg8::EpiDown E{(bf16*)(ws + WS_MCH), psm, row_off, (const unsigned*)(ws + WS_CTL) + CW_RMAXH, (const float*)(ws + WS_CTL) + CW_CMAXD, (const int*)(ws + WS_CTL) + CW_CSUMD, rstd1};
            pg8::gemm_phase<pg8::EpiDown, pg8::StaticOrder, true, true, 2>(F.lds, g, S, E);
        }
        SEAM(11 + 3 * ch);
    }
    if (IN(9 + 3 * NCHUNK)) { PH_BEGIN();
        h2_pass(NCHUNK - 1);
        pg8::Gemm g{(const bf16*)(ws + WS_PEB), (const bf16*)(ws + WS_WPLE), T, D, PLE, F.wave}; pg8::StaticOrder S; S.init(T, D, F.G, vcu);
        pg8::EpiPle E{(bf16*)(ws + WS_PP)};
        pg8::gemm_phase<pg8::EpiPle, pg8::StaticOrder, true, true>(F.lds, g, S, E);
    }
    SEAM(9 + 3 * NCHUNK);
    if (IN(10 + 3 * NCHUNK)) { PH_BEGIN();
        pg8::Gemm g{(const bf16*)(ws + WS_HQ), (const bf16*)(ws + WS_WGATE), T, D, D / 2, F.wave};   pg8::StaticOrder S; S.init(T, D, F.G, vcu);
        pg8::EpiGate E{F.out, (const bf16*)(ws + WS_PP), XB, rstd2, (const float*)(ws + WS_CTL) + CW_CMAXG};
        pg8::gemm_phase<pg8::EpiGate, pg8::StaticOrder, true, true, 2>(F.lds, g, S, E);
    }
    if (PROBE_MASK != 0u && blockIdx.x == 0 && F.wave == 0 && lane_id() == 0) {
        volatile LAS unsigned long long* ts = (volatile LAS unsigned long long*)(F.lds + RING_BYTES + 4096);
        const unsigned long long tend = __builtin_amdgcn_s_memrealtime(); ts[N_PHASES_K] = tend;
        unsigned long long extra = 0ull;
        for (int k = 0; k < N_PHASES_K; ++k) if ((PROBE_MASK >> k) & 1u) extra += ts[k + 1] - ts[k];
        while (__builtin_amdgcn_s_memrealtime() - tend < extra) __builtin_amdgcn_s_sleep(32);
    }
#undef IN
#undef SEAM
}

constexpr int N_PHASES = 11 + 3 * NCHUNK;
#ifndef MK_PER_PHASE
#define MK_PER_PHASE 0
#endif
extern "C" void kernel_launch(void* const* d_in, const int* in_sizes, int n_in, void* d_out, int out_size, void* d_ws, size_t ws_size, hipStream_t stream) {
    static int grid = 0;
    if (grid == 0) {
        if (n_in != 35 || out_size != T * D || ws_size < WS_END) { fprintf(stderr, "kernel_launch: unexpected problem (n_in %d, out %d, ws %zu)\n", n_in, out_size, ws_size); grid = -1; return; }
        int dev = 0, cus = 0;
        if (hipGetDevice(&dev) != hipSuccess || hipDeviceGetAttribute(&cus, hipDeviceAttributeMultiprocessorCount, dev) != hipSuccess) { grid = -1; return; }
        if (hipFuncSetAttribute((const void*)fwd_kernel, hipFuncAttributeMaxDynamicSharedMemorySize, LDS_BYTES) != hipSuccess) { fprintf(stderr, "kernel_launch: hipFuncSetAttribute failed\n"); grid = -1; return; }
        int per_cu = 0;
        if (hipOccupancyMaxActiveBlocksPerMultiprocessor(&per_cu, (const void*)fwd_kernel, NWAVES * 64, LDS_BYTES) != hipSuccess || per_cu < 1) fprintf(stderr, "kernel_launch: occupancy query reports %d\n", per_cu);
        (void)hipGetLastError();
        grid = cus;
    }
    if (grid < 0) return;
    (void)hipMemsetAsync((char*)d_ws + WS_CTL, 0, CTL_ZERO_BYTES, stream);
    Args a{};
    for (int i = 0; i < 35; ++i) a.in[i] = (const float*)d_in[i];
    a.out = (float*)d_out; a.ws = (unsigned char*)d_ws;
#if MK_PER_PHASE
    for (int p = 0; p < N_PHASES; ++p) { a.ph_lo = p; a.ph_hi = p + 1; hipLaunchKernelGGL(fwd_kernel, dim3(grid), dim3(NWAVES * 64), LDS_BYTES, stream, a); }
#else
    a.ph_lo = 0; a.ph_hi = N_PHASES;
    hipLaunchKernelGGL(fwd_kernel, dim3(grid), dim3(NWAVES * 64), LDS_BYTES, stream, a);
#endif
}
```

```cpp
#include <hip/hip_runtime.h>
#include <cstdio>
#include <cstdint>

#define GAS __attribute__((address_space(1)))
#define LAS __attribute__((address_space(3)))
typedef unsigned short bf16;
typedef short bf16x8 __attribute__((ext_vector_type(8)));
typedef float f32x4 __attribute__((ext_vector_type(4)));
typedef float f32x2 __attribute__((ext_vector_type(2)));
typedef unsigned u32x4 __attribute__((ext_vector_type(4)));
typedef unsigned u32x2 __attribute__((ext_vector_type(2)));

constexpr int T = 24576, TPR = 8192, D = 4096, AW = 2048, NH = 16, HD = 128, NG = 128, SP = 64, DFF = 16384, PLE = 256, NIN = 8192;
constexpr float RMS_EPS = 1e-6f;
constexpr float LOG2E = 1.4426950408889634f;
constexpr float QSCALE = 0.08838834764831845f * 1.4426950408889634f;

constexpr size_t MiB = 1u << 20;
constexpr size_t WS_CTL = 0, CTL_ZERO_BYTES = 1 * MiB;
constexpr size_t WS_RSTD0 = 1 * MiB, WS_RSTD1 = WS_RSTD0 + 128 * 1024, WS_RSTD2 = WS_RSTD1 + 128 * 1024, WS_RATIO = WS_RSTD2 + 128 * 1024, WS_RSSSM = WS_RATIO + 128 * 1024;
constexpr size_t WS_PSATT = 2 * MiB, WS_PSSSM = 4 * MiB, WS_PSMIX = 8 * MiB, WS_PSM = 8 * MiB;
constexpr size_t WS_PEB = 24 * MiB;
constexpr size_t WS_KTAB = 14 * MiB, WS_MC = 40 * MiB, WS_MB = 72 * MiB;
constexpr size_t WS_WIN = 104 * MiB, WS_WGLU = 168 * MiB, WS_WOUT = 176 * MiB;
constexpr size_t WS_XB = 208 * MiB;
constexpr size_t WS_Q = 400 * MiB, WS_K = 496 * MiB, WS_V = 592 * MiB, WS_UG = 688 * MiB, WS_Z = 784 * MiB, WS_S = 880 * MiB, WS_HB = 976 * MiB;
constexpr size_t WS_WUP = 400 * MiB, WS_WDOWN = 528 * MiB, WS_WGATE = 656 * MiB, WS_WPLE = 688 * MiB;
constexpr size_t WS_HBUF = 692 * MiB;
constexpr size_t WS_MCH = 36 * MiB;
constexpr size_t WS_PP = 692 * MiB;
constexpr size_t WS_MIX = 692 * MiB;
constexpr size_t WS_ZF8 = 880 * MiB;
constexpr size_t WS_HQ = 104 * MiB;
constexpr float WGLU_SCALE = 64.f;
constexpr size_t WS_END = 1024 * MiB;
constexpr int MCHUNK = 8192, NCHUNK = T / MCHUNK;

constexpr int CW_BAR = 4096;
constexpr int N_PHASES_K = 20;
constexpr int CW_CMAXD = 53248, CW_CSUMD = 57344, CW_RMAXH = 65536;
constexpr int CW_CMAXU = 32768, CW_CMAXG = 49152;
constexpr int CW_RANK = 8192;

constexpr int RING_BYTES = 131072;
constexpr int MISC_OFF = RING_BYTES + 320;
constexpr int LDS_BYTES = 147456;
constexpr int NWAVES = 8;

__device__ __forceinline__ unsigned cvt_pk_bf16(float lo, float hi) { unsigned r; asm volatile("v_cvt_pk_bf16_f32 %0, %1, %2" : "=v"(r) : "v"(lo), "v"(hi)); return r; }
__device__ __forceinline__ float bf_lo(unsigned v) { return __builtin_bit_cast(float, v << 16); }
__device__ __forceinline__ float bf_hi(unsigned v) { return __builtin_bit_cast(float, v & 0xffff0000u); }
__device__ __forceinline__ float wave_sum(float v) {
#pragma unroll
    for (int o = 1; o < 64; o <<= 1) v += __shfl_xor(v, o);
    return v;
}
__device__ __forceinline__ float wave_max(float v) {
#pragma unroll
    for (int o = 1; o < 64; o <<= 1) v = fmaxf(v, __shfl_xor(v, o));
    return v;
}
__device__ __forceinline__ int lane_id() { return (int)__builtin_amdgcn_mbcnt_hi(~0u, __builtin_amdgcn_mbcnt_lo(~0u, 0u)); }
__device__ __forceinline__ int lane_op() { int l = lane_id(); asm volatile("" : "+v"(l)); return l; }
__device__ __forceinline__ unsigned pack4_i8(float a, float b, float c, float d) {
    const int q0 = (int)__builtin_rintf(a), q1 = (int)__builtin_rintf(b), q2 = (int)__builtin_rintf(c), q3 = (int)__builtin_rintf(d);
    return ((unsigned)q0 & 0xFFu) | (((unsigned)q1 & 0xFFu) << 8) | (((unsigned)q2 & 0xFFu) << 16) | ((unsigned)q3 << 24);
}
__device__ __forceinline__ unsigned pack4_i8s(float a, float b, float c, float d, int& sum) {
    const int q0 = (int)__builtin_rintf(a), q1 = (int)__builtin_rintf(b), q2 = (int)__builtin_rintf(c), q3 = (int)__builtin_rintf(d); sum += (q0 + q1) + (q2 + q3);
    return ((unsigned)q0 & 0xFFu) | (((unsigned)q1 & 0xFFu) << 8) | (((unsigned)q2 & 0xFFu) << 16) | ((unsigned)q3 << 24);
}
__device__ __forceinline__ unsigned pack4_fp8(float a, float b, float c, float d) { int p = 0; p = __builtin_amdgcn_cvt_pk_fp8_f32(a, b, p, false); p = __builtin_amdgcn_cvt_pk_fp8_f32(c, d, p, true); return (unsigned)p; }
__device__ __forceinline__ float sigmoidf_(float x) { return __builtin_amdgcn_rcpf(1.0f + __builtin_amdgcn_exp2f(x * -1.4426950408889634f)); }
__device__ __forceinline__ float gelu_tanh(float x) { const float a = (1.5957691216057308f * -1.4426950408889634f) * (x + 0.044715f * x * x * x); return x * __builtin_amdgcn_rcpf(1.0f + __builtin_amdgcn_exp2f(a)); }

namespace pg8 {
#define PG8_LAS __attribute__((address_space(3)))
typedef unsigned short bf16_t;
typedef int v4i_t __attribute__((ext_vector_type(4)));
constexpr int BM = 256, BK = 64, HALF = 128, HTB = HALF * BK * 2, STAGE_BYTES = 8 * HTB, NXCD = 8, WGM = 8;
__host__ __device__ __forceinline__ int lds_byte(int r, int c) { const int st = (r >> 4) * 2 + (c >> 5), rr = r & 15, cc = c & 31, ob = rr * 64 + cc * 2; return st * 1024 + (ob ^ (((ob >> 9) & 1) << 5)); }
__host__ __device__ __forceinline__ void stage_rc(int b, int& R, int& C) { const int st = b / 1024, sb = b % 1024, swz = sb ^ (((sb >> 9) & 1) << 5); R = (st >> 1) * 16 + swz / 64; C = (st & 1) * 32 + (swz % 64) / 2; }
__host__ __device__ __forceinline__ int perm32(int rho) { const int n = rho >> 4, i = rho & 15; return 8 * (i >> 2) + 4 * n + (i & 3); }
struct Unit { int pm, pn; };
struct Gemm { const bf16_t* A; const bf16_t* Bt; int M, N, K, wave, lda; };
struct StaticOrder {
    int nM, nN, nwg, G, c;
    __host__ __device__ void init(int M, int N, int G_, int c_) { nM = M / BM; nN = N / BM; nwg = nM * nN; G = G_; c = c_; }
    __host__ __device__ bool next(int i, Unit& u) const {
        const long L = (long)i * G + c; if (L >= nwg) return false;
        int wgid = (int)L; { const int q = nwg / NXCD, r = nwg % NXCD, xcd = wgid % NXCD, off = wgid / NXCD; wgid = (xcd < r ? xcd * (q + 1) : r * (q + 1) + (xcd - r) * q) + off; }
        const int nig = WGM * nN, gid = wgid / nig, fm = gid * WGM, gsz = (nM - fm) < WGM ? (nM - fm) : WGM;
        u.pm = fm + ((wgid % nig) % gsz); u.pn = (wgid % nig) / gsz; return true;
    }
    __device__ __forceinline__ void a_ready(const Unit&) const {}
    __device__ __forceinline__ void done(const Unit&) const {}
};

template <class Epi, class Sched, bool ALIGN_EPI = false, bool SP2 = false, int MODE = 0  >
__device__ __forceinline__ void gemm_phase(PG8_LAS unsigned char* lds, const Gemm g, const Sched& S, const Epi& E) {
    const int lane = lane_op(), wid = g.wave, tid = wid * 64 + lane, wr = wid >> 2, wc = wid & 3, fr = lane & 15, fq = lane >> 4;
    const int K = g.K, nt = K / BK, LDA = g.lda ? g.lda : g.K;
    unsigned voffA[2], voffB[2];
#pragma unroll
    for (int i = 0; i < 2; ++i) { int R, C; stage_rc(tid * 16 + i * 8192, R, C); const int Rb = Epi::PERM ? ((R & ~31) + perm32(R & 31)) : R;
        voffA[i] = (unsigned)(R * LDA + C) * 2u; voffB[i] = (unsigned)(Rb * K + C) * 2u; }
    const size_t kstep = (size_t)(BK * 2);
    const size_t hstep = (size_t)HALF * K * 2, hstepA = (size_t)HALF * LDA * 2;
    const size_t tstep = 2 * hstep, tstepA = 2 * hstepA;
    const unsigned ldsw = (unsigned)wid * 1024u;
    const int aoff = lds_byte(wr * 64 + fr, fq * 8), boff = lds_byte(wc * 32 + fr, fq * 8);
#define PG8_SA(b, h) (((b) * 2 + (h)) * HTB)
#define PG8_SB(b, h) ((4 + (b) * 2 + (h)) * HTB)
#define PG8_STAGE(bufoff, gbase, voff) do { _Pragma("unroll") for (int _i = 0; _i < 2; ++_i) \
        __builtin_amdgcn_global_load_lds((const unsigned*)((const char*)(gbase) + (voff)[_i]), (PG8_LAS unsigned*)(lds + (bufoff) + ldsw + _i * 8192), 16, 0, 0); } while (0)
#define PG8_LDA(dst, b, h) do { _Pragma("unroll") for (int m = 0; m < 4; ++m) _Pragma("unroll") for (int k = 0; k < 2; ++k) dst[m][k] = *(const PG8_LAS bf16x8*)(lds + PG8_SA(b, h) + aoff + m * 2048 + k * 1024); } while (0)
#define PG8_LDB(dst, b, h) do { _Pragma("unroll") for (int n = 0; n < 2; ++n) _Pragma("unroll") for (int k = 0; k < 2; ++k) dst[n][k] = *(const PG8_LAS bf16x8*)(lds + PG8_SB(b, h) + boff + n * 2048 + k * 1024); } while (0)
#define PG8_CAT(x0, x1) __builtin_shufflevector(__builtin_bit_cast(v4i_t, x0), __builtin_bit_cast(v4i_t, x1), 0, 1, 2, 3, 4, 5, 6, 7)
#define PG8_MMA(ai, bj, At, Bt) do { __builtin_amdgcn_s_setprio(1); \
        if constexpr (MODE == 2) { _Pragma("unroll") for (int m = 0; m < 4; ++m) _Pragma("unroll") for (int n = 0; n < 2; ++n) _Pragma("unroll") for (int k = 0; k < 2; ++k) \
            acc[ai][bj][m][n] = __builtin_bit_cast(f32x4, __builtin_amdgcn_mfma_i32_16x16x64_i8(__builtin_bit_cast(v4i_t, Bt[n][k]), __builtin_bit_cast(v4i_t, At[m][k]), __builtin_bit_cast(v4i_t, acc[ai][bj][m][n]), 0, 0, 0)); } \
        else if constexpr (MODE == 1) { _Pragma("unroll") for (int m = 0; m < 4; ++m) _Pragma("unroll") for (int n = 0; n < 2; ++n) \
            asm volatile("v_mfma_scale_f32_16x16x128_f8f6f4 %0, %1, %2, %0, %3, %3 op_sel_hi:[0,0,0]" : "+v"(acc[ai][bj][m][n]) : "v"(PG8_CAT(Bt[n][0], Bt[n][1])), "v"(PG8_CAT(At[m][0], At[m][1])), "v"(f8scale)); } \
        else { _Pragma("unroll") for (int m = 0; m < 4; ++m) _Pragma("unroll") for (int n = 0; n < 2; ++n) _Pragma("unroll") for (int k = 0; k < 2; ++k) \
            acc[ai][bj][m][n] = __builtin_amdgcn_mfma_f32_16x16x32_bf16(Bt[n][k], At[m][k], acc[ai][bj][m][n], 0, 0, 0); } \
        __builtin_amdgcn_s_setprio(0); } while (0)
#define PG8_WAIT_V(n) asm volatile("s_waitcnt vmcnt(" #n ")" ::: "memory")
#define PG8_WAIT_L(n) asm volatile("s_waitcnt lgkmcnt(" #n ")" ::: "memory")
#define PG8_BAR __builtin_amdgcn_s_barrier()
#define PG8_SCHED __builtin_amdgcn_sched_barrier(0)
    Unit cur, nxt; int ui = 0;
    if (!S.next(0, cur)) return;
    f32x4 acc[2][2][4][2];
#pragma unroll
    for (int a = 0; a < 2; ++a)
#pragma unroll
        for (int b = 0; b < 2; ++b)
#pragma unroll
            for (int m = 0; m < 4; ++m)
#pragma unroll
                for (int n = 0; n < 2; ++n) acc[a][b][m][n] = (f32x4){0.f, 0.f, 0.f, 0.f};
    bf16x8 At[4][2], B0[2][2], B1[2][2];
    const int f8scale = 0x7F7F7F7F;
    const char* cA = (const char*)g.A + (size_t)cur.pm * tstepA; const char* cB = (const char*)g.Bt + (size_t)cur.pn * tstep;
    S.a_ready(cur);
    if constexpr (SP2) {
        PG8_STAGE(PG8_SB(0, 0), cB, voffB); PG8_STAGE(PG8_SB(0, 1), cB + hstep, voffB); PG8_STAGE(PG8_SA(0, 0), cA, voffA); PG8_STAGE(PG8_SA(0, 1), cA + hstepA, voffA);
        if (wr == 1) PG8_BAR;
        PG8_WAIT_V(2); PG8_BAR;
        PG8_STAGE(PG8_SB(1, 0), cB + kstep, voffB); PG8_STAGE(PG8_SA(1, 0), cA + kstep, voffA); PG8_STAGE(PG8_SB(1, 1), cB + hstep + kstep, voffB);
        PG8_WAIT_V(6); PG8_BAR;
    } else {
        PG8_STAGE(PG8_SB(0, 0), cB, voffB); PG8_STAGE(PG8_SA(0, 0), cA, voffA); PG8_STAGE(PG8_SB(0, 1), cB + hstep, voffB); PG8_STAGE(PG8_SA(0, 1), cA + hstepA, voffA);
        if (wr == 1) PG8_BAR;
        PG8_WAIT_V(4); PG8_BAR;
        PG8_STAGE(PG8_SB(1, 0), cB + kstep, voffB); PG8_STAGE(PG8_SA(1, 0), cA + kstep, voffA); PG8_STAGE(PG8_SB(1, 1), cB + hstep + kstep, voffB);
        PG8_WAIT_V(6); PG8_BAR;
    }
    for (;;) {
        const bool has_next = S.next(ui + 1, nxt);
        const char* nA = has_next ? (const char*)g.A + (size_t)nxt.pm * tstepA : cA; const char* nB = has_next ? (const char*)g.Bt + (size_t)nxt.pn * tstep : cB;
#pragma nounroll
        for (int t = 0; t < nt; t += 2) {
            const bool last = (t == nt - 2);
            const char* a1 = cA + (size_t)(t + 1) * kstep;
            const char* a2 = last ? nA : cA + (size_t)(t + 2) * kstep; const char* b2 = last ? nB : cB + (size_t)(t + 2) * kstep;
            const char* a3 = a2 + kstep; const char* b3 = b2 + kstep;
            if (last && has_next) S.a_ready(nxt);
            if constexpr (Epi::MIDK) { if (t == (nt >> 1)) E.midk(acc, cur, wr, wc, fr, fq); }
            if constexpr (SP2) {
            PG8_LDB(B0, 0, 0); PG8_LDB(B1, 0, 1); PG8_SCHED; PG8_LDA(At, 0, 0); PG8_STAGE(PG8_SA(1, 1), a1 + hstepA, voffA);
            PG8_WAIT_V(8); PG8_WAIT_L(0); PG8_BAR; PG8_MMA(0, 0, At, B0); PG8_MMA(0, 1, At, B1); PG8_BAR; PG8_SCHED;
            PG8_LDA(At, 0, 1); PG8_STAGE(PG8_SB(0, 0), b2, voffB); PG8_STAGE(PG8_SB(0, 1), b2 + hstep, voffB); PG8_STAGE(PG8_SA(0, 0), a2, voffA);
            PG8_WAIT_V(8); PG8_WAIT_L(0); PG8_BAR; PG8_MMA(1, 0, At, B0); PG8_MMA(1, 1, At, B1); PG8_BAR; PG8_SCHED;
            PG8_LDB(B0, 1, 0); PG8_LDB(B1, 1, 1); PG8_SCHED; PG8_LDA(At, 1, 0); PG8_STAGE(PG8_SA(0, 1), a2 + hstepA, voffA);
            PG8_WAIT_V(8); PG8_WAIT_L(0); PG8_BAR; PG8_MMA(0, 0, At, B0); PG8_MMA(0, 1, At, B1); PG8_BAR; PG8_SCHED;
            PG8_LDA(At, 1, 1); PG8_STAGE(PG8_SB(1, 0), b3, voffB); PG8_STAGE(PG8_SB(1, 1), b3 + hstep, voffB); PG8_STAGE(PG8_SA(1, 0), a3, voffA);
            PG8_WAIT_V(8); PG8_WAIT_L(0); PG8_BAR; PG8_MMA(1, 0, At, B0); PG8_MMA(1, 1, At, B1); PG8_BAR; PG8_SCHED;
            } else {
            PG8_LDB(B0, 0, 0); PG8_SCHED; PG8_LDA(At, 0, 0); PG8_STAGE(PG8_SA(1, 1), a1 + hstepA, voffA);
            PG8_WAIT_L(8); PG8_BAR; PG8_WAIT_L(0); PG8_MMA(0, 0, At, B0); PG8_BAR; PG8_SCHED;
            PG8_LDB(B1, 0, 1); PG8_STAGE(PG8_SB(0, 0), b2, voffB);
            PG8_BAR; PG8_WAIT_L(0); PG8_MMA(0, 1, At, B1); PG8_BAR;
            PG8_LDA(At, 0, 1); PG8_STAGE(PG8_SA(0, 0), a2, voffA);
            PG8_BAR; PG8_WAIT_L(0); PG8_MMA(1, 0, At, B0); PG8_BAR; PG8_SCHED;
            PG8_STAGE(PG8_SB(0, 1), b2 + hstep, voffB);
            PG8_WAIT_V(6); PG8_BAR; PG8_MMA(1, 1, At, B1); PG8_BAR;
            PG8_LDB(B0, 1, 0); PG8_SCHED; PG8_LDA(At, 1, 0); PG8_STAGE(PG8_SA(0, 1), a2 + hstepA, voffA);
            PG8_WAIT_L(8); PG8_BAR; PG8_WAIT_L(0); PG8_MMA(0, 0, At, B0); PG8_BAR; PG8_SCHED;
            PG8_LDB(B1, 1, 1); PG8_STAGE(PG8_SB(1, 0), b3, voffB);
            PG8_BAR; PG8_WAIT_L(0); PG8_MMA(0, 1, At, B1); PG8_BAR;
            PG8_LDA(At, 1, 1); PG8_STAGE(PG8_SA(1, 0), a3, voffA);
            PG8_BAR; PG8_WAIT_L(0); PG8_MMA(1, 0, At, B0); PG8_BAR; PG8_SCHED;
            PG8_STAGE(PG8_SB(1, 1), b3 + hstep, voffB);
            PG8_WAIT_V(6); PG8_BAR; PG8_MMA(1, 1, At, B1); PG8_BAR;
            }
        }
        if constexpr (MODE == 1) asm volatile("s_nop 15\n\ts_nop 15" ::: "memory");
        if constexpr (ALIGN_EPI) { if (wr == 0) PG8_BAR; }
        E(acc, cur, wr, wc, fr, fq); S.done(cur);
        if (!has_next) break;
#pragma unroll
        for (int a = 0; a < 2; ++a)
#pragma unroll
            for (int b = 0; b < 2; ++b)
#pragma unroll
                for (int m = 0; m < 4; ++m)
#pragma unroll
                    for (int n = 0; n < 2; ++n) acc[a][b][m][n] = (f32x4){0.f, 0.f, 0.f, 0.f};
        cur = nxt; cA = nA; cB = nB; ++ui;
        if constexpr (ALIGN_EPI) { if (wr == 1) PG8_BAR; }
    }
    PG8_WAIT_V(0);
    if constexpr (!ALIGN_EPI) { if (wr == 0) PG8_BAR; }
    PG8_BAR;
#undef PG8_SA
#undef PG8_SB
#undef PG8_STAGE
#undef PG8_LDA
#undef PG8_LDB
#undef PG8_MMA
#undef PG8_CAT
#undef PG8_WAIT_V
#undef PG8_WAIT_L
#undef PG8_BAR
#undef PG8_SCHED
}

typedef f32x4 Acc[2][2][4][2];

struct EpiProj {
    static constexpr bool PERM = true, MIDK = false;
    bf16_t *Q, *Ug; const float* rstd;
    __device__ __forceinline__ void operator()(const Acc& acc, const Unit& u, int wr, int wc, int fr, int fq) const {
        const int row0 = u.pm * BM + wr * 64 + fr; const int t = u.pn >> 3;
        const int colt = (u.pn & 7) * BM + wc * 32 + 8 * fq;
        bf16_t* base = Q + (size_t)t * ((size_t)T * AW);
#pragma unroll
        for (int ai = 0; ai < 2; ++ai)
#pragma unroll
            for (int m = 0; m < 4; ++m) { const int row = row0 + ai * HALF + m * 16; const float rs = rstd[row];
#pragma unroll
                for (int bj = 0; bj < 2; ++bj) { const f32x4 v0 = acc[ai][bj][m][0] * rs, v1 = acc[ai][bj][m][1] * rs;
                    u32x4 w; w.x = cvt_pk_bf16(v0[0], v0[1]); w.y = cvt_pk_bf16(v0[2], v0[3]); w.z = cvt_pk_bf16(v1[0], v1[1]); w.w = cvt_pk_bf16(v1[2], v1[3]);
                    const int col = colt + bj * HALF;
                    if (t == 0) *(u32x4*)(base + (size_t)row * AW + col) = w;
                    else if (t < 3) *(u32x4*)(base + (size_t)row * AW + ((((col >> 7) + row) & 15) << 7) + (col & 127)) = w;
                    else *(u32x4*)(Ug + ((size_t)(((col >> 4) * 24 + (row >> 10)) * 32 + (row & 31)) * 64 + ((row >> 5) & 31) + 4 * (col & 8)) * 8) = w; } }
    }
};
struct EpiGlu {
    static constexpr bool PERM = true, MIDK = false;
    const bf16_t* Z; bf16_t* cat; const float* bglu; float* ps; float ws_;
    __device__ __forceinline__ void operator()(const Acc& acc, const Unit& u, int wr, int wc, int fr, int fq) const {
        const int row0 = u.pm * BM + wr * 64 + fr; const int col0 = u.pn * BM + wc * 32 + 8 * fq;
        f32x4 bv[2][2];
#pragma unroll
        for (int bj = 0; bj < 2; ++bj)
#pragma unroll
            for (int n = 0; n < 2; ++n) bv[bj][n] = *(const f32x4*)(bglu + col0 + bj * HALF + 4 * n);
#pragma unroll
        for (int ai = 0; ai < 2; ++ai)
#pragma unroll
            for (int m = 0; m < 4; ++m) { const int row = row0 + ai * HALF + m * 16; float ssq = 0.f;
#pragma unroll
                for (int bj = 0; bj < 2; ++bj) { const int col = col0 + bj * HALF;
                    const u32x4 zr = *(const u32x4*)(Z + (size_t)row * AW + col);
                    const f32x4 a0 = acc[ai][bj][m][0] * ws_ + bv[bj][0], a1 = acc[ai][bj][m][1] * ws_ + bv[bj][1];
                    f32x4 s0, s1;
                    s0[0] = bf_lo(zr.x) * sigmoidf_(a0[0]); s0[1] = bf_hi(zr.x) * sigmoidf_(a0[1]); s0[2] = bf_lo(zr.y) * sigmoidf_(a0[2]); s0[3] = bf_hi(zr.y) * sigmoidf_(a0[3]);
                    s1[0] = bf_lo(zr.z) * sigmoidf_(a1[0]); s1[1] = bf_hi(zr.z) * sigmoidf_(a1[1]); s1[2] = bf_lo(zr.w) * sigmoidf_(a1[2]); s1[3] = bf_hi(zr.w) * sigmoidf_(a1[3]);
                    ssq += (s0[0] * s0[0] + s0[1] * s0[1]) + (s0[2] * s0[2] + s0[3] * s0[3]) + (s1[0] * s1[0] + s1[1] * s1[1]) + (s1[2] * s1[2] + s1[3] * s1[3]);
                    u32x4 w; w.x = cvt_pk_bf16(s0[0], s0[1]); w.y = cvt_pk_bf16(s0[2], s0[3]); w.z = cvt_pk_bf16(s1[0], s1[1]); w.w = cvt_pk_bf16(s1[2], s1[3]);
                    *(u32x4*)(cat + (size_t)row * D + AW + col) = w; }
                ssq += __shfl_xor(ssq, 16); ssq += __shfl_xor(ssq, 32);
                if (fq == 0) ps[(size_t)row * 32 + u.pn * 4 + wc] = ssq;
                asm volatile("" ::: "memory"); }
    }
};
struct EpiOut {
    static constexpr bool PERM = true, MIDK = true;
    bf16_t* out; const float* ratio; const float* rsssm; float* ps;
    __device__ __forceinline__ void midk(Acc& acc, const Unit& u, int wr, int wc, int fr, int fq) const {
        const int row0 = u.pm * BM + wr * 64 + fr;
#pragma unroll
        for (int ai = 0; ai < 2; ++ai)
#pragma unroll
            for (int m = 0; m < 4; ++m) { const float r = ratio[row0 + ai * HALF + m * 16];
#pragma unroll
                for (int bj = 0; bj < 2; ++bj)
#pragma unroll
                    for (int n = 0; n < 2; ++n) acc[ai][bj][m][n] = acc[ai][bj][m][n] * r; }
    }
    __device__ __forceinline__ void operator()(const Acc& acc, const Unit& u, int wr, int wc, int fr, int fq) const {
        const int row0 = u.pm * BM + wr * 64 + fr; const int col0 = u.pn * BM + wc * 32 + 8 * fq;
#pragma unroll
        for (int ai = 0; ai < 2; ++ai)
#pragma unroll
            for (int m = 0; m < 4; ++m) { const int row = row0 + ai * HALF + m * 16; const float rs = rsssm[row]; float ssq = 0.f;
#pragma unroll
                for (int bj = 0; bj < 2; ++bj) { const f32x4 v0 = acc[ai][bj][m][0] * rs, v1 = acc[ai][bj][m][1] * rs;
                    ssq += (v0[0] * v0[0] + v0[1] * v0[1]) + (v0[2] * v0[2] + v0[3] * v0[3]) + (v1[0] * v1[0] + v1[1] * v1[1]) + (v1[2] * v1[2] + v1[3] * v1[3]);
                    u32x4 w; w.x = cvt_pk_bf16(v0[0], v0[1]); w.y = cvt_pk_bf16(v0[2], v0[3]); w.z = cvt_pk_bf16(v1[0], v1[1]); w.w = cvt_pk_bf16(v1[2], v1[3]);
                    *(u32x4*)(out + (size_t)row * D + col0 + bj * HALF) = w; }
                ssq += __shfl_xor(ssq, 16); ssq += __shfl_xor(ssq, 32);
                if (fq == 0) ps[(size_t)row * 64 + u.pn * 4 + wc] = ssq; }
    }
};
struct EpiUp {
    static constexpr bool PERM = true, MIDK = false;
    bf16_t* H; const float* cmax; int row_off; unsigned* rmax;
    __device__ __forceinline__ void operator()(const Acc& acc, const Unit& u, int wr, int wc, int fr, int fq) const {
        const int row0 = u.pm * BM + wr * 64 + fr; const int col0 = u.pn * BM + wc * 32 + 8 * fq;
        f32x2 c2[2][4];
#pragma unroll
        for (int bj = 0; bj < 2; ++bj) { const f32x4 ca = *(const f32x4*)(cmax + col0 + bj * HALF), cb = *(const f32x4*)(cmax + col0 + bj * HALF + 4);
            c2[bj][0] = (f32x2){ca[0] * ca[0], ca[1] * ca[1]}; c2[bj][1] = (f32x2){ca[2] * ca[2], ca[3] * ca[3]}; c2[bj][2] = (f32x2){cb[0] * cb[0], cb[1] * cb[1]}; c2[bj][3] = (f32x2){cb[2] * cb[2], cb[3] * cb[3]}; }
#pragma unroll
        for (int ai = 0; ai < 2; ++ai)
#pragma unroll
            for (int m = 0; m < 4; ++m) { const int row = row0 + ai * HALF + m * 16; unsigned hm = 0u;
#pragma unroll
                for (int bj = 0; bj < 2; ++bj) { const v4i_t i0 = __builtin_bit_cast(v4i_t, acc[ai][bj][m][0]), i1 = __builtin_bit_cast(v4i_t, acc[ai][bj][m][1]);
                    f32x2 p0 = (f32x2){(float)max(i0[0], 0), (float)max(i0[1], 0)}, p1 = (f32x2){(float)max(i0[2], 0), (float)max(i0[3], 0)};
                    f32x2 p2 = (f32x2){(float)max(i1[0], 0), (float)max(i1[1], 0)}, p3 = (f32x2){(float)max(i1[2], 0), (float)max(i1[3], 0)};
                    p0 = (p0 * p0) * c2[bj][0]; p1 = (p1 * p1) * c2[bj][1]; p2 = (p2 * p2) * c2[bj][2]; p3 = (p3 * p3) * c2[bj][3];
                    u32x4 w; w.x = cvt_pk_bf16(p0.x, p0.y); w.y = cvt_pk_bf16(p1.x, p1.y); w.z = cvt_pk_bf16(p2.x, p2.y); w.w = cvt_pk_bf16(p3.x, p3.y);
                    const unsigned hi4 = max(max(w.x >> 16, w.y >> 16), max(w.z >> 16, w.w >> 16)), lo4 = max(max(w.x & 0xffffu, w.y & 0xffffu), max(w.z & 0xffffu, w.w & 0xffffu));
                    hm = max(hm, max(hi4, lo4));
                    *(u32x4*)(H + (size_t)row * DFF + col0 + bj * HALF) = w; }
                unsigned hx = (unsigned)__shfl_xor((int)hm, 16); hm = max(hm, hx); hx = (unsigned)__shfl_xor((int)hm, 32); hm = max(hm, hx);
                if (fq == 0) atomicMax(rmax + row_off + row, hm << 16); }
    }
};
struct EpiDown {
    static constexpr bool PERM = true, MIDK = false;
    bf16_t* Mo; float* ps; int row_off; const unsigned* rmax; const float* cmax; const int* csum; const float* rs1;
    __device__ __forceinline__ void operator()(const Acc& acc, const Unit& u, int wr, int wc, int fr, int fq) const {
        const int row0 = u.pm * BM + wr * 64 + fr; const int col0 = u.pn * BM + wc * 32 + 8 * fq;
        f32x2 cw[2][4]; v4i_t cz[2][2];
#pragma unroll
        for (int bj = 0; bj < 2; ++bj) { const f32x4 ca = *(const f32x4*)(cmax + col0 + bj * HALF) * (1.0f / 127.0f), cb = *(const f32x4*)(cmax + col0 + bj * HALF + 4) * (1.0f / 127.0f);
            cw[bj][0] = (f32x2){ca[0], ca[1]}; cw[bj][1] = (f32x2){ca[2], ca[3]}; cw[bj][2] = (f32x2){cb[0], cb[1]}; cw[bj][3] = (f32x2){cb[2], cb[3]};
            cz[bj][0] = *(const v4i_t*)(csum + col0 + bj * HALF) * 128; cz[bj][1] = *(const v4i_t*)(csum + col0 + bj * HALF + 4) * 128; }
#pragma unroll
        for (int ai = 0; ai < 2; ++ai)
#pragma unroll
            for (int m = 0; m < 4; ++m) { const int row = row0 + ai * HALF + m * 16; const float r1 = rs1[row_off + row];
                const float sa = __uint_as_float(rmax[row_off + row]) * (1.0f / 255.0f) * r1 * r1; const f32x2 sa2 = (f32x2){sa, sa}; f32x2 sq = (f32x2){0.f, 0.f};
#pragma unroll
                for (int bj = 0; bj < 2; ++bj) { const v4i_t i0 = __builtin_bit_cast(v4i_t, acc[ai][bj][m][0]) + cz[bj][0], i1 = __builtin_bit_cast(v4i_t, acc[ai][bj][m][1]) + cz[bj][1];
                    f32x2 p0 = (f32x2){(float)i0[0], (float)i0[1]}, p1 = (f32x2){(float)i0[2], (float)i0[3]}, p2 = (f32x2){(float)i1[0], (float)i1[1]}, p3 = (f32x2){(float)i1[2], (float)i1[3]};
                    p0 = (p0 * cw[bj][0]) * sa2; p1 = (p1 * cw[bj][1]) * sa2; p2 = (p2 * cw[bj][2]) * sa2; p3 = (p3 * cw[bj][3]) * sa2;
                    sq = p0 * p0 + sq; sq = p1 * p1 + sq; sq = p2 * p2 + sq; sq = p3 * p3 + sq;
                    u32x4 w; w.x = cvt_pk_bf16(p0.x, p0.y); w.y = cvt_pk_bf16(p1.x, p1.y); w.z = cvt_pk_bf16(p2.x, p2.y); w.w = cvt_pk_bf16(p3.x, p3.y);
                    *(u32x4*)(Mo + (size_t)row * D + col0 + bj * HALF) = w; }
                float ssq = sq.x + sq.y; ssq += __shfl_xor(ssq, 16); ssq += __shfl_xor(ssq, 32);
                if (fq == 0) ps[(size_t)(row_off + row) * 64 + u.pn * 4 + wc] = ssq; }
    }
};
struct EpiPle {
    static constexpr bool PERM = true, MIDK = false;
    bf16_t* P;
    __device__ __forceinline__ void operator()(const Acc& acc, const Unit& u, int wr, int wc, int fr, int fq) const {
        const int row0 = u.pm * BM + wr * 64 + fr; const int col0 = u.pn * BM + wc * 32 + 8 * fq;
#pragma unroll
        for (int ai = 0; ai < 2; ++ai)
#pragma unroll
            for (int m = 0; m < 4; ++m) { const int row = row0 + ai * HALF + m * 16;
#pragma unroll
                for (int bj = 0; bj < 2; ++bj) { const f32x4 v0 = acc[ai][bj][m][0], v1 = acc[ai][bj][m][1];
                    u32x4 w; w.x = cvt_pk_bf16(v0[0], v0[1]); w.y = cvt_pk_bf16(v0[2], v0[3]); w.z = cvt_pk_bf16(v1[0], v1[1]); w.w = cvt_pk_bf16(v1[2], v1[3]);
                    *(u32x4*)(P + (size_t)row * D + col0 + bj * HALF) = w; } }
    }
};
struct EpiGate {
    static constexpr bool PERM = false, MIDK = false;
    float* out; const bf16_t* P; const bf16_t* H2; const float* rstd; const float* cmax;
    __device__ __forceinline__ void operator()(const Acc& acc, const Unit& u, int wr, int wc, int fr, int fq) const {
        const int row0 = u.pm * BM + wr * 64 + fr; const int col0 = u.pn * BM + wc * 32 + 4 * fq;
#pragma unroll
        for (int ai = 0; ai < 2; ++ai)
#pragma unroll
            for (int m = 0; m < 4; ++m) { const int row = row0 + ai * HALF + m * 16; const float rs = rstd[row];
#pragma unroll
                for (int bj = 0; bj < 2; ++bj)
#pragma unroll
                    for (int n = 0; n < 2; ++n) { const size_t off = (size_t)row * D + col0 + bj * HALF + n * 16;
                        const u32x2 hr = *(const u32x2*)(H2 + off); const u32x2 pr = *(const u32x2*)(P + off); const v4i_t ia = __builtin_bit_cast(v4i_t, acc[ai][bj][m][n]); const f32x4 cw = *(const f32x4*)(cmax + col0 + bj * HALF + n * 16);
                        f32x4 a; a[0] = (float)ia[0] * rs * cw[0]; a[1] = (float)ia[1] * rs * cw[1]; a[2] = (float)ia[2] * rs * cw[2]; a[3] = (float)ia[3] * rs * cw[3];
                        f32x4 o; o[0] = bf_lo(hr.x) + bf_lo(pr.x) * sigmoidf_(a[0]); o[1] = bf_hi(hr.x) + bf_hi(pr.x) * sigmoidf_(a[1]); o[2] = bf_lo(hr.y) + bf_lo(pr.y) * sigmoidf_(a[2]); o[3] = bf_hi(hr.y) + bf_hi(pr.y) * sigmoidf_(a[3]);
                        *(f32x4*)(out + off) = o; }
                asm volatile("" ::: "memory"); }
    }
};
}

#define XB_TMO      128
#define XB_XCNT(j)  (256  + 64 * (j))
#define XB_XSUB(j)  (1280 + 64 * (j))
#define XB_XGEN(j)  (2304 + 64 * (j))
#define XB_TOP      3328
#define XB_TOPGEN   3392
#define XCD_BAR_WORDS 3456
#define XB_SPIN_CAP (1u << 18)
__device__ __forceinline__ unsigned xb_ld(unsigned* p)              { return __hip_atomic_load(p, __ATOMIC_RELAXED, __HIP_MEMORY_SCOPE_AGENT); }
__device__ __forceinline__ unsigned xb_add(unsigned* p, unsigned v) { return __hip_atomic_fetch_add(p, v, __ATOMIC_RELAXED, __HIP_MEMORY_SCOPE_AGENT); }
__device__ __forceinline__ unsigned xb_xcc_id() { return (unsigned)__builtin_amdgcn_s_getreg((3 << 11) | 20) & 0xFu; }
#define XB_SPIN(cond, bar) do { unsigned _sp = 0; while (cond) { __builtin_amdgcn_s_sleep(1); \
    if ((++_sp & 255u) == 0u) { if (xb_ld(&(bar)[XB_TMO])) break; if (_sp > XB_SPIN_CAP) { atomicAdd(&(bar)[XB_TMO], 1u); break; } } } } while (0)
struct XcdBarrier { unsigned* bar; unsigned x; volatile LAS unsigned* st; int wave; };
__device__ __forceinline__ XcdBarrier xcd_barrier_post(unsigned* bar, volatile LAS unsigned* st, int wave) {
    XcdBarrier b; b.bar = bar; b.x = xb_xcc_id(); b.st = st; b.wave = wave;
    if (wave == 0 && lane_id() == 0) (void)xb_add(&bar[XB_XCNT(b.x)], 1u);
    return b;
}
__device__ __forceinline__ void xcd_barrier_complete(unsigned* bar, unsigned x, unsigned& nloc, unsigned& nx) {
    const unsigned G = gridDim.x * gridDim.y * gridDim.z;
    unsigned sum, cnt, mine, sp = 0u;
    for (;;) {
        sum = 0u; cnt = 0u; mine = 0u;
#pragma unroll
        for (unsigned j = 0; j < 16; ++j) { const unsigned c = xb_ld(&bar[XB_XCNT(j)]); sum += c; cnt += (c > 0u) ? 1u : 0u; mine = (j == x) ? c : mine; }
        if (sum == G) break;
        __builtin_amdgcn_s_sleep(1);
        if ((++sp & 255u) == 0u) { if (xb_ld(&bar[XB_TMO])) break; if (sp > XB_SPIN_CAP) { atomicAdd(&bar[XB_TMO], 1u); break; } }
    }
    nloc = mine > 0u ? mine : 1u; nx = cnt > 0u ? cnt : 1u;
}
__device__ __forceinline__ void xcd_barrier(const XcdBarrier& b) {
    asm volatile("s_waitcnt vmcnt(0)" ::: "memory");
    __syncthreads();
    if (b.wave == 0 && lane_id() == 0) {
        unsigned* bar = b.bar;
        __builtin_amdgcn_s_waitcnt(0);
        unsigned nloc = b.st[0], nx = b.st[1];
        if (nloc == 0u) { xcd_barrier_complete(bar, b.x, nloc, nx); b.st[0] = nloc; b.st[1] = nx; }
        const unsigned old = xb_add(&bar[XB_XSUB(b.x)], 1u);
        const unsigned gen = old / nloc;
        if (old + 1u == (gen + 1u) * nloc) {
            __builtin_amdgcn_fence(__ATOMIC_RELEASE, "agent");
            asm volatile("s_waitcnt vmcnt(0)" ::: "memory");
            const unsigned og = xb_add(&bar[XB_TOP], 1u);
            const unsigned tg = og / nx;
            if (og + 1u == (tg + 1u) * nx) xb_add(&bar[XB_TOPGEN], 1u);
            else XB_SPIN(xb_ld(&bar[XB_TOPGEN]) == tg, bar);
            __builtin_amdgcn_fence(__ATOMIC_ACQUIRE, "agent");
            xb_add(&bar[XB_XGEN(b.x)], 1u);
            asm volatile("s_waitcnt vmcnt(0)" ::: "memory");
        } else {
            XB_SPIN(xb_ld(&bar[XB_XGEN(b.x)]) == gen, bar);
            __builtin_amdgcn_fence(__ATOMIC_ACQUIRE, "agent");
            asm volatile("s_waitcnt vmcnt(0)" ::: "memory");
        }
    }
    __syncthreads();
}

struct Args { const float* in[35]; float* out; unsigned char* ws; int ph_lo, ph_hi; };
template <int I> __device__ __forceinline__ const float* argp() {
    const unsigned long long kp = (unsigned long long)__builtin_amdgcn_kernarg_segment_ptr(); unsigned long long v;
    asm volatile("s_load_dwordx2 %0, %1, %2\n\ts_waitcnt lgkmcnt(0)" : "=s"(v) : "s"(kp), "n"(I * 8) : "memory");
    return (const float*)v;
}
#define ARGP(i) argp<(i)>()
struct Frame {
    LAS unsigned char* lds;
    int tid, lane, wave, G, gw, NGW;
    float* out; unsigned char* ws;
};
#define LDS_WAIT() asm volatile("s_waitcnt lgkmcnt(0)" ::: "memory")

__device__ __forceinline__ const float* xrow(const float* xp, const float* xs, int m) { return m < TPR ? xp + (size_t)m * D : xs + (size_t)(m - TPR) * D; }
__device__ __forceinline__ const float* perow(const float* pp_, const float* ps_, int m) { return m < TPR ? pp_ + (size_t)m * PLE : ps_ + (size_t)(m - TPR) * PLE; }

template <int OUT = 0> __device__ __forceinline__ void transpose_item(const float* W, int K, int N, bf16* WT, const float* gk, int ncs, float cscale, LAS float* scr, int item, int lane, const float* cmax = nullptr, int* csum = nullptr) {
    const int nblk = N / 64, kb = item / nblk, nb = item % nblk, k0 = 64 * kb, n0 = 64 * nb;
    const float cs = (n0 < ncs) ? cscale : 1.0f;
    const int kl = lane >> 4, n4 = 4 * (lane & 15);
    f32x4 v[16];
#pragma unroll
    for (int i = 0; i < 16; ++i) v[i] = *(const f32x4*)(W + (size_t)(k0 + 4 * i + kl) * N + n0 + n4);
    float gs[16];
#pragma unroll
    for (int i = 0; i < 16; ++i) gs[i] = gk ? gk[k0 + 4 * i + kl] * cs : cs;
    const int rn = lane >> 2, rc = lane & 3;
    f32x4 cinv = (f32x4){1.f, 1.f, 1.f, 1.f}; int cs0 = 0, cs1 = 0, cs2 = 0, cs3 = 0;
    if constexpr (OUT == 2) { const f32x4 cm = *(const f32x4*)(cmax + n0 + n4);
#pragma unroll
        for (int e = 0; e < 4; ++e) cinv[e] = cm[e] > 0.f ? 127.0f / cm[e] : 0.f; }
#pragma unroll
    for (int hh = 0; hh < 2; ++hh) {
#pragma unroll
        for (int i8 = 0; i8 < 8; ++i8) { const int i = hh * 8 + i8, kk = 4 * i8 + kl, c = kk >> 3; *(LAS f32x4*)(scr + kk * 68 + (n4 ^ (8 * c))) = v[i] * gs[i] * cinv; }
        LDS_WAIT(); asm volatile("" ::: "memory");
#pragma unroll
        for (int j = 0; j < 4; ++j) { const int n = rn + 16 * j; const LAS float* sp = scr + (8 * rc) * 68 + (n ^ (8 * rc));
            if constexpr (OUT == 2) { int sm = 0; u32x2 o; o.x = pack4_i8s(sp[0 * 68], sp[1 * 68], sp[2 * 68], sp[3 * 68], sm); o.y = pack4_i8s(sp[4 * 68], sp[5 * 68], sp[6 * 68], sp[7 * 68], sm);
                if (j == 0) cs0 += sm; else if (j == 1) cs1 += sm; else if (j == 2) cs2 += sm; else cs3 += sm;
                *(u32x2*)((unsigned char*)WT + (size_t)(n0 + n) * K + k0 + 32 * hh + 8 * rc) = o; }
            else if constexpr (OUT == 1) { u32x2 o; o.x = pack4_fp8(sp[0 * 68], sp[1 * 68], sp[2 * 68], sp[3 * 68]); o.y = pack4_fp8(sp[4 * 68], sp[5 * 68], sp[6 * 68], sp[7 * 68]);
                *(u32x2*)((unsigned char*)WT + (size_t)(n0 + n) * K + k0 + 32 * hh + 8 * rc) = o; }
            else { u32x4 o; o.x = cvt_pk_bf16(sp[0 * 68], sp[1 * 68]); o.y = cvt_pk_bf16(sp[2 * 68], sp[3 * 68]); o.z = cvt_pk_bf16(sp[4 * 68], sp[5 * 68]); o.w = cvt_pk_bf16(sp[6 * 68], sp[7 * 68]);
                *(u32x4*)(WT + (size_t)(n0 + n) * K + k0 + 32 * hh + 8 * rc) = o; } }
        LDS_WAIT(); asm volatile("" ::: "memory");
    }
    if constexpr (OUT == 2) { if (csum) {
        cs0 += __shfl_xor(cs0, 1); cs0 += __shfl_xor(cs0, 2); cs1 += __shfl_xor(cs1, 1); cs1 += __shfl_xor(cs1, 2); cs2 += __shfl_xor(cs2, 1); cs2 += __shfl_xor(cs2, 2); cs3 += __shfl_xor(cs3, 1); cs3 += __shfl_xor(cs3, 2);
        if (rc == 0) { atomicAdd(csum + n0 + rn, cs0); atomicAdd(csum + n0 + rn + 16, cs1); atomicAdd(csum + n0 + rn + 32, cs2); atomicAdd(csum + n0 + rn + 48, cs3); } } }
}

__device__ __forceinline__ void colmax_item(const float* W, int N, const float* gk, unsigned* cmax, int item, int lane) {
    const int nblk = N / 64, kb = item / nblk, nb = item % nblk, k0 = 64 * kb, n0 = 64 * nb;
    const int kl = lane >> 4, n4 = 4 * (lane & 15);
    f32x4 v[16];
#pragma unroll
    for (int i = 0; i < 16; ++i) v[i] = *(const f32x4*)(W + (size_t)(k0 + 4 * i + kl) * N + n0 + n4);
    float m0 = 0.f, m1 = 0.f, m2 = 0.f, m3 = 0.f;
#pragma unroll
    for (int i = 0; i < 16; ++i) { const float gs = gk ? gk[k0 + 4 * i + kl] : 1.0f; const f32x4 t = v[i] * gs;
        m0 = fmaxf(m0, fabsf(t.x)); m1 = fmaxf(m1, fabsf(t.y)); m2 = fmaxf(m2, fabsf(t.z)); m3 = fmaxf(m3, fabsf(t.w)); }
    m0 = fmaxf(m0, __shfl_xor(m0, 16)); m0 = fmaxf(m0, __shfl_xor(m0, 32));
    m1 = fmaxf(m1, __shfl_xor(m1, 16)); m1 = fmaxf(m1, __shfl_xor(m1, 32));
    m2 = fmaxf(m2, __shfl_xor(m2, 16)); m2 = fmaxf(m2, __shfl_xor(m2, 32));
    m3 = fmaxf(m3, __shfl_xor(m3, 16)); m3 = fmaxf(m3, __shfl_xor(m3, 32));
    if (kl == 0) { unsigned* cp = cmax + n0 + n4;
        atomicMax(cp + 0, __builtin_bit_cast(unsigned, m0)); atomicMax(cp + 1, __builtin_bit_cast(unsigned, m1)); atomicMax(cp + 2, __builtin_bit_cast(unsigned, m2)); atomicMax(cp + 3, __builtin_bit_cast(unsigned, m3)); }
}
__device__ __forceinline__ void xb_row(const Frame& F, const float* xp, const float* xs, int m) {
    const f32x4* xr = (const f32x4*)xrow(xp, xs, m) + F.lane;
    bf16* orow = (bf16*)(F.ws + WS_XB) + (size_t)m * D;
    float ssq = 0.f;
#pragma unroll
    for (int j = 0; j < 16; ++j) { const f32x4 v = xr[64 * j]; ssq += (v[0] * v[0] + v[1] * v[1]) + (v[2] * v[2] + v[3] * v[3]);
        u32x2 w; w.x = cvt_pk_bf16(v[0], v[1]); w.y = cvt_pk_bf16(v[2], v[3]); *((u32x2*)orow + F.lane + 64 * j) = w; }
    ssq = wave_sum(ssq);
    if (F.lane == 0) ((float*)(F.ws + WS_RSTD0))[m] = 1.0f / sqrtf(ssq * (1.0f / D) + RMS_EPS);
}
__device__ __forceinline__ void requant_row(const Frame& F, bf16* hrow, float rowmax) {
    const float sc = rowmax > 0.f ? 255.0f / rowmax : 0.f;
#pragma unroll 1
    for (int half = 0; half < 2; ++half) {
        u32x4 v[16];
#pragma unroll
        for (int i = 0; i < 16; ++i) v[i] = ((const u32x4*)(hrow + 8192 * half))[F.lane + 64 * i];
        asm volatile("s_waitcnt vmcnt(0)" ::: "memory");
#pragma unroll
        for (int i = 0; i < 16; ++i) { u32x2 o;
            o.x = pack4_i8(bf_lo(v[i].x) * sc - 128.f, bf_hi(v[i].x) * sc - 128.f, bf_lo(v[i].y) * sc - 128.f, bf_hi(v[i].y) * sc - 128.f);
            o.y = pack4_i8(bf_lo(v[i].z) * sc - 128.f, bf_hi(v[i].z) * sc - 128.f, bf_lo(v[i].w) * sc - 128.f, bf_hi(v[i].w) * sc - 128.f);
            ((u32x2*)((unsigned char*)hrow + 8192 * half))[F.lane + 64 * i] = o; }
        asm volatile("s_waitcnt vmcnt(0)" ::: "memory"); }
}
template <bool BASE_BF16> __device__ __forceinline__ void row_pass(const Frame& F, const void* base, const bf16* add, const float* ps, const f32x4 (&gg)[16], bf16* outb, float* rs_out, unsigned char* outq) {
    u32x2 ar[16]; u32x2 br[16]; f32x4 bf[16];
#pragma unroll
    for (int j = 0; j < 16; ++j) { const int c4 = F.lane + 64 * j; ar[j] = ((const u32x2*)add)[c4];
        if constexpr (BASE_BF16) br[j] = ((const u32x2*)base)[c4]; else bf[j] = ((const f32x4*)base)[c4]; }
    const float rsa = 1.0f / sqrtf(wave_sum(ps[F.lane]) * (1.0f / D) + RMS_EPS);
    float ssq = 0.f, amax = 0.f; f32x4 hv[16];
#pragma unroll
    for (int j = 0; j < 16; ++j) { const int c4 = F.lane + 64 * j;
        f32x4 b;
        if constexpr (BASE_BF16) { b[0] = bf_lo(br[j].x); b[1] = bf_hi(br[j].x); b[2] = bf_lo(br[j].y); b[3] = bf_hi(br[j].y); } else b = bf[j];
        f32x4 a; a[0] = bf_lo(ar[j].x); a[1] = bf_hi(ar[j].x); a[2] = bf_lo(ar[j].y); a[3] = bf_hi(ar[j].y);
        const f32x4 h = b + a * rsa * gg[j]; hv[j] = h;
        ssq += (h[0] * h[0] + h[1] * h[1]) + (h[2] * h[2] + h[3] * h[3]);
        amax = fmaxf(fmaxf(amax, fmaxf(fabsf(h[0]), fabsf(h[1]))), fmaxf(fabsf(h[2]), fabsf(h[3])));
        u32x2 w; w.x = cvt_pk_bf16(h[0], h[1]); w.y = cvt_pk_bf16(h[2], h[3]); ((u32x2*)outb)[c4] = w; }
    ssq = wave_sum(ssq); amax = wave_max(amax);
    const float inv = amax > 0.f ? 127.0f / amax : 0.f;
#pragma unroll
    for (int j = 0; j < 16; ++j) ((unsigned*)outq)[F.lane + 64 * j] = pack4_i8(hv[j][0] * inv, hv[j][1] * inv, hv[j][2] * inv, hv[j][3] * inv);
    if (F.lane == 0) *rs_out = amax * (1.0f / (127.0f * 127.0f)) / sqrtf(ssq * (1.0f / D) + RMS_EPS);
}

typedef float f32x16 __attribute__((ext_vector_type(16)));
typedef short s16x4 __attribute__((ext_vector_type(4)));
#define MFMA32(a, b, c) __builtin_amdgcn_mfma_f32_32x32x16_bf16((a), (b), (c), 0, 0, 0)
constexpr int NCH = T / 32;

__device__ __forceinline__ void ssm_tables(const Frame& F, int g) {
    LAS float* BBr = (LAS float*)F.lds; LAS float* BBi = BBr + 2048; LAS float* CCr = BBi + 2048; LAS float* CCi = CCr + 2048;
    LAS float* PWr = CCi + 2048; LAS float* PWi = PWr + 4224;
    const int tid = F.tid;
    const float* lamre[2] = {ARGP(7), ARGP(14)}; const float* lamim[2] = {ARGP(8), ARGP(15)}; const float* logdt[2] = {ARGP(9), ARGP(16)};
    {   const float* bre0 = ARGP(10); const float* bim0 = ARGP(11); const float* bre1 = ARGP(17); const float* bim1 = ARGP(18);
        const float* cre0 = ARGP(12); const float* cim0 = ARGP(13); const float* cre1 = ARGP(19); const float* cim1 = ARGP(20);
        for (int idx = tid; idx < 2048; idx += 512) {
            { const int dir = idx >> 10, p = (idx >> 4) & 63, h = idx & 15;
              const float lr = fminf((dir ? lamre[1] : lamre[0])[g * SP + p], -1e-4f), li = (dir ? lamim[1] : lamim[0])[g * SP + p], dt = expf((dir ? logdt[1] : logdt[0])[g]);
              const float mag = expf(lr * dt); float sn, cs; sincosf(li * dt, &sn, &cs);
              const float lbr = mag * cs, lbi = mag * sn, den = lr * lr + li * li, nr = lbr - 1.0f;
              const float cr = (nr * lr + lbi * li) / den, ci = (lbi * lr - nr * li) / den;
              const float br = (dir ? bre1 : bre0)[(size_t)(g * SP + p) * 16 + h], bi = (dir ? bim1 : bim0)[(size_t)(g * SP + p) * 16 + h];
              BBr[idx] = cr * br - ci * bi; BBi[idx] = cr * bi + ci * br; }
            { const int dir = idx >> 10, h = (idx >> 6) & 15, p = idx & 63;
              CCr[idx] = (dir ? cre1 : cre0)[(size_t)(g * 16 + h) * SP + p]; CCi[idx] = (dir ? cim1 : cim0)[(size_t)(g * 16 + h) * SP + p]; }
        }
        for (int idx = tid; idx < 4224; idx += 512) { const int dir = idx / 2112, n = (idx % 2112) >> 6, p = idx & 63;
            const float lr = fminf((dir ? lamre[1] : lamre[0])[g * SP + p], -1e-4f), li = (dir ? lamim[1] : lamim[0])[g * SP + p], dt = expf((dir ? logdt[1] : logdt[0])[g]);
            const float mag = expf(lr * dt * (float)n); float sn, cs; sincosf(li * dt * (float)n, &sn, &cs);
            PWr[idx] = mag * cs; PWi[idx] = mag * sn; }
    }
    __syncthreads();
    bf16* MBg = (bf16*)(F.ws + WS_MB) + (size_t)g * 256 * 512; bf16* MCg = (bf16*)(F.ws + WS_MC) + (size_t)g * 512 * 256; bf16* Kt = (bf16*)(F.ws + WS_KTAB) + (size_t)g * 32768;
    for (int task = tid; task < 8192; task += 512) { const int hb = task & 1, ip = (task >> 1) & 31, p = (task >> 6) & 63, dir = task >> 12;
        const int n = dir ? ip : 31 - ip; const float pr = PWr[dir * 2112 + n * 64 + p], pi = PWi[dir * 2112 + n * 64 + p];
        float vr[8], vi[8];
#pragma unroll
        for (int j = 0; j < 8; ++j) { const float br = BBr[(dir * 64 + p) * 16 + 8 * hb + j], bi = BBi[(dir * 64 + p) * 16 + 8 * hb + j]; vr[j] = pr * br - pi * bi; vi[j] = pr * bi + pi * br; }
        u32x4 wr_, wi_; wr_.x = cvt_pk_bf16(vr[0], vr[1]); wr_.y = cvt_pk_bf16(vr[2], vr[3]); wr_.z = cvt_pk_bf16(vr[4], vr[5]); wr_.w = cvt_pk_bf16(vr[6], vr[7]);
        wi_.x = cvt_pk_bf16(vi[0], vi[1]); wi_.y = cvt_pk_bf16(vi[2], vi[3]); wi_.z = cvt_pk_bf16(vi[4], vi[5]); wi_.w = cvt_pk_bf16(vi[6], vi[7]);
        { const int mtile = dir * 4 + (p >> 4), r0 = 2 * (p & 15); bf16* fb = MBg + ((size_t)(mtile * 32 + ip) * 64) * 8;
          *(u32x4*)(fb + (r0 + 32 * hb) * 8) = wr_; *(u32x4*)(fb + (r0 + 1 + 32 * hb) * 8) = wi_; } }
    for (int task = tid; task < 16384; task += 512) { const int pb = task & 15, dir = (task >> 4) & 1, h = (task >> 5) & 15, i = task >> 9;
        const int n = dir ? 32 - i : i + 1; float v[8];
#pragma unroll
        for (int j = 0; j < 4; ++j) { const int p = 4 * pb + j; const float cr = CCr[(dir * 16 + h) * 64 + p], ci = CCi[(dir * 16 + h) * 64 + p], pr = PWr[dir * 2112 + n * 64 + p], pi = PWi[dir * 2112 + n * 64 + p];
            v[2 * j] = cr * pr - ci * pi; v[2 * j + 1] = -(cr * pi + ci * pr); }
        u32x4 w; w.x = cvt_pk_bf16(v[0], v[1]); w.y = cvt_pk_bf16(v[2], v[3]); w.z = cvt_pk_bf16(v[4], v[5]); w.w = cvt_pk_bf16(v[6], v[7]);
        *(u32x4*)(MCg + ((size_t)(((i >> 1) * 16 + dir * 8 + (pb >> 1)) * 64) + ((i & 1) * 16 + h) + 32 * (pb & 1)) * 8) = w; }
    const float* dsk = ARGP(21);
    for (int task = tid; task < 2016; task += 512) { const int hb = task & 1, h = (task >> 1) & 15, di = task >> 5; const int d = di - 31;
        float acc[8];
#pragma unroll
        for (int j = 0; j < 8; ++j) acc[j] = 0.f;
        for (int dir = 0; dir < 2; ++dir) { if ((dir == 0 && d < 0) || (dir == 1 && d > 0)) continue; const int n = d < 0 ? -d : d;
            for (int p = 0; p < 64; ++p) { const float cr = CCr[(dir * 16 + h) * 64 + p], ci = CCi[(dir * 16 + h) * 64 + p], pr = PWr[dir * 2112 + n * 64 + p], pi = PWi[dir * 2112 + n * 64 + p];
                const float wr_ = cr * pr - ci * pi, wi_ = cr * pi + ci * pr;
#pragma unroll
                for (int j = 0; j < 8; ++j) acc[j] += wr_ * BBr[(dir * 64 + p) * 16 + 8 * hb + j] - wi_ * BBi[(dir * 64 + p) * 16 + 8 * hb + j]; } }
        if (d == 0) {
#pragma unroll
            for (int j = 0; j < 8; ++j) if (8 * hb + j == h) acc[j] += dsk[g * 16 + h]; }
        u32x4 w; w.x = cvt_pk_bf16(acc[0], acc[1]); w.y = cvt_pk_bf16(acc[2], acc[3]); w.z = cvt_pk_bf16(acc[4], acc[5]); w.w = cvt_pk_bf16(acc[6], acc[7]);
        if (di <= 61) *(u32x4*)(Kt + ((size_t)di * 64 + h + 32 * hb) * 8) = w;
        if (di >= 1) *(u32x4*)(Kt + ((size_t)(di - 1) * 64 + 16 + h + 32 * hb) * 8) = w; }
    __syncthreads();
}

__device__ __forceinline__ void ssm_stage_a(const Frame& F, int unit) {
    const int mq = unit & 3, cp = (unit >> 2) % 12, G8 = unit / 48;
    const int g = G8 * 8 + F.wave, c = F.lane & 31, hf = F.lane >> 5;
    const bf16* Up = (const bf16*)(F.ws + WS_UG) + ((size_t)(g * 24 + 2 * cp) * 32) * 512 + F.lane * 8;
    const bf16* Ap = (const bf16*)(F.ws + WS_MB) + ((size_t)(g * 8 + 2 * mq) * 32) * 512 + F.lane * 8;
    f32x16 acc[2][2];
#pragma unroll
    for (int t = 0; t < 2; ++t)
#pragma unroll
        for (int m = 0; m < 2; ++m)
#pragma unroll
            for (int i = 0; i < 16; ++i) acc[t][m][i] = 0.f;
#pragma unroll 4
    for (int ks = 0; ks < 32; ++ks) { const bf16x8 b0 = *(const bf16x8*)(Up + ks * 512), b1 = *(const bf16x8*)(Up + (32 + ks) * 512);
#pragma unroll
        for (int m = 0; m < 2; ++m) { const bf16x8 a = *(const bf16x8*)(Ap + (size_t)(m * 32 + ks) * 512); acc[0][m] = MFMA32(a, b0, acc[0][m]); acc[1][m] = MFMA32(a, b1, acc[1][m]); } }
#pragma unroll
    for (int t = 0; t < 2; ++t) { float* Sp = (float*)(F.ws + WS_S) + ((size_t)(g * 24 + 2 * cp + t) * 64 + 16 * mq + hf) * 128 + c * 4;
#pragma unroll
        for (int m = 0; m < 2; ++m)
#pragma unroll
            for (int q = 0; q < 4; ++q) *(f32x4*)(Sp + (size_t)(8 * m + 2 * q) * 128) = (f32x4){acc[t][m][4 * q], acc[t][m][4 * q + 1], acc[t][m][4 * q + 2], acc[t][m][4 * q + 3]}; }
}

template <int dir> __device__ __forceinline__ void ssm_scan_task(const Frame& F, int task) {
    const int p = F.lane, g = (task >> 1) & 127, seq = task >> 8;
    const int c0 = seq == 0 ? 0 : (seq == 1 ? 128 : 256), nc = seq == 2 ? 512 : 128;
    const float lr = fminf(ARGP(dir ? 14 : 7)[g * SP + p], -1e-4f), li = ARGP(dir ? 15 : 8)[g * SP + p], dt = expf(ARGP(dir ? 16 : 9)[g]);
    const float mag = expf(lr * dt * 32.0f); float sn, cs; sincosf(li * dt * 32.0f, &sn, &cs);
    const float qr = mag * cs, qi = mag * sn;
    const float* Sg = (const float*)(F.ws + WS_S) + ((size_t)g * 24 * 64 + dir * 32 + (p >> 1)) * 128 + 2 * (p & 1);
    bf16* Hg = (bf16*)(F.ws + WS_HB) + ((size_t)g * 24 * 16 + dir * 8 + (p >> 3)) * 512 + 32 * 8 * ((p & 7) >> 2) + 2 * (p & 3);
#define S_AT(cg) (Sg + (size_t)((cg) >> 5) * (64 * 128) + ((cg) & 31) * 4)
#define H_AT(cg) (Hg + (size_t)((cg) >> 5) * (16 * 512) + ((cg) & 31) * 8)
    float hr = 0.f, hi = 0.f;
    f32x2 cur[32];
#pragma unroll
    for (int j = 0; j < 32; ++j) { const int c = dir ? (c0 + nc - 1 - j) : (c0 + j); cur[j] = *(const f32x2*)S_AT(c); }
    for (int sb = 0; sb < nc / 32; ++sb) {
        f32x2 nxt[32];
        const int sbn = (sb + 1 < nc / 32) ? sb + 1 : sb;
#pragma unroll
        for (int j = 0; j < 32; ++j) { const int k = sbn * 32 + j; const int c = dir ? (c0 + nc - 1 - k) : (c0 + k); nxt[j] = *(const f32x2*)S_AT(c); }
#pragma unroll
        for (int j = 0; j < 32; ++j) { const int k = sb * 32 + j; const int c = dir ? (c0 + nc - 1 - k) : (c0 + k);
            *(unsigned*)H_AT(c) = cvt_pk_bf16(hr, hi);
            const float nr = qr * hr - qi * hi + cur[j].x, ni = qr * hi + qi * hr + cur[j].y; hr = nr; hi = ni; }
#pragma unroll
        for (int j = 0; j < 32; ++j) cur[j] = nxt[j];
    }
#undef S_AT
#undef H_AT
}

__device__ __forceinline__ void ssm_stage_c(const Frame& F, int unit) {
    const int mb = unit & 3, cp = (unit >> 2) % 12, G8 = unit / 48;
    const int g = G8 * 8 + F.wave, r = F.lane & 31, hf = F.lane >> 5;
    const bf16* Up = (const bf16*)(F.ws + WS_UG) + ((size_t)(g * 24 + 2 * cp) * 32) * 512 + F.lane * 8;
    const bf16* Kp = (const bf16*)(F.ws + WS_KTAB) + ((size_t)g * 64 + 8 * mb + 31) * 512 + F.lane * 8;
    const bf16* Hp = (const bf16*)(F.ws + WS_HB) + ((size_t)(g * 24 + 2 * cp) * 16) * 512 + F.lane * 8;
    const bf16* Cp = (const bf16*)(F.ws + WS_MC) + ((size_t)(g * 16 + 4 * mb) * 16) * 512 + F.lane * 8;
    f32x16 acc[2][4];
#pragma unroll
    for (int t = 0; t < 2; ++t)
#pragma unroll
        for (int m = 0; m < 4; ++m)
#pragma unroll
            for (int i = 0; i < 16; ++i) acc[t][m][i] = 0.f;
#pragma unroll 4
    for (int ks = 0; ks < 32; ++ks) { const bf16x8 b0 = *(const bf16x8*)(Up + ks * 512), b1 = *(const bf16x8*)(Up + (32 + ks) * 512);
#pragma unroll
        for (int m = 0; m < 4; ++m) { const bf16x8 a = *(const bf16x8*)(Kp + (2 * m - ks) * 512); acc[0][m] = MFMA32(a, b0, acc[0][m]); acc[1][m] = MFMA32(a, b1, acc[1][m]); } }
#pragma unroll 4
    for (int ks = 0; ks < 16; ++ks) { const bf16x8 b0 = *(const bf16x8*)(Hp + ks * 512), b1 = *(const bf16x8*)(Hp + (16 + ks) * 512);
#pragma unroll
        for (int m = 0; m < 4; ++m) { const bf16x8 a = *(const bf16x8*)(Cp + (size_t)(m * 16 + ks) * 512); acc[0][m] = MFMA32(a, b0, acc[0][m]); acc[1][m] = MFMA32(a, b1, acc[1][m]); } }
#pragma unroll
    for (int t = 0; t < 2; ++t) {
        __syncthreads();
        { LAS unsigned char* wb = F.lds + (unsigned)(r * 8) * 256u + (unsigned)((F.wave ^ (r & 7)) * 32 + 8 * hf);
          LAS unsigned char* w8 = F.lds + 65536 + (unsigned)(r * 8) * 128u + (unsigned)((F.wave ^ (r & 7)) * 16 + 4 * hf);
#pragma unroll
          for (int m = 0; m < 4; ++m)
#pragma unroll
            for (int q = 0; q < 4; ++q) { u32x2 w; w.x = cvt_pk_bf16(gelu_tanh(acc[t][m][4 * q]), gelu_tanh(acc[t][m][4 * q + 1])); w.y = cvt_pk_bf16(gelu_tanh(acc[t][m][4 * q + 2]), gelu_tanh(acc[t][m][4 * q + 3]));
                *(LAS u32x2*)(wb + (2 * m + (q >> 1)) * 256 + 16 * (q & 1)) = w;
                *(LAS unsigned*)(w8 + (2 * m + (q >> 1)) * 128 + 8 * (q & 1)) = pack4_fp8(bf_lo(w.x), bf_hi(w.x), bf_lo(w.y), bf_hi(w.y)); } }
        __syncthreads();
        const size_t tok0 = (size_t)((2 * cp + t) * 32) * 32 + 8 * mb;
#pragma unroll
        for (int i = 0; i < 8; ++i) { const int idx = F.tid + 512 * i, row = idx >> 4, seg = idx & 15;
            const u32x4 v = *(const LAS u32x4*)(F.lds + row * 256 + (((seg >> 1) ^ ((row >> 3) & 7)) * 32) + (seg & 1) * 16);
            *(u32x4*)((bf16*)(F.ws + WS_Z) + (tok0 + 32 * (row >> 3) + (row & 7)) * AW + G8 * 128 + seg * 8) = v; }
#pragma unroll
        for (int i = 0; i < 4; ++i) { const int idx = F.tid + 512 * i, row = idx >> 3, seg = idx & 7;
            const u32x4 v = *(const LAS u32x4*)(F.lds + 65536 + row * 128 + ((seg ^ ((row >> 3) & 7)) * 16));
            *(u32x4*)((unsigned char*)(F.ws + WS_ZF8) + (tok0 + 32 * (row >> 3) + (row & 7)) * AW + G8 * 128 + seg * 16) = v; }
    }
}

constexpr int BT_OFF = 132096;
#define KRD(o, a, off) "ds_read_b128 %" #o ", %" #a " offset:" #off "\n\t"
#define TRD(o, a, off) "ds_read_b64_tr_b16 %" #o ", %" #a " offset:" #off "\n\t"
template <int CT>
__device__ __forceinline__ void attn_unit6(const Frame& F, const float* rpb, int unit) {
    constexpr int KB = CT == 0 ? 0 : CT == 1 ? 8 : CT == 2 ? 24 : 32;
    const int h = unit & 15, rg = unit >> 4;
    const int lane = F.lane, wave = F.wave, tid = F.tid, rp = wave >> 2;
    const int R0 = 4 * rg;
    int Rb, rows; if (R0 < 64) { Rb = 0; rows = 64; } else if (R0 < 128) { Rb = 64; rows = 64; } else { Rb = 128; rows = 256; }
    const int r0 = R0 - Rb;
    const int j31 = lane & 31, hf = lane >> 5;
    const int qrow = 2 * rp + (j31 >> 4), r = r0 + qrow;
    int rs = r - 4; rs = rs < 0 ? 0 : rs; rs = rs > rows - 8 ? rows - 8 : rs;
    int rsA = r0 + 2 * rp - 4; rsA = rsA < 0 ? 0 : rsA; rsA = rsA > rows - 8 ? rows - 8 : rsA;
    int rsB = r0 + 2 * rp + 1 - 4; rsB = rsB < 0 ? 0 : rsB; rsB = rsB > rows - 8 ? rows - 8 : rsB;
    int kr_lo = r0 - 4; kr_lo = kr_lo < 0 ? 0 : kr_lo; kr_lo = kr_lo > rows - 8 ? rows - 8 : kr_lo;
    int kr_hi = r0 + 3 - 4; kr_hi = kr_hi < 0 ? 0 : kr_hi; kr_hi = kr_hi > rows - 8 ? rows - 8 : kr_hi; kr_hi += 7;
    const int c = 16 * CT + (j31 & 15); int cs = c - 8; cs = cs < 0 ? 0 : cs; cs = cs > 48 ? 48 : cs;
    const int tokq = (R0 + qrow) * 64 + c;
    LAS float* bt = (LAS float*)(F.lds + BT_OFF);
    __syncthreads();
    for (int i = tid; i < 1024; i += 512) { const int dr_ = i >> 6, dc = (i & 63) - 32; const bool in = dr_ < 15 && dc >= -15 && dc <= 15;
        float v = -__builtin_inff(); if (in) v = rpb[h * 465 + dr_ * 31 + dc + 15] * LOG2E;
        bt[1024 + i] = v; bt[i] = (dc >= -8 && dc <= 7) ? v : -__builtin_inff(); }
    const bf16* Qb = (const bf16*)(F.ws + WS_Q); const bf16* Kb = (const bf16*)(F.ws + WS_K); const bf16* Vb = (const bf16*)(F.ws + WS_V);
    bf16x8 qf[8];
    { const bf16* qp = Qb + (size_t)tokq * AW + h * HD + 8 * hf;
#pragma unroll
      for (int s_ = 0; s_ < 8; ++s_) qf[s_] = *(const bf16x8*)(qp + 16 * s_); }
    f32x16 O[4];
#pragma unroll
    for (int d = 0; d < 4; ++d)
#pragma unroll
        for (int i = 0; i < 16; ++i) O[d][i] = 0.f;
    float mrun = -1e30f, lrun = 0.f;
    unsigned goff[2];
#pragma unroll
    for (int i = 0; i < 2; ++i) { const int row = 8 * wave + 4 * i + (lane >> 4); goff[i] = (unsigned)(row * AW + ((h + row) & 15) * HD + 8 * ((lane & 15) ^ (((row & 3) << 2) | ((row >> 2) & 3)))) * 2u; }
#define ATT_DMA(kr_, buf_) do { const char* kg_ = (const char*)(Kb + (size_t)((Rb + (kr_)) * 64) * AW); const char* vg_ = (const char*)(Vb + (size_t)((Rb + (kr_)) * 64) * AW); \
        _Pragma("unroll") for (int i_ = 0; i_ < 2; ++i_) { \
            __builtin_amdgcn_global_load_lds((const unsigned*)(kg_ + goff[i_]), (LAS unsigned*)(F.lds + (buf_) * 32768 + 2048 * wave + 1024 * i_), 16, 0, 0); \
            __builtin_amdgcn_global_load_lds((const unsigned*)(vg_ + goff[i_]), (LAS unsigned*)(F.lds + (buf_) * 32768 + 16384 + 2048 * wave + 1024 * i_), 16, 0, 0); } } while (0)
    const unsigned lbase = (unsigned)(uintptr_t)F.lds;
    const int krow = KB + j31;
    const unsigned ka = lbase + 256 * krow + 16 * (hf ^ (((krow & 3) << 2) | ((krow >> 2) & 3)));
    const int i16 = lane & 15, q4 = i16 >> 2, pp = i16 & 3, g1 = (lane >> 4) & 1;
    unsigned tbo[4][2];
#pragma unroll
    for (int d = 0; d < 4; ++d)
#pragma unroll
        for (int sec = 0; sec < 2; ++sec) { const int row_l = 4 * hf + 8 * sec + q4, swz = (q4 << 2) | ((hf + 2 * sec + KB / 4) & 3), ch = 4 * d + 2 * g1 + (pp >> 1);
            tbo[d][sec] = lbase + 16384 + 256 * (KB + row_l) + 16 * (ch ^ swz) + 8 * (pp & 1); }
    asm volatile("" :: "v"(qf[0]), "v"(qf[1]), "v"(qf[2]), "v"(qf[3]), "v"(qf[4]), "v"(qf[5]), "v"(qf[6]), "v"(qf[7]));
    asm volatile("s_waitcnt vmcnt(0) lgkmcnt(0)" ::: "memory");
    ATT_DMA(kr_lo, 0); ATT_DMA(kr_lo + 1, 1); ATT_DMA(kr_lo + 2, 2);
    int bi = 0;
    for (int kr = kr_lo; kr <= kr_hi; ++kr) {
        const unsigned bofs = (unsigned)bi * 32768u;
        asm volatile("s_waitcnt vmcnt(8)" ::: "memory");
        __builtin_amdgcn_s_barrier();
        asm volatile("" ::: "memory");
        { const int krn = kr + 3 <= kr_hi ? kr + 3 : kr_hi; const int bn = (bi + 3) & 3; ATT_DMA(krn, bn); }
        if (kr >= rsA && kr < rsB + 8) {
            constexpr bool INTERIOR = (CT == 1 || CT == 2);
            const int dr = kr - r + 7;
            const bool rowok = (unsigned)(kr - rs) < 8u;
            const LAS float* brow = bt + (INTERIOR ? 0 : 1024) + (rowok ? dr : 15) * 64 + (32 - c + KB + 4 * hf);
            f32x16 sacc;
#pragma unroll
            for (int i = 0; i < 16; ++i) sacc[i] = brow[(i & 3) + 8 * (i >> 2)];
            {   bf16x8 k0, k1, k2, k3, k4, k5, k6, k7;
                const unsigned a0 = (ka + bofs), a1 = (ka + bofs) ^ 32u, a2 = (ka + bofs) ^ 64u, a3 = (ka + bofs) ^ 96u, a4 = (ka + bofs) ^ 128u, a5 = (ka + bofs) ^ 160u, a6 = (ka + bofs) ^ 192u, a7 = (ka + bofs) ^ 224u;
                asm volatile(KRD(0, 8, 0) KRD(1, 9, 0) KRD(2, 10, 0) KRD(3, 11, 0) KRD(4, 12, 0) KRD(5, 13, 0) KRD(6, 14, 0) KRD(7, 15, 0) "s_waitcnt lgkmcnt(0)"
                             : "=&v"(k0), "=&v"(k1), "=&v"(k2), "=&v"(k3), "=&v"(k4), "=&v"(k5), "=&v"(k6), "=&v"(k7)
                             : "v"(a0), "v"(a1), "v"(a2), "v"(a3), "v"(a4), "v"(a5), "v"(a6), "v"(a7) : "memory");
                sacc = MFMA32(k0, qf[0], sacc); sacc = MFMA32(k1, qf[1], sacc); sacc = MFMA32(k2, qf[2], sacc); sacc = MFMA32(k3, qf[3], sacc);
                sacc = MFMA32(k4, qf[4], sacc); sacc = MFMA32(k5, qf[5], sacc); sacc = MFMA32(k6, qf[6], sacc); sacc = MFMA32(k7, qf[7], sacc); }
            float mloc = -1e30f;
#pragma unroll
            for (int rg_ = 0; rg_ < 16; ++rg_) { const int kc = KB + (rg_ & 3) + 8 * (rg_ >> 2) + 4 * hf;
                float sc = sacc[rg_];
                if (!INTERIOR) { sc = ((unsigned)(kc - cs) < 16u) ? sc : -__builtin_inff(); sacc[rg_] = sc; }
                mloc = fmaxf(mloc, sc); }
            mloc = fmaxf(mloc, __shfl_xor(mloc, 32));
            const float mnew = fmaxf(mrun, mloc), alpha = __builtin_amdgcn_exp2f(mrun - mnew); mrun = mnew;
            float psum = 0.f;
#pragma unroll
            for (int rg_ = 0; rg_ < 16; ++rg_) { const float p = __builtin_amdgcn_exp2f(sacc[rg_] - mnew); sacc[rg_] = p; psum += p; }
            lrun = lrun * alpha + psum;
            if (!__all(alpha == 1.0f)) {
#pragma unroll
            for (int d = 0; d < 4; ++d)
#pragma unroll
                for (int i = 0; i < 16; ++i) O[d][i] *= alpha; }
            bf16x8 pb[2];
#pragma unroll
            for (int s2 = 0; s2 < 2; ++s2) { u32x4 w; w.x = cvt_pk_bf16(sacc[8 * s2], sacc[8 * s2 + 1]); w.y = cvt_pk_bf16(sacc[8 * s2 + 2], sacc[8 * s2 + 3]);
                w.z = cvt_pk_bf16(sacc[8 * s2 + 4], sacc[8 * s2 + 5]); w.w = cvt_pk_bf16(sacc[8 * s2 + 6], sacc[8 * s2 + 7]); pb[s2] = __builtin_bit_cast(bf16x8, w); }
#pragma unroll
            for (int dp = 0; dp < 2; ++dp) { s16x4 f0, f1, f2, f3, f4, f5, f6, f7;
                const unsigned a0 = bofs + tbo[2 * dp][0], a1 = bofs + tbo[2 * dp][1], a2 = bofs + tbo[2 * dp + 1][0], a3 = bofs + tbo[2 * dp + 1][1];
                asm volatile(TRD(0, 8, 0) TRD(1, 9, 0) TRD(2, 8, 4096) TRD(3, 9, 4096) TRD(4, 10, 0) TRD(5, 11, 0) TRD(6, 10, 4096) TRD(7, 11, 4096) "s_waitcnt lgkmcnt(0)"
                             : "=&v"(f0), "=&v"(f1), "=&v"(f2), "=&v"(f3), "=&v"(f4), "=&v"(f5), "=&v"(f6), "=&v"(f7)
                             : "v"(a0), "v"(a1), "v"(a2), "v"(a3) : "memory");
#define SV(x, y) __builtin_shufflevector(x, y, 0, 1, 2, 3, 4, 5, 6, 7)
                O[2 * dp] = MFMA32(SV(f0, f1), pb[0], O[2 * dp]); O[2 * dp + 1] = MFMA32(SV(f4, f5), pb[0], O[2 * dp + 1]);
                O[2 * dp] = MFMA32(SV(f2, f3), pb[1], O[2 * dp]); O[2 * dp + 1] = MFMA32(SV(f6, f7), pb[1], O[2 * dp + 1]);
#undef SV
            }
        }
        bi = (bi + 1) & 3;
    }
    asm volatile("s_waitcnt vmcnt(0)" ::: "memory");
#undef ATT_DMA
    const float inv = 1.0f / (lrun + __shfl_xor(lrun, 32));
    __syncthreads();
    LAS unsigned char* ot = F.lds + wave * 8704;
    float ssq = 0.f;
#pragma unroll
    for (int d = 0; d < 4; ++d)
#pragma unroll
        for (int q = 0; q < 4; ++q) { const float o0 = O[d][4 * q] * inv, o1 = O[d][4 * q + 1] * inv, o2 = O[d][4 * q + 2] * inv, o3 = O[d][4 * q + 3] * inv;
            ssq += (o0 * o0 + o1 * o1) + (o2 * o2 + o3 * o3);
            u32x2 w; w.x = cvt_pk_bf16(o0, o1); w.y = cvt_pk_bf16(o2, o3); *(LAS u32x2*)(ot + j31 * 272 + 8 * hf + 16 * (4 * d + q)) = w; }
    ssq += __shfl_xor(ssq, 32);
    if (hf == 0) ((float*)(F.ws + WS_PSATT))[(size_t)tokq * 16 + h] = ssq;
    { const int seg = lane & 15;
      bf16* og = (bf16*)(F.ws + WS_XB) + (size_t)((R0 + 2 * rp) * 64 + 16 * CT + (lane >> 4)) * D + h * HD + seg * 8;
#pragma unroll
      for (int i = 0; i < 8; ++i) { const int row = 4 * i + (lane >> 4);
          const u32x4 v = *(const LAS u32x4*)(ot + row * 272 + seg * 16);
          *(u32x4*)(og + (size_t)((i >> 2) * 64 + 4 * (i & 3)) * D) = v; } }
}
#undef KRD
#undef TRD

__global__ void __launch_bounds__(NWAVES * 64, 2) fwd_kernel(Args args) {
    extern __shared__ __attribute__((aligned(16))) unsigned char lds_raw[];
    Frame F;
    F.lds = (LAS unsigned char*)lds_raw;
    F.wave = __builtin_amdgcn_readfirstlane((int)threadIdx.x >> 6); F.lane = lane_op(); F.tid = F.wave * 64 + F.lane;
    F.G = gridDim.x; F.gw = blockIdx.x * NWAVES + F.wave; F.NGW = F.G * NWAVES;
    F.out = args.out; F.ws = args.ws;
    unsigned char* ws = args.ws;
    volatile LAS unsigned* MISC = (volatile LAS unsigned*)(F.lds + MISC_OFF);
    for (int u = F.tid; u < (LDS_BYTES - RING_BYTES) / 4; u += NWAVES * 64) ((LAS unsigned*)(F.lds + RING_BYTES))[u] = 0u;
    __syncthreads();
    XcdBarrier bar = xcd_barrier_post((unsigned*)(ws + WS_CTL) + CW_BAR, MISC + 8, F.wave);
    if (F.wave == 0 && lane_id() == 0) { const unsigned x_ = xb_xcc_id(); MISC[12] = xb_add((unsigned*)(ws + WS_CTL) + CW_RANK + 64 * (x_ & 7u), 1u); MISC[13] = x_; }
    __syncthreads();
    const int lo = args.ph_lo, hi = args.ph_hi;
#define IN(k) (lo <= (k) && (k) < hi)
#define PH_BEGIN() do { F.lane = lane_op(); F.tid = F.wave * 64 + F.lane; } while (0)
#ifndef PROBE_MASK
#define PROBE_MASK 0u
#endif
#define STAMP(k) do { if (PROBE_MASK != 0u && blockIdx.x == 0 && F.wave == 0 && lane_id() == 0) ((volatile LAS unsigned long long*)(F.lds + RING_BYTES + 4096))[(k)] = __builtin_amdgcn_s_memrealtime(); } while (0)
#define SEAM(k) do { if (IN(k) && IN((k) + 1)) xcd_barrier(bar); STAMP((k) + 1); } while (0)
    STAMP(0);

    bf16* XB = (bf16*)(ws + WS_XB);
    float* rstd0 = (float*)(ws + WS_RSTD0); float* rstd1 = (float*)(ws + WS_RSTD1); float* rstd2 = (float*)(ws + WS_RSTD2);
    float* ratio = (float*)(ws + WS_RATIO); float* rsssm = (float*)(ws + WS_RSSSM);
    float* psatt = (float*)(ws + WS_PSATT); float* psssm = (float*)(ws + WS_PSSSM); float* psmix = (float*)(ws + WS_PSMIX); float* psm = (float*)(ws + WS_PSM);
    LAS float* scr = (LAS float*)(F.lds + F.wave * 16384);

    if (IN(0)) { PH_BEGIN();
        for (int g = blockIdx.x; g < NG; g += F.G) ssm_tables(F, g);
        constexpr int I_IN = (D / 64) * (NIN / 64), I_GLU = (AW / 64) * (AW / 64), I_OUT = (D / 64) * (D / 64);
        {
            const float* w_in = ARGP(5); const float* g_pre = ARGP(4); const float* w_glu = ARGP(22); const float* w_out = ARGP(26); const float* g_att = ARGP(24); const float* g_ssm = ARGP(25);
            const float* xp = ARGP(0); const float* xs = ARGP(1);
            const float* w_up0 = ARGP(29); const float* g_mlp0 = ARGP(28); const float* w_gt0 = ARGP(33); const float* g_pl0 = ARGP(32);
            unsigned* cmaxU = (unsigned*)(ws + WS_CTL) + CW_CMAXU; unsigned* cmaxG = (unsigned*)(ws + WS_CTL) + CW_CMAXG;
            const float* w_dn0 = ARGP(30); unsigned* cmaxD = (unsigned*)(ws + WS_CTL) + CW_CMAXD; constexpr int I_CD = (DFF / 64) * (D / 64);
            constexpr int I_CU = (D / 64) * (DFF / 64), I_CG = (D / 64) * (D / 64);
            constexpr int NW = I_IN + I_GLU + I_OUT, NIT = NW + T + I_CU + I_CG + I_CD, PRE = 4;
            const int nfree = (F.G > NG ? F.G - NG : 0) * NWAVES, npre = nfree * PRE < NIT ? nfree * PRE : 0;
            auto do_item = [&](int it) {
                int r = it;
                if (r < I_IN) { transpose_item(w_in, D, NIN, (bf16*)(ws + WS_WIN), g_pre, AW, QSCALE, scr, r, F.lane); return; } r -= I_IN;
                if (r < I_GLU) { transpose_item<1>(w_glu, AW, AW, (bf16*)(ws + WS_WGLU), nullptr, AW, WGLU_SCALE, scr, r, F.lane); return; } r -= I_GLU;
                if (r < I_OUT) {
                    const int nblk = D / 64, kb = r / nblk; const int k0 = 64 * kb;
                    const float* gk = k0 < AW ? g_att : g_ssm - AW;
                    transpose_item(w_out, D, D, (bf16*)(ws + WS_WOUT), gk, 0, 1.f, scr, r, F.lane); return; } r -= I_OUT;
                if (r < T) { xb_row(F, xp, xs, r); return; } r -= T;
                if (r < I_CU) { colmax_item(w_up0, DFF, g_mlp0, cmaxU, r, F.lane); return; } r -= I_CU;
                if (r < I_CG) { colmax_item(w_gt0, D, g_pl0, cmaxG, r, F.lane); return; } r -= I_CG;
                colmax_item(w_dn0, D, nullptr, cmaxD, r, F.lane); };
            if ((int)blockIdx.x >= NG) for (int it = ((int)blockIdx.x - NG) * NWAVES + F.wave; it < npre; it += nfree) do_item(it);
            for (int it = npre + F.gw; it < NIT; it += F.NGW) do_item(it);
        }
        const float* pep = ARGP(2); const float* pes = ARGP(3);
        for (int i = F.gw * 64 + F.lane; i < T * PLE / 4; i += F.NGW * 64) { const int m = i / (PLE / 4), c4 = i % (PLE / 4);
            const f32x4 v = ((const f32x4*)perow(pep, pes, m))[c4]; u32x2 w; w.x = cvt_pk_bf16(v[0], v[1]); w.y = cvt_pk_bf16(v[2], v[3]);
            ((u32x2*)(ws + WS_PEB))[i] = w; }
    }
    SEAM(0);
    int vcu = (int)blockIdx.x;
    if (IN(0) && IN(1) && (F.G & 7) == 0) { bool ok = MISC[13] < 8u;
#pragma unroll
        for (int j = 0; j < 8; ++j) ok = ok && (xb_ld((unsigned*)(ws + WS_CTL) + CW_RANK + 64 * j) == (unsigned)(F.G >> 3));
        if (ok) vcu = (int)(MISC[12] * 8u + MISC[13]); }
    vcu = __builtin_amdgcn_readfirstlane(vcu);
    if (IN(1)) { PH_BEGIN();
        pg8::Gemm g{XB, (const bf16*)(ws + WS_WIN), T, NIN, D, F.wave}; pg8::StaticOrder S; S.init(T, NIN, F.G, vcu);
        pg8::EpiProj E{(bf16*)(ws + WS_Q), (bf16*)(ws + WS_UG), rstd0};
        pg8::gemm_phase<pg8::EpiProj, pg8::StaticOrder, true, true>(F.lds, g, S, E);
    }
    SEAM(1);
    if (IN(2)) { PH_BEGIN();
        if (F.G == 256) {
            for (int it = 0; it < 3; ++it) { const int j = it * 32 + (vcu >> 3), blk = 8 * (vcu & 7) + j / 12, cp_ = j - 12 * (j / 12); ssm_stage_a(F, (blk & 3) + 4 * (cp_ + 12 * (blk >> 2))); }
        } else
            for (int unit = vcu; unit < 768; unit += F.G) ssm_stage_a(F, unit);
        const float* rpb = ARGP(6);
        for (int unit = vcu; unit < 1536; unit += F.G) { switch (F.wave & 3) { case 0: attn_unit6<0>(F, rpb, unit); break; case 1: attn_unit6<1>(F, rpb, unit); break; case 2: attn_unit6<2>(F, rpb, unit); break; default: attn_unit6<3>(F, rpb, unit); break; } }
    }
    SEAM(2);
    if (IN(3)) { PH_BEGIN();
        for (int task = F.wave * F.G + blockIdx.x; task < 768; task += F.NGW) { if (task & 1) ssm_scan_task<1>(F, task); else ssm_scan_task<0>(F, task); }
        {
            constexpr int I_UP = (D / 64) * (DFF / 64), I_DN = (DFF / 64) * (D / 64), I_GT = (D / 64) * (D / 64), NITC = I_UP + I_DN + I_GT, PRE = 5;
            const float* w_up = ARGP(29); const float* g_mlp = ARGP(28); const float* w_dn = ARGP(30); const float* w_gt = ARGP(33); const float* g_pl = ARGP(32);
            auto cv_item = [&](int r) {
                if (r < I_UP) { transpose_item<2>(w_up, D, DFF, (bf16*)(ws + WS_WUP), g_mlp, 0, 1.f, scr, r, F.lane, (const float*)(ws + WS_CTL) + CW_CMAXU); return; } r -= I_UP;
                if (r < I_DN) { transpose_item<2>(w_dn, DFF, D, (bf16*)(ws + WS_WDOWN), nullptr, 0, 1.f, scr, r, F.lane, (const float*)(ws + WS_CTL) + CW_CMAXD, (int*)(ws + WS_CTL) + CW_CSUMD); return; } r -= I_DN;
                transpose_item<2>(w_gt, D, D, (bf16*)(ws + WS_WGATE), g_pl, 0, 1.f, scr, r, F.lane, (const float*)(ws + WS_CTL) + CW_CMAXG); };
            const int widx = F.wave * F.G + (int)blockIdx.x, nfree = F.NGW > 768 ? F.NGW - 768 : 0, npre = nfree * PRE < NITC ? nfree * PRE : 0;
            if (widx >= 768) for (int it = widx - 768; it < npre; it += nfree) cv_item(it);
            for (int it = npre + widx; it < NITC; it += F.NGW) cv_item(it);
        }
    }
    SEAM(3);
    if (IN(4)) { PH_BEGIN();
        if (F.G == 256) {
            for (int it = 0; it < 3; ++it) { const int j = it * 32 + (vcu >> 3), blk = 8 * (vcu & 7) + j / 12, cp_ = j - 12 * (j / 12); ssm_stage_c(F, (blk & 3) + 4 * (cp_ + 12 * (blk >> 2))); }
        } else
            for (int unit = vcu; unit < 768; unit += F.G) ssm_stage_c(F, unit);
    }
    SEAM(4);
    if (IN(5)) { PH_BEGIN();
        pg8::Gemm g{(const bf16*)(ws + WS_ZF8), (const bf16*)(ws + WS_WGLU), T, AW, AW / 2, F.wave};   pg8::StaticOrder S; S.init(T, AW, F.G, vcu);
        pg8::EpiGlu E{(const bf16*)(ws + WS_Z), XB, ARGP(23), psssm, 1.0f / WGLU_SCALE};
        pg8::gemm_phase<pg8::EpiGlu, pg8::StaticOrder, true, true, 1>(F.lds, g, S, E);
    }
    SEAM(5);
    if (IN(6)) { PH_BEGIN();
        for (int m = blockIdx.x * 512 + F.tid; m < T; m += F.G * 512) {
            float sa = 0.f, ss = 0.f;
#pragma unroll
            for (int j = 0; j < 4; ++j) { const f32x4 v = ((const f32x4*)(psatt + (size_t)m * 16))[j]; sa += (v[0] + v[1]) + (v[2] + v[3]); }
#pragma unroll
            for (int j = 0; j < 8; ++j) { const f32x4 v = ((const f32x4*)(psssm + (size_t)m * 32))[j]; ss += (v[0] + v[1]) + (v[2] + v[3]); }
            const float ra = 1.0f / sqrtf(sa * (1.0f / AW) + RMS_EPS), rs = 1.0f / sqrtf(ss * (1.0f / AW) + RMS_EPS);
            ratio[m] = ra / rs; rsssm[m] = rs; }
    }
    SEAM(6);
    if (IN(7)) { PH_BEGIN();
        pg8::Gemm g{XB, (const bf16*)(ws + WS_WOUT), T, D, D, F.wave}; pg8::StaticOrder S; S.init(T, D, F.G, vcu);
        pg8::EpiOut E{(bf16*)(ws + WS_MIX), ratio, rsssm, psmix};
        pg8::gemm_phase<pg8::EpiOut, pg8::StaticOrder, true, true>(F.lds, g, S, E);
    }
    SEAM(7);
    if (IN(8)) { PH_BEGIN();
        { const float* xp = ARGP(0); const float* xs = ARGP(1); const float* gpm = ARGP(27);
        f32x4 gg[16];
#pragma unroll
        for (int j = 0; j < 16; ++j) gg[j] = ((const f32x4*)gpm)[F.lane + 64 * j];
        for (int m = F.gw; m < T; m += F.NGW)
            row_pass<false>(F, xrow(xp, xs, m), (const bf16*)(ws + WS_MIX) + (size_t)m * D, psmix + (size_t)m * 64, gg, XB + (size_t)m * D, rstd1 + m, (unsigned char*)(ws + WS_HQ) + (size_t)m * D); }
        { constexpr int I_PL = (PLE / 64) * (D / 64); const float* w_pl = ARGP(34);
          for (int it = F.gw; it < I_PL; it += F.NGW) transpose_item(w_pl, PLE, D, (bf16*)(ws + WS_WPLE), nullptr, 0, 1.f, scr, it, F.lane); }
    }
    SEAM(8);
    auto h2_pass = [&](int chp) {
        const float* gpl = ARGP(31); const int roff = chp * MCHUNK;
        f32x4 gg[16];
#pragma unroll
        for (int j = 0; j < 16; ++j) gg[j] = ((const f32x4*)gpl)[F.lane + 64 * j];
        for (int ml = F.gw; ml < MCHUNK; ml += F.NGW) { const int m = roff + ml;
            row_pass<true>(F, XB + (size_t)m * D, (const bf16*)(ws + WS_MCH) + (size_t)ml * D, psm + (size_t)m * 64, gg, XB + (size_t)m * D, rstd2 + m, (unsigned char*)(ws + WS_HQ) + (size_t)m * D); } };
    for (int ch = 0; ch < NCHUNK; ++ch) {
        const int row_off = ch * MCHUNK;
        if (IN(9 + 3 * ch)) { PH_BEGIN();
            pg8::Gemm g{(const bf16*)(ws + WS_HQ) + (size_t)row_off * (D / 2), (const bf16*)(ws + WS_WUP), MCHUNK, DFF, D / 2, F.wave};   pg8::StaticOrder S; S.init(MCHUNK, DFF, F.G, vcu);
            pg8::EpiUp E{(bf16*)(ws + WS_HBUF), (const float*)(ws + WS_CTL) + CW_CMAXU, row_off, (unsigned*)(ws + WS_CTL) + CW_RMAXH};
            pg8::gemm_phase<pg8::EpiUp, pg8::StaticOrder, true, true, 2>(F.lds, g, S, E);
        }
        SEAM(9 + 3 * ch);
        if (IN(10 + 3 * ch)) { PH_BEGIN();
            const unsigned* rmx = (const unsigned*)(ws + WS_CTL) + CW_RMAXH;
            for (int ml = F.gw; ml < MCHUNK; ml += F.NGW) requant_row(F, (bf16*)(ws + WS_HBUF) + (size_t)ml * DFF, __uint_as_float(rmx[row_off + ml]));
            if (ch > 0) h2_pass(ch - 1);
        }
        SEAM(10 + 3 * ch);
        if (IN(11 + 3 * ch)) { PH_BEGIN();
            pg8::Gemm g{(const bf16*)(ws + WS_HBUF), (const bf16*)(ws + WS_WDOWN), MCHUNK, D, DFF / 2, F.wave, DFF};   pg8::StaticOrder S; S.init(MCHUNK, D, F.G, vcu);
            pg8::EpiDown E{(bf16*)(ws + WS_MCH), psm, row_off, (const unsigned*)(ws + WS_CTL) + CW_RMAXH, (const float*)(ws + WS_CTL) + CW_CMAXD, (const int*)(ws + WS_CTL) + CW_CSUMD, rstd1};
            pg8::gemm_phase<pg8::EpiDown, pg8::StaticOrder, true, true, 2>(F.lds, g, S, E);
        }
        SEAM(11 + 3 * ch);
    }
    if (IN(9 + 3 * NCHUNK)) { PH_BEGIN();
        h2_pass(NCHUNK - 1);
        pg8::Gemm g{(const bf16*)(ws + WS_PEB), (const bf16*)(ws + WS_WPLE), T, D, PLE, F.wave}; pg8::StaticOrder S; S.init(T, D, F.G, vcu);
        pg8::EpiPle E{(bf16*)(ws + WS_PP)};
        pg8::gemm_phase<pg8::EpiPle, pg8::StaticOrder, true, true>(F.lds, g, S, E);
    }
    SEAM(9 + 3 * NCHUNK);
    if (IN(10 + 3 * NCHUNK)) { PH_BEGIN();
        pg8::Gemm g{(const bf16*)(ws + WS_HQ), (const bf16*)(ws + WS_WGATE), T, D, D / 2, F.wave};   pg8::StaticOrder S; S.init(T, D, F.G, vcu);
        pg8::EpiGate E{F.out, (const bf16*)(ws + WS_PP), XB, rstd2, (const float*)(ws + WS_CTL) + CW_CMAXG};
        pg8::gemm_phase<pg8::EpiGate, pg8::StaticOrder, true, true, 2>(F.lds, g, S, E);
    }
    if (PROBE_MASK != 0u && blockIdx.x == 0 && F.wave == 0 && lane_id() == 0) {
        volatile LAS unsigned long long* ts = (volatile LAS unsigned long long*)(F.lds + RING_BYTES + 4096);
        const unsigned long long tend = __builtin_amdgcn_s_memrealtime(); ts[N_PHASES_K] = tend;
        unsigned long long extra = 0ull;
        for (int k = 0; k < N_PHASES_K; ++k) if ((PROBE_MASK >> k) & 1u) extra += ts[k + 1] - ts[k];
        while (__builtin_amdgcn_s_memrealtime() - tend < extra) __builtin_amdgcn_s_sleep(32);
    }
#undef IN
#undef SEAM
}

constexpr int N_PHASES = 11 + 3 * NCHUNK;
#ifndef MK_PER_PHASE
#define MK_PER_PHASE 0
#endif
extern "C" void kernel_launch(void* const* d_in, const int* in_sizes, int n_in, void* d_out, int out_size, void* d_ws, size_t ws_size, hipStream_t stream) {
    static int grid = 0;
    if (grid == 0) {
        if (n_in != 35 || out_size != T * D || ws_size < WS_END) { fprintf(stderr, "kernel_launch: unexpected problem (n_in %d, out %d, ws %zu)\n", n_in, out_size, ws_size); grid = -1; return; }
        int dev = 0, cus = 0;
        if (hipGetDevice(&dev) != hipSuccess || hipDeviceGetAttribute(&cus, hipDeviceAttributeMultiprocessorCount, dev) != hipSuccess) { grid = -1; return; }
        if (hipFuncSetAttribute((const void*)fwd_kernel, hipFuncAttributeMaxDynamicSharedMemorySize, LDS_BYTES) != hipSuccess) { fprintf(stderr, "kernel_launch: hipFuncSetAttribute failed\n"); grid = -1; return; }
        int per_cu = 0;
        if (hipOccupancyMaxActiveBlocksPerMultiprocessor(&per_cu, (const void*)fwd_kernel, NWAVES * 64, LDS_BYTES) != hipSuccess || per_cu < 1) fprintf(stderr, "kernel_launch: occupancy query reports %d\n", per_cu);
        (void)hipGetLastError();
        grid = cus;
    }
    if (grid < 0) return;
    (void)hipMemsetAsync((char*)d_ws + WS_CTL, 0, CTL_ZERO_BYTES, stream);
    Args a{};
    for (int i = 0; i < 35; ++i) a.in[i] = (const float*)d_in[i];
    a.out = (float*)d_out; a.ws = (unsigned char*)d_ws;
#if MK_PER_PHASE
    for (int p = 0; p < N_PHASES; ++p) { a.ph_lo = p; a.ph_hi = p + 1; hipLaunchKernelGGL(fwd_kernel, dim3(grid), dim3(NWAVES * 64), LDS_BYTES, stream, a); }
#else
    a.ph_lo = 0; a.ph_hi = N_PHASES;
    hipLaunchKernelGGL(fwd_kernel, dim3(grid), dim3(NWAVES * 64), LDS_BYTES, stream, a);
#endif
}
```
